# Optimizing an MI355X kernel written in HIP

```python
import jax, jax.numpy as jnp
from jax import lax
import numpy as np

D_MODEL = 1024
BATCH = 4
SEQ = 4096
DEPTH = 4
DEC_BATCH = 32
DEC_SEQ = 1
PAST_LEN = 8192
PAGE_SIZE = 128

N_AB = (DEPTH + 1) // 2
N_C = DEPTH // 2
D_A = D_MODEL // 2
DK_A = 128
H_A = D_A // DK_A
DV_A = D_A // H_A
CHUNK_A = 64
D_B = D_MODEL // 2
HD_B = 64
H_B = D_B // HD_B
N_KV_B = 2
REP_B = H_B // N_KV_B
CMP_BLOCK = 32
CMP_STRIDE = 16
CMP_HIDDEN = 2 * HD_B
SEL_BLOCK = 64
N_SEL = 16
N_LOCAL = 2
WINDOW = 512
WIN_BLOCK = 128
QB_SEL = 64
D_C = D_MODEL
CHUNK_C = 128
G_C = 8
GC_DIM = D_C // G_C
D_FF = 4 * D_MODEL
A_COLS = 4 * D_A
KV_COLS = 2 * N_KV_B * HD_B
B_COLS = D_B + 3 * KV_COLS + 3 * H_B
AB_COLS = A_COLS + B_COLS
ATT_SCALE = HD_B ** -0.5
EPS = 1e-6
BIG = 1e6

kernel_name = "hgrn2_nsa_gmlp_hybrid_step"


def rmsnorm(x, g):
    xf = x.astype(jnp.float32)
    y = xf * lax.rsqrt(jnp.mean(xf * xf, axis=-1, keepdims=True) + EPS)
    return (y * g.astype(jnp.float32)).astype(x.dtype)


def layernorm(x, g, b):
    xf = x.astype(jnp.float32)
    mu = jnp.mean(xf, axis=-1, keepdims=True)
    var = jnp.mean(jnp.square(xf - mu), axis=-1, keepdims=True)
    y = (xf - mu) * lax.rsqrt(var + EPS) * g.astype(jnp.float32) + b.astype(jnp.float32)
    return y.astype(x.dtype)


def masked_softmax(s, mask):
    s = jnp.where(mask, s.astype(jnp.float32), -jnp.inf)
    m = jnp.max(s, axis=-1, keepdims=True)
    m = jnp.where(jnp.isfinite(m), m, 0.0)
    e = jnp.exp(s - m)
    return e / jnp.maximum(jnp.sum(e, axis=-1, keepdims=True), 1e-30)


def ffn(h, w1, w2):
    return jnp.square(jax.nn.relu(h @ w1)) @ w2


def hgrn2_chunked(q, k, v, logf, s0):
    B, T, H = q.shape[:3]
    c = min(CHUNK_A, T)
    pad = (-T) % c
    nc = (T + pad) // c

    def prep(a):
        a = jnp.pad(a.astype(jnp.float32), ((0, 0), (0, pad), (0, 0), (0, 0)))
        return a.reshape(B, nc, c, H, a.shape[-1]).transpose(1, 0, 3, 2, 4)

    qc, kc, vc, fc = prep(q), prep(k), prep(v), prep(logf)
    causal = jnp.tril(jnp.ones((c, c), dtype=bool))

    def step(S, inp):
        qi, ki, vi, fi = inp
        b = jnp.cumsum(fi, axis=2)
        o_inter = jnp.einsum('bhtd,bhde->bhte', qi * jnp.exp(b), S)
        diff = b[:, :, :, None, :] - b[:, :, None, :, :]
        decay = jnp.exp(jnp.where(causal[:, :, None], diff, -jnp.inf))
        att = jnp.einsum('bhtd,bhsd,bhtsd->bhts', qi, ki, decay)
        o = o_inter + jnp.einsum('bhts,bhse->bhte', att, vi)
        b_last = b[:, :, -1:, :]
        S = jnp.exp(b_last[:, :, 0, :, None]) * S + jnp.einsum('bhsd,bhse->bhde', ki * jnp.exp(b_last - b), vi)
        return S, o

    S, o = lax.scan(step, s0.astype(jnp.float32), (qc, kc, vc, fc))
    o = o.transpose(1, 0, 3, 2, 4).reshape(B, nc * c, H, v.shape[-1])[:, :T]
    return o, S


def hgrn2_mixer(za, s0, lb, norm_g):
    B, T = za.shape[:2]
    q, f, i, g = jnp.split(za.astype(jnp.float32), 4, axis=-1)
    lbf = lb.astype(jnp.float32)
    fgate = lbf + (1.0 - lbf) * jax.nn.sigmoid(f)
    heads = lambda a: a.reshape(B, T, H_A, -1)
    o, S = hgrn2_chunked(heads(jax.nn.silu(q)), heads(1.0 - fgate), heads(i), heads(jnp.log(fgate)), s0)
    o = rmsnorm(o, norm_g) * heads(jax.nn.silu(g))
    return o.reshape(B, T, D_A), S


def split_ab(z):
    B, T = z.shape[:2]
    o = A_COLS
    za = z[..., :o]
    q = z[..., o:o + D_B].reshape(B, T, N_KV_B, REP_B, HD_B)
    o += D_B
    kv_cmp = z[..., o:o + KV_COLS].reshape(B, T, 2, N_KV_B, HD_B)
    o += KV_COLS
    kv_sel = z[..., o:o + KV_COLS].reshape(B, T, 2, N_KV_B, HD_B)
    o += KV_COLS
    kv_win = z[..., o:o + KV_COLS].reshape(B, T, 2, N_KV_B, HD_B)
    o += KV_COLS
    gates = jax.nn.sigmoid(z[..., o:].astype(jnp.float32)).reshape(B, T, N_KV_B, REP_B, 3)
    return za, q, kv_cmp, kv_sel, kv_win, gates


def compress_blocks(kv, pe, w1, w2):
    B, L = kv.shape[:2]
    nseg = L // CMP_STRIDE
    r = CMP_BLOCK // CMP_STRIDE
    n_cmp = nseg - r + 1
    segs = kv[:, :nseg * CMP_STRIDE].reshape(B, nseg, CMP_STRIDE, 2, N_KV_B, HD_B)
    blocks = jnp.concatenate([segs[:, j:j + n_cmp] for j in range(r)], axis=2)
    blocks = blocks + pe.transpose(1, 0, 2)[:, :, None, :]
    flat = blocks.transpose(0, 1, 3, 4, 2, 5).reshape(B, n_cmp, 2, N_KV_B, CMP_BLOCK * HD_B)
    hid = jax.nn.gelu(jnp.einsum('bnkgf,kfh->bnkgh', flat, w1))
    return jnp.einsum('bnkgh,khd->bnkgd', hid, w2)


def nsa_cmp_sel(q, kv_cmp, kv_sel, q_pos, pe, w1, w2):
    B, T = q.shape[:2]
    L = kv_cmp.shape[1]
    qf = q.astype(jnp.float32)
    kc = compress_blocks(kv_cmp, pe, w1, w2).astype(jnp.float32)
    n_cmp = kc.shape[1]
    cstart = jnp.arange(n_cmp) * CMP_STRIDE
    cmask = (cstart + CMP_BLOCK - 1)[None, :] <= q_pos[:, None]
    s = jnp.einsum('btgrd,bngd->bgrtn', qf, kc[:, :, 0]) * ATT_SCALE
    p = masked_softmax(s, cmask)
    o_cmp = jnp.einsum('bgrtn,bngd->btgrd', p, kc[:, :, 1])
    n_sel = -(-L // SEL_BLOCK)
    sstart = jnp.arange(n_sel) * SEL_BLOCK
    overlap = ((cstart[:, None] < sstart[None, :] + SEL_BLOCK) &
               (cstart[:, None] + CMP_BLOCK > sstart[None, :])).astype(jnp.float32)
    imp = jnp.einsum('bgrtn,nj->bgtj', p, overlap)
    pad = n_sel * SEL_BLOCK - L
    ks = jnp.pad(kv_sel.astype(jnp.float32), ((0, 0), (0, pad), (0, 0), (0, 0), (0, 0)))
    ks = ks.reshape(B, n_sel, SEL_BLOCK, 2, N_KV_B, HD_B).transpose(0, 4, 1, 2, 3, 5)
    k_top = min(N_SEL, n_sel)
    qb = QB_SEL if T % QB_SEL == 0 else T
    nqb = T // qb
    bi = jnp.arange(B)[:, None, None, None]
    gi = jnp.arange(N_KV_B)[None, :, None, None]
    jsel = jnp.arange(n_sel)

    def sel_block(args):
        qi, impi, posi = args
        cur = posi // SEL_BLOCK
        valid = jsel[None, :] <= cur[:, None]
        dist = cur[:, None] - jsel[None, :]
        forced = (jsel[None, :] == 0) | ((dist >= 0) & (dist < N_LOCAL))
        rank = jnp.where(valid, impi + BIG * forced.astype(jnp.float32), -BIG)
        _, idx = lax.top_k(rank, k_top)
        kvg = ks[bi, gi, idx].reshape(B, N_KV_B, qb, k_top * SEL_BLOCK, 2, HD_B)
        kpos = idx[..., None] * SEL_BLOCK + jnp.arange(SEL_BLOCK)
        kmask = (kpos <= posi[None, None, :, None, None]).reshape(B, N_KV_B, qb, k_top * SEL_BLOCK)
        sc = jnp.einsum('btgrd,bgtkd->bgrtk', qi, kvg[..., 0, :]) * ATT_SCALE
        pr = masked_softmax(sc, kmask[:, :, None])
        return jnp.einsum('bgrtk,bgtkd->btgrd', pr, kvg[..., 1, :])

    q_blocks = qf.reshape(B, nqb, qb, N_KV_B, REP_B, HD_B).transpose(1, 0, 2, 3, 4, 5)
    imp_blocks = imp.reshape(B, N_KV_B, nqb, qb, n_sel).transpose(2, 0, 1, 3, 4)
    o_sel = lax.map(sel_block, (q_blocks, imp_blocks, q_pos.reshape(nqb, qb)))
    o_sel = o_sel.transpose(1, 0, 2, 3, 4, 5).reshape(B, T, N_KV_B, REP_B, HD_B)
    return o_cmp, o_sel


def window_attn_prompt(q, kv):
    B, S = q.shape[:2]
    nb = S // WIN_BLOCK
    nback = WINDOW // WIN_BLOCK
    kb_len = (nback + 1) * WIN_BLOCK
    kvp = jnp.pad(kv.astype(jnp.float32), ((0, 0), (WINDOW, 0), (0, 0), (0, 0), (0, 0)))
    band = jnp.concatenate([kvp[:, j * WIN_BLOCK:j * WIN_BLOCK + S].reshape(B, nb, WIN_BLOCK, 2, N_KV_B, HD_B)
                            for j in range(nback + 1)], axis=2)
    qpos = jnp.arange(S).reshape(nb, WIN_BLOCK)
    kpos = jnp.arange(nb)[:, None] * WIN_BLOCK - WINDOW + jnp.arange(kb_len)[None, :]
    d = qpos[:, :, None] - kpos[:, None, :]
    mask = (kpos[:, None, :] >= 0) & (d >= 0) & (d < WINDOW)
    qblk = q.astype(jnp.float32).reshape(B, nb, WIN_BLOCK, N_KV_B, REP_B, HD_B)
    s = jnp.einsum('bctgrd,bckgd->bcgrtk', qblk, band[:, :, :, 0]) * ATT_SCALE
    p = masked_softmax(s, mask[None, :, None, None])
    o = jnp.einsum('bcgrtk,bckgd->bctgrd', p, band[:, :, :, 1])
    return o.reshape(B, S, N_KV_B, REP_B, HD_B)


def window_attn_dense(q, kv, q_pos, k_pos):
    d = q_pos[:, None] - k_pos[None, :]
    mask = (d >= 0) & (d < WINDOW)
    kvf = kv.astype(jnp.float32)
    s = jnp.einsum('btgrd,bkgd->bgrtk', q.astype(jnp.float32), kvf[:, :, 0]) * ATT_SCALE
    p = masked_softmax(s, mask)
    return jnp.einsum('bgrtk,bkgd->btgrd', p, kvf[:, :, 1])


def merge_ab(o_a, o_cmp, o_sel, o_win, gates, w_out, dtype):
    B, T = o_a.shape[:2]
    o_b = gates[..., 0:1] * o_cmp + gates[..., 1:2] * o_sel + gates[..., 2:3] * o_win
    o = jnp.concatenate([o_a.astype(dtype), o_b.reshape(B, T, D_B).astype(dtype)], axis=-1)
    return o @ w_out


def ab_prompt(h, w_in, w_out, lb, hnorm, pe, w1, w2):
    B, S = h.shape[:2]
    za, q, kv_cmp, kv_sel, kv_win, gates = split_ab(h @ w_in)
    o_a, s_fin = hgrn2_mixer(za, jnp.zeros((B, H_A, DK_A, DV_A), jnp.float32), lb, hnorm)
    o_cmp, o_sel = nsa_cmp_sel(q, kv_cmp, kv_sel, jnp.arange(S), pe, w1, w2)
    o_win = window_attn_prompt(q, kv_win)
    out = merge_ab(o_a, o_cmp, o_sel, o_win, gates, w_out, h.dtype)
    return out, kv_cmp, kv_sel, kv_win[:, S - min(WINDOW, S):], s_fin


def gather_pages(cache, page_table):
    rows = cache[page_table]
    return rows.reshape(rows.shape[0], -1, *rows.shape[3:])


def ab_sample(h, page_table, cache_cmp, cache_sel, win_buf, s_hgrn, w_in, w_out, lb, hnorm, pe, w1, w2):
    T = h.shape[1]
    za, q, kv_cmp, kv_sel, kv_win, gates = split_ab(h @ w_in)
    o_a, s_new = hgrn2_mixer(za, s_hgrn, lb, hnorm)
    full_cmp = jnp.concatenate([gather_pages(cache_cmp, page_table).astype(kv_cmp.dtype), kv_cmp], axis=1)
    full_sel = jnp.concatenate([gather_pages(cache_sel, page_table).astype(kv_sel.dtype), kv_sel], axis=1)
    q_pos = PAST_LEN + jnp.arange(T)
    o_cmp, o_sel = nsa_cmp_sel(q, full_cmp, full_sel, q_pos, pe, w1, w2)
    w_buf = win_buf.shape[1]
    kv_w = jnp.concatenate([win_buf.astype(kv_win.dtype), kv_win], axis=1)
    k_pos = PAST_LEN - w_buf + jnp.arange(w_buf + T)
    o_win = window_attn_dense(q, kv_w, q_pos, k_pos)
    out = merge_ab(o_a, o_cmp, o_sel, o_win, gates, w_out, h.dtype)
    return out, kv_cmp, kv_sel, kv_w[:, T:], s_new


def chunk_mlp(h, w_in, ln_g, ln_b, w_s, b_s, w_out):
    B, T = h.shape[:2]
    z = jax.nn.gelu(h @ w_in)
    u, v = jnp.split(z, 2, axis=-1)
    v = layernorm(v, ln_g, ln_b)
    c = min(CHUNK_C, T)
    pad = (-T) % c
    vv = jnp.pad(v, ((0, 0), (0, pad), (0, 0))).reshape(B, (T + pad) // c, c, G_C, GC_DIM)
    ws = jnp.tril(w_s[:, :c, :c])
    mix = jnp.einsum('gts,bnsgc->bntgc', ws, vv) + b_s[:, :c].T[None, None, :, :, None]
    mix = mix.reshape(B, T + pad, D_C)[:, :T]
    return (u * mix) @ w_out, v


def setup_inputs(seed: int = 0) -> dict:
    key = jax.random.key(seed)
    ks = jax.random.split(key, 32)
    nrm = lambda k, shape, scale: jax.random.normal(k, shape, jnp.float32) * scale
    n_pages = PAST_LEN // PAGE_SIZE
    n_pool = (DEC_BATCH * n_pages * 5) // 4
    w_buf = min(WINDOW, PAST_LEN)
    page_table = jax.random.permutation(ks[0], n_pool)[:DEC_BATCH * n_pages].reshape(DEC_BATCH, n_pages).astype(jnp.int32)
    return {
        "x_prompt": nrm(ks[1], (BATCH, SEQ, D_MODEL), 1.0),
        "x_sample": nrm(ks[2], (DEC_BATCH, DEC_SEQ, D_MODEL), 1.0),
        "cache_cmp_kv": nrm(ks[3], (N_AB, n_pool, PAGE_SIZE, 2, N_KV_B, HD_B), 1.0),
        "cache_sel_kv": nrm(ks[4], (N_AB, n_pool, PAGE_SIZE, 2, N_KV_B, HD_B), 1.0),
        "state_win_kv": nrm(ks[5], (N_AB, DEC_BATCH, w_buf, 2, N_KV_B, HD_B), 1.0),
        "state_hgrn": nrm(ks[6], (N_AB, DEC_BATCH, H_A, DK_A, DV_A), 0.5),
        "page_table": page_table,
        "norm_mix": 1.0 + nrm(ks[7], (DEPTH, D_MODEL), 0.1),
        "norm_ffn": 1.0 + nrm(ks[8], (DEPTH, D_MODEL), 0.1),
        "norm_final": 1.0 + nrm(ks[9], (D_MODEL,), 0.1),
        "w_in_ab": nrm(ks[10], (N_AB, D_MODEL, AB_COLS), D_MODEL ** -0.5),
        "w_out_ab": nrm(ks[11], (N_AB, D_A + D_B, D_MODEL), (D_A + D_B) ** -0.5),
        "hgrn_lower_bounds": nrm(ks[12], (N_AB, D_A), 0.5),
        "hgrn_norm": 1.0 + nrm(ks[13], (N_AB, DV_A), 0.1),
        "cmp_pe": nrm(ks[14], (N_AB, 2, CMP_BLOCK, HD_B), 0.1),
        "cmp_w1": nrm(ks[15], (N_AB, 2, CMP_BLOCK * HD_B, CMP_HIDDEN), (CMP_BLOCK * HD_B) ** -0.5),
        "cmp_w2": nrm(ks[16], (N_AB, 2, CMP_HIDDEN, HD_B), CMP_HIDDEN ** -0.5),
        "w_in_c": nrm(ks[17], (N_C, D_MODEL, 2 * D_C), D_MODEL ** -0.5),
        "ln_c_g": 1.0 + nrm(ks[18], (N_C, D_C), 0.1),
        "ln_c_b": nrm(ks[19], (N_C, D_C), 0.1),
        "w_s": nrm(ks[20], (N_C, G_C, CHUNK_C, CHUNK_C), CHUNK_C ** -0.5),
        "b_s": 1.0 + nrm(ks[21], (N_C, G_C, CHUNK_C), 0.1),
        "w_out_c": nrm(ks[22], (N_C, D_C, D_MODEL), D_C ** -0.5),
        "w_ffn1": nrm(ks[23], (DEPTH, D_MODEL, D_FF), D_MODEL ** -0.5),
        "w_ffn2": nrm(ks[24], (DEPTH, D_FF, D_MODEL), D_FF ** -0.5),
    }


def reference(x_prompt, x_sample, cache_cmp_kv, cache_sel_kv, state_win_kv, state_hgrn, page_table,
              norm_mix, norm_ffn, norm_final, w_in_ab, w_out_ab, hgrn_lower_bounds, hgrn_norm,
              cmp_pe, cmp_w1, cmp_w2, w_in_c, ln_c_g, ln_c_b, w_s, b_s, w_out_c, w_ffn1, w_ffn2):
    lbs = jax.nn.softmax(hgrn_lower_bounds.astype(jnp.float32), axis=0)
    lbs = jnp.cumsum(lbs, axis=0) - lbs[0:1]
    hp, hs = x_prompt, x_sample
    cmp_p, cmp_s, sel_p, sel_s, win_p, win_s, hg_p, hg_s, cv_s = [], [], [], [], [], [], [], [], []
    for layer in range(DEPTH):
        j = layer // 2
        hpn = rmsnorm(hp, norm_mix[layer])
        hsn = rmsnorm(hs, norm_mix[layer])
        if layer % 2 == 0:
            op, kc, ksl, kw, st = ab_prompt(hpn, w_in_ab[j], w_out_ab[j], lbs[j], hgrn_norm[j],
                                            cmp_pe[j], cmp_w1[j], cmp_w2[j])
            cmp_p.append(kc); sel_p.append(ksl); win_p.append(kw); hg_p.append(st)
            osm, kc, ksl, kw, st = ab_sample(hsn, page_table, cache_cmp_kv[j], cache_sel_kv[j], state_win_kv[j],
                                             state_hgrn[j], w_in_ab[j], w_out_ab[j], lbs[j], hgrn_norm[j],
                                             cmp_pe[j], cmp_w1[j], cmp_w2[j])
            cmp_s.append(kc); sel_s.append(ksl); win_s.append(kw); hg_s.append(st)
        else:
            op, _ = chunk_mlp(hpn, w_in_c[j], ln_c_g[j], ln_c_b[j], w_s[j], b_s[j], w_out_c[j])
            osm, v_new = chunk_mlp(hsn, w_in_c[j], ln_c_g[j], ln_c_b[j], w_s[j], b_s[j], w_out_c[j])
            cv_s.append(v_new)
        hp = hp + op.astype(hp.dtype)
        hs = hs + osm.astype(hs.dtype)
        hp = hp + ffn(rmsnorm(hp, norm_ffn[layer]), w_ffn1[layer], w_ffn2[layer])
        hs = hs + ffn(rmsnorm(hs, norm_ffn[layer]), w_ffn1[layer], w_ffn2[layer])
    y_prompt = rmsnorm(hp, norm_final)
    y_sample = rmsnorm(hs, norm_final)
    return (y_prompt, y_sample, jnp.stack(cmp_p), jnp.stack(cmp_s), jnp.stack(sel_p), jnp.stack(sel_s),
            jnp.stack(win_p), jnp.stack(win_s), jnp.stack(hg_p), jnp.stack(hg_s), jnp.stack(cv_s))
```

```cpp
#include <hip/hip_runtime.h>
#include <cstdio>
#include <cstdint>

#ifndef MK_ONE_LAUNCH
#define MK_ONE_LAUNCH 1
#endif

#define DI __device__ __forceinline__
#define LAS __attribute__((address_space(3)))
#define GAS __attribute__((address_space(1)))
typedef unsigned short bf16;
typedef short bf16x8 __attribute__((ext_vector_type(8)));
typedef short s16x4 __attribute__((ext_vector_type(4)));
typedef float f32x4 __attribute__((ext_vector_type(4)));
typedef float f32x2 __attribute__((ext_vector_type(2)));
typedef unsigned u32x4 __attribute__((ext_vector_type(4)));
typedef unsigned u32x2 __attribute__((ext_vector_type(2)));
typedef unsigned long long u64;

constexpr int D = 1024, BATCH = 4, SEQ = 4096, MP = BATCH * SEQ, DB = 32, PAST = 8192, NPAGES = 64, NPOOL = 2560;
constexpr int ABC = 3352, ABP = 3584, FF = 4096;
constexpr float EPS = 1e-6f;
constexpr int C_Q = 0, C_F = 512, C_I = 1024, C_G = 1536, C_QB = 2048, C_CMP = 2560, C_SEL = 2816, C_WIN = 3072, C_GATE = 3328;

constexpr size_t O_YP = 0, O_YS = 16777216, O_CMP_P = O_YS + 32768, O_CMP_S = O_CMP_P + 8388608, O_SEL_P = O_CMP_S + 16384, O_SEL_S = O_SEL_P + 8388608,
                 O_WIN_P = O_SEL_S + 16384, O_WIN_S = O_WIN_P + 1048576, O_HG_P = O_WIN_S + 8388608, O_HG_S = O_HG_P + 524288, O_CV_S = O_HG_S + 4194304, O_END = O_CV_S + 65536;

constexpr size_t MiB = 1u << 20;
constexpr size_t WS_CTL = 0, CTL_ZERO_BYTES = 1 * MiB;
constexpr size_t WS_WINAB = 2 * MiB, WS_WOUTAB = 16 * MiB, WS_WINC = 20 * MiB, WS_WOUTC = 28 * MiB, WS_WF1 = 32 * MiB, WS_WF2 = 64 * MiB, WS_WC1 = 96 * MiB, WS_WC2 = 98 * MiB,
                 WS_TRIL = 99 * MiB, WS_SMALL = 100 * MiB, WS_HP = 104 * MiB, WS_HB = 168 * MiB, WS_SSQ = 200 * MiB, WS_VSTAT = 201 * MiB, WS_ZB = 204 * MiB, WS_HFF = 316 * MiB,
                 WS_OC = 444 * MiB, WS_LT = 476 * MiB, WS_DL = 540 * MiB, WS_KCP = 541 * MiB, WS_KCS = 542 * MiB, WS_SMP = 558 * MiB, WS_END = 560 * MiB, WS_DUMMY = 560 * MiB;
constexpr size_t WS_MSK = WS_SMALL + 1 * MiB;
constexpr size_t SMP_HS = 0, SMP_ZS = 128 * 1024, SMP_OCS = 576 * 1024, SMP_HFFS = 704 * 1024, SMP_UVS = 1216 * 1024, SMP_HSB = 1472 * 1024;

constexpr int LDS_BYTES = 163840;
constexpr int MISC_OFF = LDS_BYTES - 64;

DI unsigned pk2(float lo, float hi) { typedef __bf16 bf2 __attribute__((ext_vector_type(2))); f32x2 v = {lo, hi}; bf2 b = __builtin_convertvector(v, bf2); return __builtin_bit_cast(unsigned, b); }
DI bf16 f2bf(float x) { return (bf16)(pk2(x, 0.f) & 0xffffu); }
DI float bf2f(bf16 h) { return __uint_as_float((unsigned)h << 16); }
DI float bflo(unsigned u) { return __uint_as_float(u << 16); }
DI float bfhi(unsigned u) { return __uint_as_float(u & 0xffff0000u); }
DI float sigmoidf_(float x) { return __builtin_amdgcn_rcpf(1.f + __expf(-x)); }
DI float siluf_(float x) { return x * __builtin_amdgcn_rcpf(1.f + __expf(-x)); }
DI float gelu_tanh(float x) { const float u = 0.7978845608028654f * (x + 0.044715f * x * x * x); return x * __builtin_amdgcn_rcpf(1.f + __expf(-2.f * u)); }
DI float wave_sum(float v) {
#pragma unroll
    for (int o = 1; o < 64; o <<= 1) v += __shfl_xor(v, o);
    return v;
}
DI float wave_max(float v) {
#pragma unroll
    for (int o = 1; o < 64; o <<= 1) v = fmaxf(v, __shfl_xor(v, o));
    return v;
}
DI float fmax2(float a, float b) { float r; asm("v_max_f32 %0, %1, %2" : "=v"(r) : "v"(a), "v"(b)); return r; }
DI float fmax3(float a, float b, float c) { float r; asm("v_max3_f32 %0, %1, %2, %3" : "=v"(r) : "v"(a), "v"(b), "v"(c)); return r; }
DI float quad_max(float v) {
    auto a = __builtin_amdgcn_permlane16_swap(__float_as_uint(v), __float_as_uint(v), false, false); v = fmax2(__uint_as_float(a[0]), __uint_as_float(a[1]));
    auto b = __builtin_amdgcn_permlane32_swap(__float_as_uint(v), __float_as_uint(v), false, false); return fmax2(__uint_as_float(b[0]), __uint_as_float(b[1]));
}
DI float quad_sum(float v) {
    auto a = __builtin_amdgcn_permlane16_swap(__float_as_uint(v), __float_as_uint(v), false, false); v = __uint_as_float(a[0]) + __uint_as_float(a[1]);
    auto b = __builtin_amdgcn_permlane32_swap(__float_as_uint(v), __float_as_uint(v), false, false); return __uint_as_float(b[0]) + __uint_as_float(b[1]);
}
DI bf16x8 pack8(f32x4 a, f32x4 b) { u32x4 p; p.x = pk2(a.x, a.y); p.y = pk2(a.z, a.w); p.z = pk2(b.x, b.y); p.w = pk2(b.z, b.w); return __builtin_bit_cast(bf16x8, p); }
DI int otid() { int t = threadIdx.x; asm volatile("" : "+v"(t)); return t; }
#define MFMA16(a, b, c) __builtin_amdgcn_mfma_f32_16x16x32_bf16((a), (b), (c), 0, 0, 0)
DI s16x4 vtr(const bf16* p) { return __builtin_bit_cast(s16x4, __builtin_amdgcn_ds_read_tr16_b64_v4i16((LAS s16x4*)(LAS char*)p)); }
DI bf16x8 tr_frag(const bf16* img, int stride, int k0, int c0, int r16, int quad) {
    const bf16* p = img + (k0 + quad * 8 + (r16 >> 2)) * stride + c0 + (r16 & 3) * 4;
    const s16x4 lo = vtr(p), hi = vtr(p + 4 * stride);
    return __builtin_shufflevector(lo, hi, 0, 1, 2, 3, 4, 5, 6, 7);
}

namespace pg8 {
#define PG8_LAS __attribute__((address_space(3)))
constexpr int BM = 256, BK = 64, HALF = 128, HTB = HALF * BK * 2, STAGE_BYTES = 8 * HTB, NXCD = 8, WGM = 4;
__host__ __device__ __forceinline__ int lds_byte(int r, int c) { const int st = (r >> 4) * 2 + (c >> 5), rr = r & 15, cc = c & 31, ob = rr * 64 + cc * 2; return st * 1024 + (ob ^ (((ob >> 9) & 1) << 5)); }
__host__ __device__ __forceinline__ void stage_rc(int b, int& R, int& C) { const int st = b / 1024, sb = b % 1024, swz = sb ^ (((sb >> 9) & 1) << 5); R = (st >> 1) * 16 + swz / 64; C = (st & 1) * 32 + (swz % 64) / 2; }
__host__ __device__ __forceinline__ int perm32(int rho) { const int n = rho >> 4, i = rho & 15; return 8 * (i >> 2) + 4 * n + (i & 3); }
struct Unit { int pm, pn; };
struct Gemm { const bf16* A; const bf16* Bt; int M, N, K; };
struct StaticOrder {
    int nM, nN, nwg, G, c, wgm;
    __host__ __device__ void init(int M, int N, int G_, int c_, int wgm_ = WGM) { nM = M / BM; nN = N / BM; nwg = nM * nN; G = G_; c = c_; wgm = wgm_; }
    __host__ __device__ bool next(int i, Unit& u) const {
        const long L = (long)i * G + c; if (L >= nwg) return false;
        int wgid = (int)L; { const int q = nwg / NXCD, r = nwg % NXCD, xcd = wgid % NXCD, off = wgid / NXCD; wgid = (xcd < r ? xcd * (q + 1) : r * (q + 1) + (xcd - r) * q) + off; }
        const int nig = wgm * nN, gid = wgid / nig, fm = gid * wgm, gsz = (nM - fm) < wgm ? (nM - fm) : wgm;
        u.pm = fm + ((wgid % nig) % gsz); u.pn = (wgid % nig) / gsz; return true;
    }
    __device__ __forceinline__ void a_ready(const Unit&) const {}
    __device__ __forceinline__ void done(const Unit&) const {}
};
template <class Epi, class Sched, bool ALIGN_EPI = false, bool SP2 = false>
__device__ __forceinline__ void gemm_phase(PG8_LAS unsigned char* lds, const Gemm g, const Sched& S, const Epi& E) {
    const int tid = otid(), wid = __builtin_amdgcn_readfirstlane(tid >> 6), lane = tid & 63, wr = wid >> 2, wc = wid & 3, fr = lane & 15, fq = lane >> 4;
    const int K = g.K, nt = K / BK;
    unsigned voffA[2], voffB[2];
#pragma unroll
    for (int i = 0; i < 2; ++i) { int R, C; stage_rc(tid * 16 + i * 8192, R, C); const int Rb = Epi::PERM ? ((R & ~31) + perm32(R & 31)) : R;
        voffA[i] = (unsigned)(R * K + C) * 2u; voffB[i] = (unsigned)(Rb * K + C) * 2u; }
    const size_t kstep = (size_t)(BK * 2);
    const size_t hstep = (size_t)HALF * K * 2;
    const size_t tstep = 2 * hstep;
    const unsigned ldsw = (unsigned)wid * 1024u;
    const int aoff = lds_byte(wr * 64 + fr, fq * 8), boff = lds_byte(wc * 32 + fr, fq * 8);
#define PG8_SA(b, h) (((b) * 2 + (h)) * HTB)
#define PG8_SB(b, h) ((4 + (b) * 2 + (h)) * HTB)
#define PG8_STAGE(bufoff, gbase, voff) do { _Pragma("unroll") for (int _i = 0; _i < 2; ++_i) \
        __builtin_amdgcn_global_load_lds((const unsigned*)((const char*)(gbase) + (voff)[_i]), (PG8_LAS unsigned*)(lds + (bufoff) + ldsw + _i * 8192), 16, 0, 0); } while (0)
#define PG8_LDA(dst, b, h) do { _Pragma("unroll") for (int m = 0; m < 4; ++m) _Pragma("unroll") for (int k = 0; k < 2; ++k) dst[m][k] = *(const PG8_LAS bf16x8*)(lds + PG8_SA(b, h) + aoff + m * 2048 + k * 1024); } while (0)
#define PG8_LDB(dst, b, h) do { _Pragma("unroll") for (int n = 0; n < 2; ++n) _Pragma("unroll") for (int k = 0; k < 2; ++k) dst[n][k] = *(const PG8_LAS bf16x8*)(lds + PG8_SB(b, h) + boff + n * 2048 + k * 1024); } while (0)
#define PG8_MMA(ai, bj, At, Bt) do { __builtin_amdgcn_s_setprio(1); _Pragma("unroll") for (int m = 0; m < 4; ++m) _Pragma("unroll") for (int n = 0; n < 2; ++n) _Pragma("unroll") for (int k = 0; k < 2; ++k) \
        acc[ai][bj][m][n] = __builtin_amdgcn_mfma_f32_16x16x32_bf16(Bt[n][k], At[m][k], acc[ai][bj][m][n], 0, 0, 0); __builtin_amdgcn_s_setprio(0); } while (0)
#define PG8_WAIT_V(n) asm volatile("s_waitcnt vmcnt(" #n ")" ::: "memory")
#define PG8_WAIT_L(n) asm volatile("s_waitcnt lgkmcnt(" #n ")" ::: "memory")
#define PG8_BAR __builtin_amdgcn_s_barrier()
#define PG8_SCHED __builtin_amdgcn_sched_barrier(0)
    Unit cur, nxt; int ui = 0;
    if (!S.next(0, cur)) return;
    f32x4 acc[2][2][4][2];
#pragma unroll
    for (int a = 0; a < 2; ++a)
#pragma unroll
        for (int b = 0; b < 2; ++b)
#pragma unroll
            for (int m = 0; m < 4; ++m)
#pragma unroll
                for (int n = 0; n < 2; ++n) acc[a][b][m][n] = (f32x4){0.f, 0.f, 0.f, 0.f};
    bf16x8 At[4][2], B0[2][2], B1[2][2];
    const char* cA = (const char*)g.A + (size_t)cur.pm * tstep; const char* cB = (const char*)g.Bt + (size_t)cur.pn * tstep;
    S.a_ready(cur);
    if constexpr (SP2) {
        PG8_STAGE(PG8_SB(0, 0), cB, voffB); PG8_STAGE(PG8_SB(0, 1), cB + hstep, voffB); PG8_STAGE(PG8_SA(0, 0), cA, voffA); PG8_STAGE(PG8_SA(0, 1), cA + hstep, voffA);
        if (wr == 1) PG8_BAR;
        PG8_WAIT_V(2); PG8_BAR;
        PG8_STAGE(PG8_SB(1, 0), cB + kstep, voffB); PG8_STAGE(PG8_SA(1, 0), cA + kstep, voffA); PG8_STAGE(PG8_SB(1, 1), cB + hstep + kstep, voffB);
        PG8_WAIT_V(6); PG8_BAR;
    } else {
        PG8_STAGE(PG8_SB(0, 0), cB, voffB); PG8_STAGE(PG8_SA(0, 0), cA, voffA); PG8_STAGE(PG8_SB(0, 1), cB + hstep, voffB); PG8_STAGE(PG8_SA(0, 1), cA + hstep, voffA);
        if (wr == 1) PG8_BAR;
        PG8_WAIT_V(4); PG8_BAR;
        PG8_STAGE(PG8_SB(1, 0), cB + kstep, voffB); PG8_STAGE(PG8_SA(1, 0), cA + kstep, voffA); PG8_STAGE(PG8_SB(1, 1), cB + hstep + kstep, voffB);
        PG8_WAIT_V(6); PG8_BAR;
    }
    for (;;) {
        const bool has_next = S.next(ui + 1, nxt);
        const char* nA = has_next ? (const char*)g.A + (size_t)nxt.pm * tstep : cA; const char* nB = has_next ? (const char*)g.Bt + (size_t)nxt.pn * tstep : cB;
        for (int t = 0; t < nt; t += 2) {
            const bool last = (t == nt - 2);
            const char* a1 = cA + (size_t)(t + 1) * kstep;
            const char* a2 = last ? nA : cA + (size_t)(t + 2) * kstep; const char* b2 = last ? nB : cB + (size_t)(t + 2) * kstep;
            const char* a3 = a2 + kstep; const char* b3 = b2 + kstep;
            if (last && has_next) S.a_ready(nxt);
            if constexpr (SP2) {
            PG8_LDB(B0, 0, 0); PG8_LDB(B1, 0, 1); PG8_SCHED; PG8_LDA(At, 0, 0); PG8_STAGE(PG8_SA(1, 1), a1 + hstep, voffA);
            PG8_WAIT_V(8); PG8_WAIT_L(0); PG8_BAR; PG8_MMA(0, 0, At, B0); PG8_MMA(0, 1, At, B1); PG8_BAR; PG8_SCHED;
            PG8_LDA(At, 0, 1); PG8_STAGE(PG8_SB(0, 0), b2, voffB); PG8_STAGE(PG8_SB(0, 1), b2 + hstep, voffB); PG8_STAGE(PG8_SA(0, 0), a2, voffA);
            PG8_WAIT_V(8); PG8_WAIT_L(0); PG8_BAR; PG8_MMA(1, 0, At, B0); PG8_MMA(1, 1, At, B1); PG8_BAR; PG8_SCHED;
            PG8_LDB(B0, 1, 0); PG8_LDB(B1, 1, 1); PG8_SCHED; PG8_LDA(At, 1, 0); PG8_STAGE(PG8_SA(0, 1), a2 + hstep, voffA);
            PG8_WAIT_V(8); PG8_WAIT_L(0); PG8_BAR; PG8_MMA(0, 0, At, B0); PG8_MMA(0, 1, At, B1); PG8_BAR; PG8_SCHED;
            PG8_LDA(At, 1, 1); PG8_STAGE(PG8_SB(1, 0), b3, voffB); PG8_STAGE(PG8_SB(1, 1), b3 + hstep, voffB); PG8_STAGE(PG8_SA(1, 0), a3, voffA);
            PG8_WAIT_V(8); PG8_WAIT_L(0); PG8_BAR; PG8_MMA(1, 0, At, B0); PG8_MMA(1, 1, At, B1); PG8_BAR; PG8_SCHED;
            } else {
            PG8_LDB(B0, 0, 0); PG8_SCHED; PG8_LDA(At, 0, 0); PG8_STAGE(PG8_SA(1, 1), a1 + hstep, voffA);
            PG8_WAIT_L(8); PG8_BAR; PG8_WAIT_L(0); PG8_MMA(0, 0, At, B0); PG8_BAR; PG8_SCHED;
            PG8_LDB(B1, 0, 1); PG8_STAGE(PG8_SB(0, 0), b2, voffB);
            PG8_BAR; PG8_WAIT_L(0); PG8_MMA(0, 1, At, B1); PG8_BAR;
            PG8_LDA(At, 0, 1); PG8_STAGE(PG8_SA(0, 0), a2, voffA);
            PG8_BAR; PG8_WAIT_L(0); PG8_MMA(1, 0, At, B0); PG8_BAR; PG8_SCHED;
            PG8_STAGE(PG8_SB(0, 1), b2 + hstep, voffB);
            PG8_WAIT_V(6); PG8_BAR; PG8_MMA(1, 1, At, B1); PG8_BAR;
            PG8_LDB(B0, 1, 0); PG8_SCHED; PG8_LDA(At, 1, 0); PG8_STAGE(PG8_SA(0, 1), a2 + hstep, voffA);
            PG8_WAIT_L(8); PG8_BAR; PG8_WAIT_L(0); PG8_MMA(0, 0, At, B0); PG8_BAR; PG8_SCHED;
            PG8_LDB(B1, 1, 1); PG8_STAGE(PG8_SB(1, 0), b3, voffB);
            PG8_BAR; PG8_WAIT_L(0); PG8_MMA(0, 1, At, B1); PG8_BAR;
            PG8_LDA(At, 1, 1); PG8_STAGE(PG8_SA(1, 0), a3, voffA);
            PG8_BAR; PG8_WAIT_L(0); PG8_MMA(1, 0, At, B0); PG8_BAR; PG8_SCHED;
            PG8_STAGE(PG8_SB(1, 1), b3 + hstep, voffB);
            PG8_WAIT_V(6); PG8_BAR; PG8_MMA(1, 1, At, B1); PG8_BAR;
            }
        }
        if constexpr (ALIGN_EPI) { if (wr == 0) PG8_BAR; }
        if constexpr (!Epi::AFTER_DRAIN) { E(acc, cur, wr, wc, fr, fq); S.done(cur); }
        if (!has_next) break;
#pragma unroll
        for (int a = 0; a < 2; ++a)
#pragma unroll
            for (int b = 0; b < 2; ++b)
#pragma unroll
                for (int m = 0; m < 4; ++m)
#pragma unroll
                    for (int n = 0; n < 2; ++n) acc[a][b][m][n] = (f32x4){0.f, 0.f, 0.f, 0.f};
        cur = nxt; cA = nA; cB = nB; ++ui;
        if constexpr (ALIGN_EPI) { if (wr == 1) PG8_BAR; }
    }
    PG8_WAIT_V(0);
    if constexpr (!ALIGN_EPI) { if (wr == 0) PG8_BAR; }
    PG8_BAR;
#undef PG8_SA
#undef PG8_SB
#undef PG8_STAGE
#undef PG8_LDA
#undef PG8_LDB
#undef PG8_MMA
#undef PG8_WAIT_V
#undef PG8_WAIT_L
#undef PG8_BAR
#undef PG8_SCHED
}
}
using pg8::Unit;

DI float row_rstd16(const float* ssq, int row, int fq) {
    const f32x4 a = *(const f32x4*)(ssq + (size_t)row * 16 + fq * 4);
    const float s = quad_sum((a.x + a.y) + (a.z + a.w));
    return rsqrtf(s * (1.f / 1024.f) + EPS);
}
struct EpiInAB {
    static constexpr bool PERM = true, AFTER_DRAIN = false;
    bf16* zb; const float* ssq; float* o_cmp; float* o_sel; float* o_win;
    DI void operator()(const f32x4 (&acc)[2][2][4][2], const Unit& u, int wr, int wc, int fr, int fq) const {
#pragma unroll
        for (int ai = 0; ai < 2; ++ai)
#pragma unroll
            for (int m = 0; m < 4; ++m) {
                const int row = u.pm * 256 + ai * 128 + wr * 64 + m * 16 + fr; const float rs = row_rstd16(ssq, row, fq);
#pragma unroll
                for (int bj = 0; bj < 2; ++bj) {
                    const int cl = bj * 128 + wc * 32 + fq * 8, col = u.pn * 256 + cl;
                    const f32x4 v0 = acc[ai][bj][m][0] * rs, v1 = acc[ai][bj][m][1] * rs;
                    u32x4 w; w.x = pk2(v0[0], v0[1]); w.y = pk2(v0[2], v0[3]); w.z = pk2(v1[0], v1[1]); w.w = pk2(v1[2], v1[3]);
                    *(u32x4*)(zb + (size_t)row * ABP + col) = w;
                    if (u.pn == 10) { float* o = o_cmp + (size_t)row * 256 + cl; *(f32x4*)o = v0; *(f32x4*)(o + 4) = v1; }
                    else if (u.pn == 11) { float* o = o_sel + (size_t)row * 256 + cl; *(f32x4*)o = v0; *(f32x4*)(o + 4) = v1; }
                    else if (u.pn == 12) { const int t = row & 4095, b = row >> 12; if (t >= SEQ - 512) { float* o = o_win + ((size_t)b * 512 + (t - (SEQ - 512))) * 256 + cl; *(f32x4*)o = v0; *(f32x4*)(o + 4) = v1; } }
                }
            }
    }
};
struct EpiResid {
    static constexpr bool PERM = true, AFTER_DRAIN = false;
    const bf16* res; bf16* hb; float* ssq;
    DI void operator()(const f32x4 (&acc)[2][2][4][2], const Unit& u, int wr, int wc, int fr, int fq) const {
#pragma unroll
        for (int ai = 0; ai < 2; ++ai)
#pragma unroll
            for (int m = 0; m < 4; ++m) {
                const int row = u.pm * 256 + ai * 128 + wr * 64 + m * 16 + fr; float ss = 0.f;
#pragma unroll
                for (int bj = 0; bj < 2; ++bj) {
                    const int col = u.pn * 256 + bj * 128 + wc * 32 + fq * 8; const size_t o = (size_t)row * D + col;
                    const u32x4 r8 = *(const u32x4*)(res + o);
                    const f32x4 v0 = acc[ai][bj][m][0] + (f32x4){bflo(r8.x), bfhi(r8.x), bflo(r8.y), bfhi(r8.y)}, v1 = acc[ai][bj][m][1] + (f32x4){bflo(r8.z), bfhi(r8.z), bflo(r8.w), bfhi(r8.w)};
                    u32x4 w; w.x = pk2(v0[0], v0[1]); w.y = pk2(v0[2], v0[3]); w.z = pk2(v1[0], v1[1]); w.w = pk2(v1[2], v1[3]);
                    *(u32x4*)(hb + o) = w;
                    ss += (v0[0] * v0[0] + v0[1] * v0[1]) + (v0[2] * v0[2] + v0[3] * v0[3]) + (v1[0] * v1[0] + v1[1] * v1[1]) + (v1[2] * v1[2] + v1[3] * v1[3]);
                }
                ss = quad_sum(ss);
                if (fq == 0) ssq[(size_t)row * 16 + u.pn * 4 + wc] = ss;
            }
    }
};
struct EpiFFN1 {
    static constexpr bool PERM = true, AFTER_DRAIN = false;
    bf16* hff; const float* ssq;
    DI void operator()(const f32x4 (&acc)[2][2][4][2], const Unit& u, int wr, int wc, int fr, int fq) const {
#pragma unroll
        for (int ai = 0; ai < 2; ++ai)
#pragma unroll
            for (int m = 0; m < 4; ++m) {
                const int row = u.pm * 256 + ai * 128 + wr * 64 + m * 16 + fr; const float rs = row_rstd16(ssq, row, fq);
#pragma unroll
                for (int bj = 0; bj < 2; ++bj) {
                    const int col = u.pn * 256 + bj * 128 + wc * 32 + fq * 8;
                    f32x4 v0 = acc[ai][bj][m][0] * rs, v1 = acc[ai][bj][m][1] * rs;
#pragma unroll
                    for (int i = 0; i < 4; ++i) { const float a = fmaxf(v0[i], 0.f), b = fmaxf(v1[i], 0.f); v0[i] = a * a; v1[i] = b * b; }
                    u32x4 w; w.x = pk2(v0[0], v0[1]); w.y = pk2(v0[2], v0[3]); w.z = pk2(v1[0], v1[1]); w.w = pk2(v1[2], v1[3]);
                    *(u32x4*)(hff + (size_t)row * FF + col) = w;
                }
            }
    }
};
struct EpiInC {
    static constexpr bool PERM = true, AFTER_DRAIN = false;
    bf16* ub; bf16* vb; const float* ssq; float* vstat;
    DI void operator()(const f32x4 (&acc)[2][2][4][2], const Unit& u, int wr, int wc, int fr, int fq) const {
        const bool isv = u.pn >= 4; bf16* dst = isv ? vb : ub; const int pn = isv ? u.pn - 4 : u.pn;
#pragma unroll
        for (int ai = 0; ai < 2; ++ai)
#pragma unroll
            for (int m = 0; m < 4; ++m) {
                const int row = u.pm * 256 + ai * 128 + wr * 64 + m * 16 + fr; const float rs = row_rstd16(ssq, row, fq); float s1 = 0.f, s2 = 0.f;
#pragma unroll
                for (int bj = 0; bj < 2; ++bj) {
                    const int col = pn * 256 + bj * 128 + wc * 32 + fq * 8;
                    f32x4 v0 = acc[ai][bj][m][0] * rs, v1 = acc[ai][bj][m][1] * rs;
#pragma unroll
                    for (int i = 0; i < 4; ++i) { v0[i] = gelu_tanh(v0[i]); v1[i] = gelu_tanh(v1[i]); s1 += v0[i] + v1[i]; s2 += v0[i] * v0[i] + v1[i] * v1[i]; }
                    u32x4 w; w.x = pk2(v0[0], v0[1]); w.y = pk2(v0[2], v0[3]); w.z = pk2(v1[0], v1[1]); w.w = pk2(v1[2], v1[3]);
                    *(u32x4*)(dst + (size_t)row * D + col) = w;
                }
                if (isv) { s1 = quad_sum(s1); s2 = quad_sum(s2);
                    if (fq == 0) *(f32x2*)(vstat + ((size_t)row * 16 + pn * 4 + wc) * 2) = (f32x2){s1, s2}; }
            }
    }
};

DI unsigned* ctl_words();
DI void publish_count(int idx) {
    asm volatile("s_waitcnt vmcnt(0)" ::: "memory");
    __syncthreads();
    if (threadIdx.x == 0) { __builtin_amdgcn_fence(__ATOMIC_RELEASE, "agent"); asm volatile("s_waitcnt vmcnt(0)" ::: "memory");
        __hip_atomic_fetch_add(ctl_words() + 4096 + 64 * idx, 1u, __ATOMIC_RELAXED, __HIP_MEMORY_SCOPE_AGENT); }
}
DI void wait_count(int idx, unsigned n) {
    if (threadIdx.x == 0) { unsigned* c = ctl_words() + 4096 + 64 * idx; unsigned sp = 0;
        while (__hip_atomic_load(c, __ATOMIC_RELAXED, __HIP_MEMORY_SCOPE_AGENT) < n) { __builtin_amdgcn_s_sleep(2); if (++sp > (1u << 22)) break; }
        __builtin_amdgcn_fence(__ATOMIC_ACQUIRE, "agent"); asm volatile("s_waitcnt vmcnt(0)" ::: "memory"); }
    __syncthreads();
}
DI float dot8sq(bf16x8 x) { const u32x4 u = __builtin_bit_cast(u32x4, x); float s = 0.f;
#pragma unroll
    for (int i = 0; i < 4; ++i) { const float a = bflo(u[i]), b = bfhi(u[i]); s += a * a + b * b; }
    return s; }
template <bool NORM, int KS, class Epi>
DI void skinny_gemm(unsigned char* lds, const bf16* A, int lda, const bf16* Wt, int N, int bid, int G, const Epi& E) {
    constexpr int K = KS * 32 * 8;
    float* red = (float*)lds; float* sred = red + 8 * 2 * 64 * 4;
    const int tid = otid(), wave = tid >> 6, lane = tid & 63, r16 = lane & 15, quad = lane >> 4, ksl = KS * 32;
    for (int task = bid; task < (N >> 4); task += G) {
        const int n0 = task * 16;
        f32x4 acc0 = {0.f, 0.f, 0.f, 0.f}, acc1 = {0.f, 0.f, 0.f, 0.f}; float ss0 = 0.f, ss1 = 0.f;
        const bf16* wrow = Wt + (size_t)(n0 + r16) * K + wave * ksl + quad * 8;
        const bf16* a0 = A + (size_t)r16 * lda + wave * ksl + quad * 8; const bf16* a1 = a0 + (size_t)16 * lda;
#pragma unroll
        for (int k0 = 0; k0 < KS; k0 += 8) {
            constexpr int NB = (KS < 8) ? KS : 8;
            bf16x8 bq[NB], x0[NB], x1[NB];
#pragma unroll
            for (int u = 0; u < NB; ++u) { bq[u] = *(const bf16x8*)(wrow + (k0 + u) * 32); x0[u] = *(const bf16x8*)(a0 + (k0 + u) * 32); x1[u] = *(const bf16x8*)(a1 + (k0 + u) * 32); }
#pragma unroll
            for (int u = 0; u < NB; ++u) { if (NORM) { ss0 += dot8sq(x0[u]); ss1 += dot8sq(x1[u]); } acc0 = MFMA16(x0[u], bq[u], acc0); acc1 = MFMA16(x1[u], bq[u], acc1); }
        }
        if (NORM) { ss0 = quad_sum(ss0); ss1 = quad_sum(ss1); if (quad == 0) { sred[wave * 32 + r16] = ss0; sred[wave * 32 + 16 + r16] = ss1; } }
        *(f32x4*)(red + ((wave * 2 + 0) * 64 + lane) * 4) = acc0; *(f32x4*)(red + ((wave * 2 + 1) * 64 + lane) * 4) = acc1;
        __syncthreads();
        if (tid < 128) {
            const int rt = tid >> 6, l = tid & 63; f32x4 s = {0.f, 0.f, 0.f, 0.f};
#pragma unroll
            for (int w = 0; w < 8; ++w) s += *(const f32x4*)(red + ((w * 2 + rt) * 64 + l) * 4);
#pragma unroll
            for (int i = 0; i < 4; ++i) { const int row = rt * 16 + (l >> 4) * 4 + i, col = n0 + (l & 15); float sc = 1.f;
                if (NORM) { float q = 0.f;
#pragma unroll
                    for (int w = 0; w < 8; ++w) q += sred[w * 32 + row];
                    sc = rsqrtf(q / (float)K + EPS); }
                E(row, col, s[i] * sc); }
        }
        __syncthreads();
    }
}
struct SEpiInAB { float* zs; float* o_cmp; float* o_sel;
    DI void operator()(int row, int col, float v) const { zs[row * ABP + col] = v; if (col >= C_CMP && col < C_SEL) o_cmp[row * 256 + col - C_CMP] = v; else if (col >= C_SEL && col < C_WIN) o_sel[row * 256 + col - C_SEL] = v; } };
struct SEpiResid { float* hs; bf16* hsb; DI void operator()(int row, int col, float v) const { const float r = hs[row * D + col] + v; hs[row * D + col] = r; hsb[row * D + col] = f2bf(r); } };
struct SEpiFFN1 { bf16* h; DI void operator()(int row, int col, float v) const { const float a = fmaxf(v, 0.f); h[row * FF + col] = f2bf(a * a); } };
struct SEpiInC { float* uv; DI void operator()(int row, int col, float v) const { uv[row * 2048 + col] = gelu_tanh(v); } };

#define XB_TMO      128
#define XB_XCNT(j)  (256  + 64 * (j))
#define XB_XSUB(j)  (1280 + 64 * (j))
#define XB_XGEN(j)  (2304 + 64 * (j))
#define XB_TOP      3328
#define XB_TOPGEN   3392
#define XCD_BAR_WORDS 3456
#define XB_SPIN_CAP (1u << 18)
__device__ __forceinline__ unsigned xb_ld(unsigned* p)              { return __hip_atomic_load(p, __ATOMIC_RELAXED, __HIP_MEMORY_SCOPE_AGENT); }
__device__ __forceinline__ unsigned xb_add(unsigned* p, unsigned v) { return __hip_atomic_fetch_add(p, v, __ATOMIC_RELAXED, __HIP_MEMORY_SCOPE_AGENT); }
__device__ __forceinline__ unsigned xb_xcc_id() { return (unsigned)__builtin_amdgcn_s_getreg((3 << 11) | 20) & 0xFu; }
#define XB_SPIN(cond, bar) do { unsigned _sp = 0; while (cond) { __builtin_amdgcn_s_sleep(1); \
    if ((++_sp & 255u) == 0u) { if (xb_ld(&(bar)[XB_TMO])) break; if (_sp > XB_SPIN_CAP) { atomicAdd(&(bar)[XB_TMO], 1u); break; } } } } while (0)
struct XcdBarrier { unsigned* bar; unsigned x; volatile LAS unsigned* st; };
__device__ __forceinline__ XcdBarrier xcd_barrier_post(unsigned* bar, volatile LAS unsigned* st) {
    XcdBarrier b; b.bar = bar; b.x = xb_xcc_id(); b.st = st;
    if (threadIdx.x == 0) (void)xb_add(&bar[XB_XCNT(b.x)], 1u);
    return b;
}
__device__ __forceinline__ void xcd_barrier_complete(unsigned* bar, unsigned x, unsigned& nloc, unsigned& nx) {
    const unsigned G = gridDim.x * gridDim.y * gridDim.z;
    unsigned sum, cnt, mine, sp = 0u;
    for (;;) {
        sum = 0u; cnt = 0u; mine = 0u;
#pragma unroll
        for (unsigned j = 0; j < 16; ++j) { const unsigned c = xb_ld(&bar[XB_XCNT(j)]); sum += c; cnt += (c > 0u) ? 1u : 0u; mine = (j == x) ? c : mine; }
        if (sum == G) break;
        __builtin_amdgcn_s_sleep(1);
        if ((++sp & 255u) == 0u) { if (xb_ld(&bar[XB_TMO])) break; if (sp > XB_SPIN_CAP) { atomicAdd(&bar[XB_TMO], 1u); break; } }
    }
    nloc = mine > 0u ? mine : 1u; nx = cnt > 0u ? cnt : 1u;
}
__device__ __forceinline__ void xcd_barrier(const XcdBarrier& b) {
    asm volatile("s_waitcnt vmcnt(0)" ::: "memory");
    __syncthreads();
    if (threadIdx.x == 0) {
        unsigned* bar = b.bar;
        __builtin_amdgcn_s_waitcnt(0);
        unsigned nloc = b.st[0], nx = b.st[1];
        if (nloc == 0u) { xcd_barrier_complete(bar, b.x, nloc, nx); b.st[0] = nloc; b.st[1] = nx; }
        const unsigned old = xb_add(&bar[XB_XSUB(b.x)], 1u);
        const unsigned gen = old / nloc;
        if (old + 1u == (gen + 1u) * nloc) {
            __builtin_amdgcn_fence(__ATOMIC_RELEASE, "agent");
            asm volatile("s_waitcnt vmcnt(0)" ::: "memory");
            const unsigned og = xb_add(&bar[XB_TOP], 1u);
            const unsigned tg = og / nx;
            if (og + 1u == (tg + 1u) * nx) xb_add(&bar[XB_TOPGEN], 1u);
            else XB_SPIN(xb_ld(&bar[XB_TOPGEN]) == tg, bar);
            __builtin_amdgcn_fence(__ATOMIC_ACQUIRE, "agent");
            xb_add(&bar[XB_XGEN(b.x)], 1u);
            asm volatile("s_waitcnt vmcnt(0)" ::: "memory");
        } else {
            XB_SPIN(xb_ld(&bar[XB_XGEN(b.x)]) == gen, bar);
            __builtin_amdgcn_fence(__ATOMIC_ACQUIRE, "agent");
            asm volatile("s_waitcnt vmcnt(0)" ::: "memory");
        }
    }
    __syncthreads();
}

DI void transpose_item(const float* W, int K, int N, bf16* WT, const float* gain, float* scr, int item, int nblk, int lane) {
    const int kb = item / nblk, nb = item % nblk, k0 = 64 * kb, n0 = 64 * nb;
    const int kr = lane >> 4, nc = (lane & 15) * 4; const bool ok = (n0 + nc) < N;
    f32x4 v[16];
#pragma unroll
    for (int i = 0; i < 16; ++i) v[i] = ok ? *(const f32x4*)(W + (size_t)(k0 + 4 * i + kr) * N + n0 + nc) : (f32x4){0.f, 0.f, 0.f, 0.f};
#pragma unroll
    for (int i = 0; i < 16; ++i) { const int kk = 4 * i + kr; f32x4 x = v[i]; if (gain) x = x * gain[k0 + kk]; *(f32x4*)(scr + kk * 68 + nc) = x; }
    asm volatile("s_waitcnt lgkmcnt(0)" ::: "memory");
    const int c = lane & 7;
#pragma unroll
    for (int j = 0; j < 8; ++j) { const int nn = (lane >> 3) + 8 * j; const float* s = scr + (8 * c) * 68 + nn;
        u32x4 o; o.x = pk2(s[0 * 68], s[1 * 68]); o.y = pk2(s[2 * 68], s[3 * 68]); o.z = pk2(s[4 * 68], s[5 * 68]); o.w = pk2(s[6 * 68], s[7 * 68]);
        *(u32x4*)(WT + (size_t)(n0 + nn) * K + k0 + 8 * c) = o; }
    asm volatile("s_waitcnt lgkmcnt(0)" ::: "memory");
}

struct Args { const void* in[25]; float* out; unsigned char* ws; int ph_lo, ph_hi; };
struct Ptrs {
    const float *x_prompt, *x_sample, *cache_cmp, *cache_sel, *state_win, *state_hgrn; const int* page_table;
    const float *norm_mix, *norm_ffn, *norm_final, *w_in_ab, *w_out_ab, *hgrn_lb, *hgrn_norm, *cmp_pe, *cmp_w1, *cmp_w2, *w_in_c, *ln_c_g, *ln_c_b, *w_s, *b_s, *w_out_c, *w_ffn1, *w_ffn2;
    float* out; unsigned char* ws;
};
typedef const __attribute__((address_space(4))) Args* KArgs;
DI Ptrs get_ptrs() {
    KArgs a = (KArgs)__builtin_amdgcn_kernarg_segment_ptr(); asm volatile("" : "+s"(a));
    Ptrs P;
    P.x_prompt = (const float*)a->in[0]; P.x_sample = (const float*)a->in[1]; P.cache_cmp = (const float*)a->in[2]; P.cache_sel = (const float*)a->in[3];
    P.state_win = (const float*)a->in[4]; P.state_hgrn = (const float*)a->in[5]; P.page_table = (const int*)a->in[6];
    P.norm_mix = (const float*)a->in[7]; P.norm_ffn = (const float*)a->in[8]; P.norm_final = (const float*)a->in[9]; P.w_in_ab = (const float*)a->in[10]; P.w_out_ab = (const float*)a->in[11];
    P.hgrn_lb = (const float*)a->in[12]; P.hgrn_norm = (const float*)a->in[13]; P.cmp_pe = (const float*)a->in[14]; P.cmp_w1 = (const float*)a->in[15]; P.cmp_w2 = (const float*)a->in[16];
    P.w_in_c = (const float*)a->in[17]; P.ln_c_g = (const float*)a->in[18]; P.ln_c_b = (const float*)a->in[19]; P.w_s = (const float*)a->in[20]; P.b_s = (const float*)a->in[21];
    P.w_out_c = (const float*)a->in[22]; P.w_ffn1 = (const float*)a->in[23]; P.w_ffn2 = (const float*)a->in[24]; P.out = a->out; P.ws = a->ws;
    return P;
}

DI unsigned* ctl_words() { return (unsigned*)(get_ptrs().ws + WS_CTL); }
DI void prologue(unsigned char* lds, int bid, int G) {
    const Ptrs P = get_ptrs();
    const int tid = otid(), wave = tid >> 6, lane = tid & 63;
    float* scr = (float*)lds + wave * (64 * 68);
    const int gw = bid * 8 + wave, NGW = G * 8;
    unsigned char* ws = P.ws;
    for (int t = bid; t < 128; t += G) {
        const int q = t >> 5, part = t & 31;
        float* part_l = (float*)lds + 8 * 64 * 68;
        const float* pe = P.cmp_pe + (size_t)q * 2048 + part * 64 + wave * 8; const float* w1 = P.cmp_w1 + ((size_t)q * 2048 + part * 64 + wave * 8) * 128;
        float a0 = 0.f, a1 = 0.f;
#pragma unroll
        for (int f = 0; f < 8; ++f) { const float p = pe[f]; a0 += p * w1[(size_t)f * 128 + lane]; a1 += p * w1[(size_t)f * 128 + 64 + lane]; }
        part_l[wave * 128 + lane] = a0; part_l[wave * 128 + 64 + lane] = a1;
        __syncthreads();
        if (tid < 128) { float s = 0.f; for (int w = 0; w < 8; ++w) s += part_l[w * 128 + tid]; ((float*)(ws + WS_SMALL + 8192))[(size_t)t * 128 + tid] = s; }
        publish_count(980 + q);
    }
    constexpr int I_INAB = 16 * 56, I_OUTAB = 16 * 16, I_INC = 16 * 32, I_OUTC = 16 * 16, I_F1 = 16 * 64, I_F2 = 64 * 16, I_C1 = 32 * 2, I_C2 = 2 * 1;
    constexpr int NITEMS = 2 * (I_INAB + I_OUTAB + I_INC + I_OUTC) + 4 * (I_F1 + I_F2) + 4 * I_C1;
    for (int it = gw; it < NITEMS; it += NGW) {
        int r = it;
        if (r < 4 * I_F1) { const int l = r / I_F1; transpose_item(P.w_ffn1 + (size_t)l * D * FF, D, FF, (bf16*)(ws + WS_WF1) + (size_t)l * FF * D, P.norm_ffn + l * D, scr, r % I_F1, 64, lane); continue; } r -= 4 * I_F1;
        if (r < 4 * I_F2) { const int l = r / I_F2; transpose_item(P.w_ffn2 + (size_t)l * FF * D, FF, D, (bf16*)(ws + WS_WF2) + (size_t)l * D * FF, nullptr, scr, r % I_F2, 16, lane); continue; } r -= 4 * I_F2;
        if (r < 2 * I_INAB) { const int j = r / I_INAB; transpose_item(P.w_in_ab + (size_t)j * D * ABC, D, ABC, (bf16*)(ws + WS_WINAB) + (size_t)j * ABP * D, P.norm_mix + (2 * j) * D, scr, r % I_INAB, 56, lane); continue; } r -= 2 * I_INAB;
        if (r < 2 * I_OUTAB) { const int j = r / I_OUTAB; transpose_item(P.w_out_ab + (size_t)j * D * D, D, D, (bf16*)(ws + WS_WOUTAB) + (size_t)j * D * D, nullptr, scr, r % I_OUTAB, 16, lane); continue; } r -= 2 * I_OUTAB;
        if (r < 2 * I_INC) { const int j = r / I_INC; transpose_item(P.w_in_c + (size_t)j * D * 2048, D, 2048, (bf16*)(ws + WS_WINC) + (size_t)j * 2048 * D, P.norm_mix + (2 * j + 1) * D, scr, r % I_INC, 32, lane); continue; } r -= 2 * I_INC;
        if (r < 2 * I_OUTC) { const int j = r / I_OUTC; transpose_item(P.w_out_c + (size_t)j * D * D, D, D, (bf16*)(ws + WS_WOUTC) + (size_t)j * D * D, nullptr, scr, r % I_OUTC, 16, lane); continue; } r -= 2 * I_OUTC;
        { const int q = r / I_C1; transpose_item(P.cmp_w1 + (size_t)q * 2048 * 128, 2048, 128, (bf16*)(ws + WS_WC1) + (size_t)q * 128 * 2048, nullptr, scr, r % I_C1, 2, lane); }
    }
    for (int r = (G - 1 - bid) * 8 + wave; r < 4 * I_C2; r += NGW) { const int q = r / I_C2; transpose_item(P.cmp_w2 + (size_t)q * 128 * 64, 128, 64, (bf16*)(ws + WS_WC2) + (size_t)q * 64 * 128, nullptr, scr, r % I_C2, 1, lane); }
    {
        bf16* hb = (bf16*)(ws + WS_HB); float* ssq = (float*)(ws + WS_SSQ);
        for (int m = gw; m < MP; m += NGW) {
            const f32x4* xr = (const f32x4*)(P.x_prompt + (size_t)m * D) + lane; float s = 0.f; u64* o8 = (u64*)(hb + (size_t)m * D) + lane;
#pragma unroll
            for (int j = 0; j < 4; ++j) { const f32x4 v = xr[64 * j]; s += (v.x * v.x + v.y * v.y) + (v.z * v.z + v.w * v.w); o8[64 * j] = (u64)pk2(v.x, v.y) | ((u64)pk2(v.z, v.w) << 32); }
            s = wave_sum(s);
            if (lane < 16) ssq[(size_t)m * 16 + lane] = (lane == 0) ? s : 0.f;
        }
    }
    { float* hs = (float*)(ws + WS_SMP + SMP_HS); bf16* hsb = (bf16*)(ws + WS_SMP + SMP_HSB); for (int i = bid * 512 + tid; i < DB * D; i += G * 512) { const float v = P.x_sample[i]; hs[i] = v; hsb[i] = f2bf(v); } }
    { float* lbs = (float*)(ws + WS_SMALL);
      for (int i = bid * 512 + tid; i < 512; i += G * 512) { const float a = P.hgrn_lb[i], b = P.hgrn_lb[512 + i], mx = fmaxf(a, b), ea = __expf(a - mx), eb = __expf(b - mx); lbs[i] = 0.f; lbs[512 + i] = eb / (ea + eb); } }
    { bf16* tr = (bf16*)(ws + WS_TRIL);
      for (int i = bid * 512 + tid; i < 2 * 8 * 128 * 128; i += G * 512) { const int s = i & 127, t = (i >> 7) & 127; tr[i] = (s <= t) ? f2bf(P.w_s[i]) : (bf16)0; } }
    {
        float* cb = (float*)(ws + WS_SMALL + 4096);
        for (int q = G - 2 - bid; q >= 0 && q < 4; q += G) {
            wait_count(980 + q, 32u);
            if (tid < 128) { const float* cbp = (const float*)(ws + WS_SMALL + 8192) + (size_t)q * 32 * 128 + tid; float s = 0.f;
#pragma unroll 8
                for (int p = 0; p < 32; ++p) s += __builtin_nontemporal_load(cbp + p * 128);
                cb[q * 128 + tid] = s; }
        }
    }
}

template <bool SAMPLE>
DI void compress_unit(unsigned char* lds, int j, int b, int ub, int ncmp, int L, int kv_lo, int kv_hi) {
    const Ptrs P = get_ptrs();
    const int tid = otid(), wave = tid >> 6, lane = tid & 63, r16 = lane & 15, quad = lane >> 4;
    unsigned char* rowsL = lds; bf16* hid = (bf16*)(lds + 135168);
    int* pg = (int*)(lds + 135168 + 17408);
    const bf16* w1t = (const bf16*)(P.ws + WS_WC1) + (size_t)j * 2 * 128 * 2048; const bf16* w2t = (const bf16*)(P.ws + WS_WC2) + (size_t)j * 2 * 64 * 128;
    const float* cb = (const float*)(P.ws + WS_SMALL + 4096) + j * 256;
    const int n0 = ub * 32, row0 = n0 * 16;
    if (SAMPLE) { if (tid < 5) { const int pi = (row0 >> 7) + tid; pg[tid] = (pi < NPAGES) ? P.page_table[b * NPAGES + pi] : 0; } __syncthreads(); }
    for (int kv = kv_lo; kv < kv_hi; ++kv) {
        {
            f32x4 fa[17], fc[17]; u32x4 w[17];
#pragma unroll
            for (int u = 0; u < 17; ++u) { const int idx = u * 512 + tid, row = idx >> 4, ch = idx & 15, sr = row0 + row; const bool ok = (u < 16 || tid < 256) && (sr < L);
                if (SAMPLE) { const float* src = P.cache_cmp + (((size_t)j * NPOOL + (ok ? pg[row >> 7] : 0)) * 128 + (sr & 127)) * 256 + kv * 128 + ch * 8;
                    fa[u] = ok ? *(const f32x4*)src : (f32x4){0.f, 0.f, 0.f, 0.f}; fc[u] = ok ? *(const f32x4*)(src + 4) : (f32x4){0.f, 0.f, 0.f, 0.f};
                } else w[u] = ok ? *(const u32x4*)((const bf16*)(P.ws + WS_ZB) + ((size_t)b * SEQ + sr) * ABP + C_CMP + kv * 128 + ch * 8) : (u32x4){0u, 0u, 0u, 0u}; }
#pragma unroll
            for (int u = 0; u < 17; ++u) { const int idx = u * 512 + tid, row = idx >> 4, ch = idx & 15;
                if (SAMPLE) { w[u].x = pk2(fa[u].x, fa[u].y); w[u].y = pk2(fa[u].z, fa[u].w); w[u].z = pk2(fc[u].x, fc[u].y); w[u].w = pk2(fc[u].z, fc[u].w); }
                if (u < 16 || tid < 256) *(u32x4*)(rowsL + row * 256 + ((ch ^ ((row >> 4) & 15)) << 4)) = w[u]; }
        }
        __syncthreads();
        f32x4 acc[2][2];
#pragma unroll
        for (int g = 0; g < 2; ++g) { acc[g][0] = (f32x4){0.f, 0.f, 0.f, 0.f}; acc[g][1] = (f32x4){0.f, 0.f, 0.f, 0.f}; }
        const bf16* wp = w1t + ((size_t)kv * 128 + wave * 16 + r16) * 2048 + quad * 8;
        bf16x8 bq[2][8];
#pragma unroll
        for (int u = 0; u < 8; ++u) bq[0][u] = *(const bf16x8*)(wp + u * 32);
#pragma unroll
        for (int bt8 = 0; bt8 < 8; ++bt8) {
            if (bt8 + 1 < 8) {
#pragma unroll
                for (int u = 0; u < 8; ++u) bq[(bt8 + 1) & 1][u] = *(const bf16x8*)(wp + ((bt8 + 1) * 8 + u) * 32); }
#pragma unroll
            for (int u = 0; u < 8; ++u) { const int ks = bt8 * 8 + u, r = ks >> 1, c0 = (ks & 1) * 4 + quad, sw = (r16 + (r >> 4)) & 15;
#pragma unroll
                for (int bt = 0; bt < 2; ++bt) { const int row = 256 * bt + 16 * r16 + r;
#pragma unroll
                    for (int g = 0; g < 2; ++g) { const bf16x8 a = *(const bf16x8*)(rowsL + row * 256 + (((g * 8 + c0) ^ sw) << 4)); acc[g][bt] = MFMA16(a, bq[bt8 & 1][u], acc[g][bt]); } } }
        }
#pragma unroll
        for (int g = 0; g < 2; ++g)
#pragma unroll
            for (int bt = 0; bt < 2; ++bt)
#pragma unroll
                for (int i = 0; i < 4; ++i) { const int h = wave * 16 + r16; hid[(g * 32 + bt * 16 + quad * 4 + i) * 136 + h] = f2bf(gelu_tanh(acc[g][bt][i] + cb[kv * 128 + h])); }
        __syncthreads();
        { const int rt = wave >> 1, g2 = rt >> 1; f32x4 a2[2] = {{0.f, 0.f, 0.f, 0.f}, {0.f, 0.f, 0.f, 0.f}};
#pragma unroll
          for (int ks = 0; ks < 4; ++ks) { const bf16x8 a = *(const bf16x8*)(hid + (rt * 16 + r16) * 136 + ks * 32 + quad * 8);
#pragma unroll
              for (int x = 0; x < 2; ++x) { const int ct = (wave & 1) * 2 + x; const bf16x8 bfr = *(const bf16x8*)(w2t + ((size_t)kv * 64 + ct * 16 + r16) * 128 + ks * 32 + quad * 8); a2[x] = MFMA16(a, bfr, a2[x]); } }
#pragma unroll
          for (int x = 0; x < 2; ++x)
#pragma unroll
              for (int i = 0; i < 4; ++i) { const int n = n0 + (rt & 1) * 16 + quad * 4 + i, d = ((wave & 1) * 2 + x) * 16 + r16;
                  if (n < ncmp) { if (SAMPLE) ((float*)(P.ws + WS_KCS))[(((size_t)b * 512 + n) * 4 + kv * 2 + g2) * 64 + d] = a2[x][i];
                                  else ((bf16*)(P.ws + WS_KCP))[(((size_t)b * 256 + n) * 4 + kv * 2 + g2) * 64 + d] = f2bf(a2[x][i]); } }
        }
        __syncthreads();
    }
}

DI void hgrn_p1_unit(unsigned char* lds, int j, int b, int c, int h) {
    const Ptrs P = get_ptrs();
    const int tid = otid(), wave = tid >> 6, lane = tid & 63, r16 = lane & 15, quad = lane >> 4;
    float* bl = (float*)lds; float* kk = bl + 8192; bf16* Vr = (bf16*)(lds + 65536); bf16* KD = Vr + 64 * 144; float* tot = (float*)(lds + 65536 + 2 * 64 * 144 * 2);
    const bf16* zb = (const bf16*)(P.ws + WS_ZB) + ((size_t)b * SEQ + c * 64) * ABP; const float* lb = (const float*)(P.ws + WS_SMALL) + j * 512 + h * 128;
    const int unit = (b * 4 + h) * 64 + c;
    u32x4 f8[2], v8[2];
#pragma unroll
    for (int u = 0; u < 2; ++u) { const int idx = tid + 512 * u, t = idx >> 4, ch = idx & 15; f8[u] = *(const u32x4*)(zb + (size_t)t * ABP + C_F + h * 128 + ch * 8); v8[u] = *(const u32x4*)(zb + (size_t)t * ABP + C_I + h * 128 + ch * 8); }
#pragma unroll
    for (int u = 0; u < 2; ++u) { const int idx = tid + 512 * u, t = idx >> 4, ch = idx & 15;
#pragma unroll
        for (int i = 0; i < 4; ++i) { const unsigned fw = f8[u][i]; const int d = ch * 8 + 2 * i;
            { const float lbv = lb[d], fg = lbv + (1.f - lbv) * sigmoidf_(bflo(fw)); bl[t * 128 + d] = __logf(fg); kk[t * 128 + d] = 1.f - fg; }
            { const float lbv = lb[d + 1], fg = lbv + (1.f - lbv) * sigmoidf_(bfhi(fw)); bl[t * 128 + d + 1] = __logf(fg); kk[t * 128 + d + 1] = 1.f - fg; } }
        *(u32x4*)(Vr + t * 144 + ch * 8) = v8[u]; }
    __syncthreads();
    { const int seg = tid >> 7, d = tid & 127; float run = 0.f;
#pragma unroll
      for (int i = 0; i < 16; ++i) { run += bl[(seg * 16 + i) * 128 + d]; bl[(seg * 16 + i) * 128 + d] = run; }
      tot[seg * 128 + d] = run; }
    __syncthreads();
    for (int idx = tid; idx < 4096; idx += 512) { const int t = idx >> 6, d = (idx & 63) * 2, seg = t >> 4; float e0 = 0.f, e1 = 0.f;
        e0 = tot[seg * 128 + d] - bl[t * 128 + d]; e1 = tot[seg * 128 + d + 1] - bl[t * 128 + d + 1];
        for (int s = seg + 1; s < 4; ++s) { e0 += tot[s * 128 + d]; e1 += tot[s * 128 + d + 1]; }
        *(unsigned*)(KD + t * 144 + d) = pk2(kk[t * 128 + d] * __expf(e0), kk[t * 128 + d + 1] * __expf(e1)); }
    if (tid < 128) ((float*)(P.ws + WS_DL))[(size_t)unit * 128 + tid] = __expf((tot[tid] + tot[128 + tid]) + (tot[256 + tid] + tot[384 + tid]));
    __syncthreads();
    f32x4 acc[8];
#pragma unroll
    for (int nt = 0; nt < 8; ++nt) acc[nt] = (f32x4){0.f, 0.f, 0.f, 0.f};
#pragma unroll
    for (int ks = 0; ks < 2; ++ks) { const bf16x8 a = tr_frag(Vr, 144, ks * 32, wave * 16, r16, quad);
#pragma unroll
        for (int nt = 0; nt < 8; ++nt) { const bf16x8 bb = tr_frag(KD, 144, ks * 32, nt * 16, r16, quad); acc[nt] = MFMA16(a, bb, acc[nt]); } }
    float* LT = (float*)(P.ws + WS_LT) + (size_t)unit * 16384;
#pragma unroll
    for (int nt = 0; nt < 8; ++nt)
#pragma unroll
        for (int i = 0; i < 4; ++i) LT[(wave * 16 + quad * 4 + i) * 128 + nt * 16 + r16] = acc[nt][i];
    __syncthreads();
}
DI void hgrn_scan_item(int j, int item) {
    const Ptrs P = get_ptrs();
    float* LT = (float*)(P.ws + WS_LT); const float* DL = (const float*)(P.ws + WS_DL);
    { const int gi = item * 512 + otid();
        const int bh = gi >> 12, q4 = gi & 4095, e = q4 >> 5, d4 = (q4 & 31) * 4;
        float* p = LT + (size_t)bh * 64 * 16384 + q4 * 4; const float* dp = DL + (size_t)bh * 64 * 128 + d4;
        f32x4 S = {0.f, 0.f, 0.f, 0.f};
        for (int c0 = 0; c0 < 64; c0 += 16) {
            f32x4 Lv[16], dv[16];
#pragma unroll
            for (int u = 0; u < 16; ++u) { Lv[u] = *(const f32x4*)(p + (size_t)(c0 + u) * 16384); dv[u] = *(const f32x4*)(dp + (c0 + u) * 128); }
#pragma unroll
            for (int u = 0; u < 16; ++u) { *(f32x4*)(p + (size_t)(c0 + u) * 16384) = S; S = dv[u] * S + Lv[u]; }
        }
        float* o = P.out + O_HG_P + ((size_t)j * 16 + bh) * 16384;
#pragma unroll
        for (int i = 0; i < 4; ++i) o[(d4 + i) * 128 + e] = S[i];
    }
    asm volatile("s_waitcnt vmcnt(0)" ::: "memory");
    __syncthreads();
    if (threadIdx.x == 0) { __builtin_amdgcn_fence(__ATOMIC_RELEASE, "agent"); asm volatile("s_waitcnt vmcnt(0)" ::: "memory");
        __hip_atomic_fetch_add((unsigned*)(P.ws + WS_CTL) + 4096 + 64 * (120 + j), 1u, __ATOMIC_RELAXED, __HIP_MEMORY_SCOPE_AGENT); }
}
DI void scan_wait(int j) {
    const Ptrs P = get_ptrs();
    if (threadIdx.x == 0) { unsigned* c = (unsigned*)(P.ws + WS_CTL) + 4096 + 64 * (120 + j); unsigned sp = 0;
        while (__hip_atomic_load(c, __ATOMIC_RELAXED, __HIP_MEMORY_SCOPE_AGENT) < 128u) { __builtin_amdgcn_s_sleep(2); if (++sp > (1u << 22)) break; }
        __builtin_amdgcn_fence(__ATOMIC_ACQUIRE, "agent"); asm volatile("s_waitcnt vmcnt(0)" ::: "memory"); }
    __syncthreads();
}
DI void hgrn_p3_unit(unsigned char* lds, int j, int b, int c, int h) {
    const Ptrs P = get_ptrs();
    const int tid = otid(), wave = tid >> 6, lane = tid & 63, r16 = lane & 15, quad = lane >> 4;
    float* bl = (float*)lds; unsigned char* Sb = lds;
    bf16* Qt = (bf16*)(lds + 32768); bf16* Qh = Qt + 64 * 136; bf16* Kt = Qh + 64 * 136; bf16* Vr = Kt + 160 * 136; bf16* att = Vr + 64 * 144; float* tot = (float*)(att + 64 * 72);
    float* obuf = (float*)Kt;
    const bf16* zb = (const bf16*)(P.ws + WS_ZB) + ((size_t)b * SEQ + c * 64) * ABP; const float* lb = (const float*)(P.ws + WS_SMALL) + j * 512 + h * 128;
    const int unit = (b * 4 + h) * 64 + c;
    u32x4 f8[2], v8[2], q8[2];
#pragma unroll
    for (int u = 0; u < 2; ++u) { const int idx = tid + 512 * u, t = idx >> 4, ch = idx & 15; const bf16* zr = zb + (size_t)t * ABP + h * 128 + ch * 8;
        f8[u] = *(const u32x4*)(zr + C_F); v8[u] = *(const u32x4*)(zr + C_I); q8[u] = *(const u32x4*)(zr + C_Q); }
#pragma unroll
    for (int u = 0; u < 2; ++u) { const int idx = tid + 512 * u, t = idx >> 4, ch = idx & 15;
#pragma unroll
        for (int i = 0; i < 4; ++i) { const unsigned fw = f8[u][i]; const int d = ch * 8 + 2 * i;
            { const float lbv = lb[d]; bl[t * 128 + d] = __logf(lbv + (1.f - lbv) * sigmoidf_(bflo(fw))); }
            { const float lbv = lb[d + 1]; bl[t * 128 + d + 1] = __logf(lbv + (1.f - lbv) * sigmoidf_(bfhi(fw))); } }
        *(u32x4*)(Vr + t * 144 + ch * 8) = v8[u]; }
    __syncthreads();
    { const int seg = tid >> 7, d = tid & 127; float run = 0.f;
#pragma unroll
      for (int i = 0; i < 16; ++i) { run += bl[(seg * 16 + i) * 128 + d]; bl[(seg * 16 + i) * 128 + d] = run; }
      tot[seg * 128 + d] = run; }
    __syncthreads();
#pragma unroll
    for (int u = 0; u < 2; ++u) { const int idx = tid + 512 * u, t = idx >> 4, ch = idx & 15, I = t >> 4;
        u32x4 wqt, wqh; float kv_[8], ex[8], pre[8];
#pragma unroll
        for (int i = 0; i < 8; ++i) { const int d = ch * 8 + i; float p = 0.f; for (int s = 0; s < I; ++s) p += tot[s * 128 + d]; pre[i] = p; }
#pragma unroll
        for (int i = 0; i < 4; ++i) {
            const int d = ch * 8 + 2 * i; const float q0 = siluf_(bflo(q8[u][i])), q1 = siluf_(bfhi(q8[u][i]));
            const float b0 = bl[t * 128 + d], b1 = bl[t * 128 + d + 1], e0 = __expf(b0), e1 = __expf(b1);
            wqt[i] = pk2(q0 * e0, q1 * e1); wqh[i] = pk2(q0 * e0 * __expf(pre[2 * i]), q1 * e1 * __expf(pre[2 * i + 1]));
            const float l0 = lb[d], l1 = lb[d + 1];
            kv_[2 * i] = 1.f - (l0 + (1.f - l0) * sigmoidf_(bflo(f8[u][i]))); kv_[2 * i + 1] = 1.f - (l1 + (1.f - l1) * sigmoidf_(bfhi(f8[u][i]))); ex[2 * i] = -b0; ex[2 * i + 1] = -b1;
        }
        *(u32x4*)(Qt + t * 136 + ch * 8) = wqt; *(u32x4*)(Qh + t * 136 + ch * 8) = wqh;
        for (int I2 = I; I2 < 4; ++I2) {
            u32x4 wk;
#pragma unroll
            for (int i = 0; i < 4; ++i) wk[i] = pk2(kv_[2 * i] * __expf(ex[2 * i]), kv_[2 * i + 1] * __expf(ex[2 * i + 1]));
            *(u32x4*)(Kt + (8 * I2 * (I2 + 1) + t) * 136 + ch * 8) = wk;
#pragma unroll
            for (int i = 0; i < 8; ++i) ex[i] += tot[I2 * 128 + ch * 8 + i];
        }
    }
    __syncthreads();
    { const float* St = (const float*)(P.ws + WS_LT) + (size_t)unit * 16384; f32x4 sa[4], sc4[4];
#pragma unroll
      for (int u = 0; u < 4; ++u) { const int idx = tid + 512 * u, e = idx >> 4, ch = idx & 15; sa[u] = *(const f32x4*)(St + e * 128 + ch * 8); sc4[u] = *(const f32x4*)(St + e * 128 + ch * 8 + 4); }
#pragma unroll
      for (int u = 0; u < 4; ++u) { const int idx = tid + 512 * u, e = idx >> 4, ch = idx & 15;
          u32x4 w; w.x = pk2(sa[u].x, sa[u].y); w.y = pk2(sa[u].z, sa[u].w); w.z = pk2(sc4[u].x, sc4[u].y); w.w = pk2(sc4[u].z, sc4[u].w); *(u32x4*)(Sb + e * 256 + ((ch ^ (e & 15)) << 4)) = w; } }
    { const int I = wave >> 1;
#pragma unroll
      for (int jj = 0; jj < 2; ++jj) { const int J = 2 * (wave & 1) + jj; f32x4 a4 = {0.f, 0.f, 0.f, 0.f};
          if (J <= I) {
#pragma unroll
              for (int ks = 0; ks < 4; ++ks) { const bf16x8 a = *(const bf16x8*)(Qt + (16 * I + r16) * 136 + ks * 32 + quad * 8);
                  const bf16x8 bb = *(const bf16x8*)(Kt + (8 * I * (I + 1) + 16 * J + r16) * 136 + ks * 32 + quad * 8); a4 = MFMA16(a, bb, a4); } }
#pragma unroll
          for (int i = 0; i < 4; ++i) { const int t = 16 * I + quad * 4 + i, s = 16 * J + r16; att[t * 72 + s] = (s <= t) ? f2bf(a4[i]) : (bf16)0; } } }
    __syncthreads();
    { const int I = wave >> 1; f32x4 acc[4];
#pragma unroll
      for (int x = 0; x < 4; ++x) acc[x] = (f32x4){0.f, 0.f, 0.f, 0.f};
#pragma unroll
      for (int ks = 0; ks < 4; ++ks) { const bf16x8 a = *(const bf16x8*)(Qh + (16 * I + r16) * 136 + ks * 32 + quad * 8);
#pragma unroll
          for (int x = 0; x < 4; ++x) { const int e = ((wave & 1) * 4 + x) * 16 + r16; const bf16x8 bb = *(const bf16x8*)(Sb + e * 256 + (((ks * 4 + quad) ^ (e & 15)) << 4)); acc[x] = MFMA16(a, bb, acc[x]); } }
      const int nks = (I >= 2) ? 2 : 1;
      for (int ks = 0; ks < nks; ++ks) { const bf16x8 a = *(const bf16x8*)(att + (16 * I + r16) * 72 + ks * 32 + quad * 8);
#pragma unroll
          for (int x = 0; x < 4; ++x) { const bf16x8 bb = tr_frag(Vr, 144, ks * 32, ((wave & 1) * 4 + x) * 16, r16, quad); acc[x] = MFMA16(a, bb, acc[x]); } }
#pragma unroll
      for (int x = 0; x < 4; ++x)
#pragma unroll
          for (int i = 0; i < 4; ++i) obuf[(16 * I + quad * 4 + i) * 132 + ((wave & 1) * 4 + x) * 16 + r16] = acc[x][i];
    }
    __syncthreads();
    { const float* hn = P.hgrn_norm + j * 128; bf16* oc = (bf16*)(P.ws + WS_OC) + ((size_t)b * SEQ + c * 64) * D + h * 128;
      const float h0 = hn[2 * lane], h1 = hn[2 * lane + 1]; unsigned gw[8];
#pragma unroll
      for (int i = 0; i < 8; ++i) gw[i] = *(const unsigned*)(zb + (size_t)(wave * 8 + i) * ABP + C_G + h * 128 + 2 * lane);
#pragma unroll
      for (int i = 0; i < 8; ++i) { const int t = wave * 8 + i; const f32x2 v = *(const f32x2*)(obuf + t * 132 + 2 * lane); const float ss = wave_sum(v.x * v.x + v.y * v.y), rs = rsqrtf(ss * (1.f / 128.f) + EPS);
          *(unsigned*)(oc + (size_t)t * D + 2 * lane) = pk2(v.x * rs * h0 * siluf_(bflo(gw[i])), v.y * rs * h1 * siluf_(bfhi(gw[i]))); } }
    __syncthreads();
}

DI float ex2(float x) { return __builtin_amdgcn_exp2f(x); }
DI void attn_fetch(u32x4& k8, u32x4& v8, const bf16* kbase, const bf16* vbase, size_t stride, int nvalid, int tid) {
    const int key = tid >> 3, ch = tid & 7; k8 = (u32x4){0u, 0u, 0u, 0u}; v8 = k8;
    if (key < nvalid) { k8 = *(const u32x4*)(kbase + (size_t)key * stride + ch * 8); v8 = *(const u32x4*)(vbase + (size_t)key * stride + ch * 8); }
}
DI void attn_put(bf16* Ks, const u32x4& k8, const u32x4& v8, int tid) {
    const int key = tid >> 3, ch = tid & 7; *(u32x4*)(Ks + key * 72 + ch * 8) = k8; *(u32x4*)(Ks + 64 * 72 + key * 72 + ch * 8) = v8;
}
DI void attn_qk(f32x4 (&s)[4][2], const bf16* Ks, const bf16x8 (&qf)[2][2], int r16, int quad, bool en0, bool en1) {
    if (en0 && en1) {
        bf16x8 kf[4][2];
#pragma unroll
        for (int kt = 0; kt < 4; ++kt)
#pragma unroll
            for (int ks = 0; ks < 2; ++ks) kf[kt][ks] = *(const bf16x8*)(Ks + (kt * 16 + r16) * 72 + ks * 32 + quad * 8);
#pragma unroll
        for (int kt = 0; kt < 4; ++kt) {
            s[kt][0] = MFMA16(kf[kt][0], qf[0][0], ((f32x4){0.f, 0.f, 0.f, 0.f})); s[kt][1] = MFMA16(kf[kt][0], qf[1][0], ((f32x4){0.f, 0.f, 0.f, 0.f}));
            s[kt][0] = MFMA16(kf[kt][1], qf[0][1], s[kt][0]); s[kt][1] = MFMA16(kf[kt][1], qf[1][1], s[kt][1]);
        }
    } else {
#pragma unroll
        for (int qt = 0; qt < 2; ++qt) {
            if (qt ? en1 : en0) {
#pragma unroll
                for (int kt = 0; kt < 4; ++kt) {
                    s[kt][qt] = (f32x4){0.f, 0.f, 0.f, 0.f};
#pragma unroll
                    for (int ks = 0; ks < 2; ++ks) { const bf16x8 a = *(const bf16x8*)(Ks + (kt * 16 + r16) * 72 + ks * 32 + quad * 8); s[kt][qt] = MFMA16(a, qf[qt][ks], s[kt][qt]); }
                }
            }
        }
    }
}
DI void attn_pv(f32x4 (&o)[4][2], const bf16* Vs, const bf16x8 (&pb)[2][2], int r16, int quad, bool en0, bool en1) {
    const bf16* vb = Vs + (quad * 4 + (r16 >> 2)) * 72 + (r16 & 3) * 4;
    if (en0 && en1) {
        s16x4 vf[4][2][2];
#pragma unroll
        for (int dt = 0; dt < 4; ++dt)
#pragma unroll
            for (int kk = 0; kk < 2; ++kk) { vf[dt][kk][0] = vtr(vb + (2 * kk) * 16 * 72 + dt * 16); vf[dt][kk][1] = vtr(vb + (2 * kk + 1) * 16 * 72 + dt * 16); }
#pragma unroll
        for (int dt = 0; dt < 4; ++dt)
#pragma unroll
            for (int kk = 0; kk < 2; ++kk) {
                const bf16x8 a = __builtin_shufflevector(vf[dt][kk][0], vf[dt][kk][1], 0, 1, 2, 3, 4, 5, 6, 7);
                o[dt][0] = MFMA16(a, pb[kk][0], o[dt][0]); o[dt][1] = MFMA16(a, pb[kk][1], o[dt][1]);
            }
    } else {
#pragma unroll
        for (int qt = 0; qt < 2; ++qt) {
            if (qt ? en1 : en0) {
#pragma unroll
                for (int dt = 0; dt < 4; ++dt)
#pragma unroll
                    for (int kk = 0; kk < 2; ++kk) {
                        const s16x4 lo = vtr(vb + (2 * kk) * 16 * 72 + dt * 16), hi = vtr(vb + (2 * kk + 1) * 16 * 72 + dt * 16);
                        const bf16x8 a = __builtin_shufflevector(lo, hi, 0, 1, 2, 3, 4, 5, 6, 7);
                        o[dt][qt] = MFMA16(a, pb[kk][qt], o[dt][qt]);
                    }
            }
        }
    }
}
template <int MODE>
DI void attn_branch(bf16* KV, const unsigned char* tl, int n, const bf16* zb, const bf16* kc, int g, int qi, int tid, int wave, int r16, int quad,
                    const bf16x8 (&qf)[2][2], const int (&tpos)[2], f32x4 (&o)[4][2], float (&m)[2], float (&l)[2], const u64 (&mk)[2], const u64 (&wq)[2], float* impA, float* impB) {
    const int q0 = qi * 64, rh = (r16 >> 2) & 3;
    u32x4 k8, v8;
#define AB_FETCH(i_) do { const int jb_ = tl[i_]; if (MODE <= 1) attn_fetch(k8, v8, kc + (size_t)jb_ * 64 * 256, kc + (size_t)jb_ * 64 * 256 + 128, 256, 255 - jb_ * 64, tid); \
        else { const int co_ = (MODE == 2) ? C_WIN : C_SEL; attn_fetch(k8, v8, zb + (size_t)jb_ * 64 * ABP + co_ + g * 64, zb + (size_t)jb_ * 64 * ABP + co_ + 128 + g * 64, ABP, 64, tid); } } while (0)
    if (n <= 0) return;
    AB_FETCH(0); attn_put(KV, k8, v8, tid);
    if (n > 1) AB_FETCH(1);
    __syncthreads();
    for (int i = 0; i < n; ++i) {
        bf16* Ks = KV + (i & 1) * (128 * 72);
        if (i + 1 < n) attn_put(KV + ((i + 1) & 1) * (128 * 72), k8, v8, tid);
        if (i + 2 < n) AB_FETCH(i + 2);
        const int jb = tl[i];
        bool en0 = true, en1 = true;
        if (MODE == 3) { en0 = (wq[0] >> jb) & 1ull; en1 = (wq[1] >> jb) & 1ull; }
        if (en0 || en1) {
            f32x4 s[4][2];
            attn_qk(s, Ks, qf, r16, quad, en0, en1);
            bool partial;
            if (MODE <= 1) partial = !(16 * (jb * 64 + 63) + 31 <= q0);
            else if (MODE == 2) partial = (jb == qi) || (jb + 8 == qi);
            else partial = (jb == qi);
            bf16x8 pb[2][2];
#pragma unroll
            for (int qt = 0; qt < 2; ++qt) {
                if (!(qt ? en1 : en0)) continue;
                if (partial) {
#pragma unroll
                    for (int kt = 0; kt < 4; ++kt)
#pragma unroll
                        for (int i2 = 0; i2 < 4; ++i2) { const int kp = jb * 64 + kt * 16 + quad * 4 + i2; bool ok;
                            if (MODE <= 1) ok = (16 * kp + 31 <= tpos[qt]); else if (MODE == 2) { const int dd = tpos[qt] - kp; ok = (dd >= 0 && dd < 512); } else ok = (kp <= tpos[qt]);
                            s[kt][qt][i2] = ok ? s[kt][qt][i2] : -INFINITY; }
                }
                if (MODE == 1) {
                    const float mu = m[qt], il = (l[qt] > 0.f) ? 1.f / l[qt] : 0.f; const int tokl = 8 * wave + 4 * qt + (r16 & 3);
#pragma unroll
                    for (int kt = 0; kt < 4; ++kt) {
#pragma unroll
                        for (int i2 = 0; i2 < 4; ++i2) s[kt][qt][i2] = ex2(s[kt][qt][i2] - mu) * il;
                        float v = (s[kt][qt][0] + s[kt][qt][1]) + (s[kt][qt][2] + s[kt][qt][3]), v3 = s[kt][qt][3];
                        v += __shfl_xor(v, 4); v += __shfl_xor(v, 8); v3 += __shfl_xor(v3, 4); v3 += __shfl_xor(v3, 8);
                        if (rh == 0) { const int c = jb * 16 + kt * 4 + quad; impA[tokl * 65 + c] = v; if (c + 1 < 64) impB[tokl * 65 + c + 1] = v3; }
                    }
                } else {
                    const bool lsel = (MODE == 3) ? ((mk[qt] >> jb) & 1ull) : true;
                    float mx = fmax3(s[0][qt][0], s[0][qt][1], s[0][qt][2]);
                    mx = fmax3(mx, s[0][qt][3], s[1][qt][0]); mx = fmax3(mx, s[1][qt][1], s[1][qt][2]); mx = fmax3(mx, s[1][qt][3], s[2][qt][0]); mx = fmax3(mx, s[2][qt][1], s[2][qt][2]);
                    mx = fmax3(mx, s[2][qt][3], s[3][qt][0]); mx = fmax3(mx, s[3][qt][1], s[3][qt][2]); mx = fmax2(mx, s[3][qt][3]);
                    if (MODE == 3) mx = lsel ? mx : -INFINITY;
                    mx = quad_max(mx);
                    const bool slow = (m[qt] != 0.f) || (mx > 8.f) || (l[qt] == 0.f && mx < -8.f && mx > -INFINITY);
                    f32x2 r2 = {0.f, 0.f};
                    if (__any(slow)) {
                        const bool fresh = (l[qt] == 0.f);
                        const float mn = (mx == -INFINITY) ? m[qt] : (fresh ? mx : fmax2(m[qt], mx)), alpha = fresh ? 1.f : ex2(m[qt] - mn);
#pragma unroll
                        for (int kt = 0; kt < 4; ++kt) {
#pragma unroll
                            for (int i2 = 0; i2 < 4; ++i2) s[kt][qt][i2] = ex2(s[kt][qt][i2] - mn);
                            r2 += (f32x2){s[kt][qt][0], s[kt][qt][1]}; r2 += (f32x2){s[kt][qt][2], s[kt][qt][3]}; }
                        float rs = r2.x + r2.y; if (MODE == 3) rs = lsel ? rs : 0.f;
                        l[qt] = l[qt] * alpha + quad_sum(rs); m[qt] = mn;
                        if (MODE != 0) {
#pragma unroll
                            for (int dt = 0; dt < 4; ++dt) o[dt][qt] = o[dt][qt] * alpha; }
                    } else {
#pragma unroll
                        for (int kt = 0; kt < 4; ++kt) {
#pragma unroll
                            for (int i2 = 0; i2 < 4; ++i2) s[kt][qt][i2] = ex2(s[kt][qt][i2]);
                            r2 += (f32x2){s[kt][qt][0], s[kt][qt][1]}; r2 += (f32x2){s[kt][qt][2], s[kt][qt][3]}; }
                        float rs = r2.x + r2.y; if (MODE == 3) rs = lsel ? rs : 0.f;
                        l[qt] += quad_sum(rs);
                    }
                }
                if (MODE != 0) {
#pragma unroll
                    for (int kk = 0; kk < 2; ++kk) { pb[kk][qt] = pack8(s[2 * kk][qt], s[2 * kk + 1][qt]);
                        if (MODE == 3) { const bool lsel = (mk[qt] >> jb) & 1ull; const bf16x8 z = {0, 0, 0, 0, 0, 0, 0, 0}; pb[kk][qt] = lsel ? pb[kk][qt] : z; } }
                }
            }
            if (MODE != 0) attn_pv(o, Ks + 64 * 72, pb, r16, quad, en0, en1);
        }
        __syncthreads();
    }
#undef AB_FETCH
}
DI void attn_unit(unsigned char* lds, int b, int g, int qi) {
    const Ptrs P = get_ptrs();
    const int tid = otid(), wave = tid >> 6, lane = tid & 63, r16 = lane & 15, quad = lane >> 4;
    bf16* Qs = (bf16*)lds; bf16* KV = (bf16*)(lds + 36864);
    float* impA = (float*)(lds + 73728); float* impB = impA + 64 * 65; u64* msk = (u64*)(lds + 107008);
    unsigned char* tl = lds + 107584;
    f32x4* obLo = (f32x4*)lds + tid; f32x4* obHi = (f32x4*)(lds + 73728) + tid;
    const bf16* zb = (const bf16*)(P.ws + WS_ZB) + (size_t)b * SEQ * ABP; const int q0 = qi * 64;
    const bf16* kc = (const bf16*)(P.ws + WS_KCP) + (size_t)b * 256 * 256 + g * 64;
    const int ntc = ((q0 + 32) >> 4) / 64 + 1;
    for (int idx = tid; idx < 2048; idx += 512) { const int tok = idx >> 5, r = (idx >> 3) & 3, ch = idx & 7; const float qs = 0.18033688011112042f;
        const u32x4 q8 = *(const u32x4*)(zb + (size_t)(q0 + tok) * ABP + C_QB + (g * 4 + r) * 64 + ch * 8); u32x4 w;
#pragma unroll
        for (int i = 0; i < 4; ++i) w[i] = pk2(bflo(q8[i]) * qs, bfhi(q8[i]) * qs);
        *(u32x4*)(Qs + (tok * 4 + r) * 72 + ch * 8) = w; }
    for (int idx = tid; idx < 2 * 64 * 65; idx += 512) impA[idx] = 0.f;
    if (tid < 4) tl[tid] = (unsigned char)tid;
    __syncthreads();
    bf16x8 qf[2][2]; int tpos[2]; float gate[2][3];
    const int rh = (r16 >> 2) & 3;
#pragma unroll
    for (int qt = 0; qt < 2; ++qt) { const int tokl = 8 * wave + 4 * qt + (r16 & 3); tpos[qt] = q0 + tokl;
#pragma unroll
        for (int ks = 0; ks < 2; ++ks) qf[qt][ks] = *(const bf16x8*)(Qs + (tokl * 4 + rh) * 72 + ks * 32 + quad * 8);
#pragma unroll
        for (int br = 0; br < 3; ++br) gate[qt][br] = sigmoidf_(bf2f(zb[(size_t)tpos[qt] * ABP + C_GATE + (g * 4 + rh) * 3 + br])); }
    f32x4 o[4][2]; float m[2], l[2]; u64 mk[2] = {0ull, 0ull}, wq[2] = {0ull, 0ull};
    m[0] = m[1] = 0.f; l[0] = l[1] = 0.f;
#pragma unroll
    for (int dt = 0; dt < 4; ++dt) { o[dt][0] = (f32x4){0.f, 0.f, 0.f, 0.f}; o[dt][1] = (f32x4){0.f, 0.f, 0.f, 0.f}; }
    attn_branch<0>(KV, tl, ntc, zb, kc, g, qi, tid, wave, r16, quad, qf, tpos, o, m, l, mk, wq, impA, impB);
    attn_branch<1>(KV, tl, ntc, zb, kc, g, qi, tid, wave, r16, quad, qf, tpos, o, m, l, mk, wq, impA, impB);
    {
        const int tok = tid >> 3, sub = tid & 7, cur = qi; u64 mkk;
        if (cur < 16) mkk = (1ull << (cur + 1)) - 1ull;
        else {
            float v[8]; unsigned taken = 0u;
#pragma unroll
            for (int i = 0; i < 8; ++i) { const int jb = sub + 8 * i; v[i] = (jb >= 1 && jb <= cur - 2) ? impA[tok * 65 + jb] + impB[tok * 65 + jb] : -INFINITY; }
            for (int it = 0; it < 13; ++it) {
                float bv = -INFINITY; int bi = 64;
#pragma unroll
                for (int i = 0; i < 8; ++i) { const bool c = !((taken >> i) & 1u) && v[i] > bv; bv = c ? v[i] : bv; bi = c ? sub + 8 * i : bi; }
#pragma unroll
                for (int o_ = 1; o_ < 8; o_ <<= 1) { const float ov = __shfl_xor(bv, o_); const int oi = __shfl_xor(bi, o_); const bool c = ov > bv || (ov == bv && oi < bi); bv = c ? ov : bv; bi = c ? oi : bi; }
                if ((bi & 7) == sub && bi < 64) taken |= 1u << (bi >> 3);
            }
            unsigned lo = 0u, hi = 0u;
#pragma unroll
            for (int i = 0; i < 8; ++i) if ((taken >> i) & 1u) { const int jb = sub + 8 * i; if (jb < 32) lo |= 1u << jb; else hi |= 1u << (jb - 32); }
#pragma unroll
            for (int o_ = 1; o_ < 8; o_ <<= 1) { lo |= __shfl_xor(lo, o_); hi |= __shfl_xor(hi, o_); }
            mkk = (((u64)hi << 32) | lo) | 1ull | (1ull << cur) | (1ull << (cur - 1));
        }
        if (sub == 0) msk[tok] = mkk;
        unsigned ul = (unsigned)mkk, uh = (unsigned)(mkk >> 32);
#pragma unroll
        for (int o_ = 8; o_ < 64; o_ <<= 1) { ul |= __shfl_xor(ul, o_); uh |= __shfl_xor(uh, o_); }
        if (lane == 0) msk[64 + wave] = ((u64)uh << 32) | ul;
    }
    __syncthreads();
#pragma unroll
    for (int qt = 0; qt < 2; ++qt) { obLo[(0 * 2 + qt) * 512] = o[0][qt] * gate[qt][0]; obLo[(1 * 2 + qt) * 512] = o[1][qt] * gate[qt][0]; }
    u64 uni = 0;
    {
#pragma unroll
      for (int t = 0; t < 8; ++t) uni |= msk[64 + t];
      uni &= (qi == 63) ? ~0ull : ((1ull << (qi + 1)) - 1ull);
#pragma unroll
      for (int qt = 0; qt < 2; ++qt) { mk[qt] = msk[8 * wave + 4 * qt + (r16 & 3)]; u64 w_ = 0; for (int t = 0; t < 4; ++t) w_ |= msk[8 * wave + 4 * qt + t];
          wq[qt] = ((u64)__builtin_amdgcn_readfirstlane((unsigned)(w_ >> 32)) << 32) | (unsigned)__builtin_amdgcn_readfirstlane((unsigned)w_); } }
    __syncthreads();
#pragma unroll
    for (int qt = 0; qt < 2; ++qt) { obHi[(0 * 2 + qt) * 512] = o[2][qt] * gate[qt][0]; obHi[(1 * 2 + qt) * 512] = o[3][qt] * gate[qt][0]; }
    const int jw0 = (qi > 8 ? qi - 8 : 0), nw = qi - jw0 + 1;
    if (tid < nw) tl[tid] = (unsigned char)(jw0 + tid);
    __syncthreads();
    m[0] = m[1] = 0.f; l[0] = l[1] = 0.f;
#pragma unroll
    for (int dt = 0; dt < 4; ++dt) { o[dt][0] = (f32x4){0.f, 0.f, 0.f, 0.f}; o[dt][1] = (f32x4){0.f, 0.f, 0.f, 0.f}; }
    attn_branch<2>(KV, tl, nw, zb, kc, g, qi, tid, wave, r16, quad, qf, tpos, o, m, l, mk, wq, impA, impB);
#pragma unroll
    for (int qt = 0; qt < 2; ++qt) { const float sc = gate[qt][2] / fmaxf(l[qt], 1e-30f);
        obLo[(0 * 2 + qt) * 512] += o[0][qt] * sc; obLo[(1 * 2 + qt) * 512] += o[1][qt] * sc; obHi[(0 * 2 + qt) * 512] += o[2][qt] * sc; obHi[(1 * 2 + qt) * 512] += o[3][qt] * sc; }
    if (tid < 64) ((u64*)(P.ws + WS_MSK))[(size_t)(b * 2 + g) * SEQ + q0 + tid] = msk[tid];
    { bf16* oc = (bf16*)(P.ws + WS_OC) + (size_t)b * SEQ * D;
#pragma unroll
      for (int qt = 0; qt < 2; ++qt)
#pragma unroll
          for (int dt = 0; dt < 4; ++dt) { const f32x4 acc = (dt < 2) ? obLo[(dt * 2 + qt) * 512] : obHi[((dt - 2) * 2 + qt) * 512];
              u32x2 w; w.x = pk2(acc[0], acc[1]); w.y = pk2(acc[2], acc[3]);
              *(u32x2*)(oc + (size_t)tpos[qt] * D + 512 + (g * 4 + rh) * 64 + dt * 16 + quad * 4) = w; } }
    __syncthreads();
}

namespace selb {
typedef unsigned short bf16;
using bf16x8=__attribute__((ext_vector_type(8)))short;
using s16x4=__attribute__((ext_vector_type(4)))short;
using f32x16=__attribute__((ext_vector_type(16)))float;
using u32x4=__attribute__((ext_vector_type(4)))unsigned;
constexpr int D=64,PQ=3584,PO=1024;
constexpr int NW=8,QBLK=32,QB=QBLK*NW,KVBLK=64;
__device__ __forceinline__ int crow(int r,int hi){return (r&3)+8*(r>>2)+4*hi;}
#define SBAR() __builtin_amdgcn_sched_barrier(0)
__device__ __forceinline__ void cmask(f32x16&p0,f32x16&p1,int jb,int qrel,int hi){
  const float NEG=-INFINITY; int kb=64*jb+4*hi;
  #pragma unroll
  for(int r=0;r<16;++r){int kv=kb+(r&3)+8*(r>>2); if(kv>qrel)p0[r]=NEG; if(kv+32>qrel)p1[r]=NEG;}
}

constexpr int NSLOT=3, SLOTB=8192;
constexpr int LDS_K=0, LDS_V=NSLOT*SLOTB, LDS_WS=2*NSLOT*SLOTB, LDS_OST=LDS_WS+NW*64*4, LDS_BYTES=LDS_OST+NW*4096;
constexpr float C2=0.125f*1.4426950408889634f;
__device__ __forceinline__ void glds16(const void*gsrc,unsigned lds_dst){unsigned keep;
  asm volatile("s_mov_b32 %0, m0\n\ts_mov_b32 m0, %2\n\ts_nop 0\n\tglobal_load_lds_dwordx4 %1, off\n\ts_mov_b32 m0, %0":"=&s"(keep):"v"(gsrc),"s"(lds_dst):"memory");}
__device__ __forceinline__ float max3f(float a,float b,float c){float r;asm("v_max3_f32 %0, %1, %2, %3":"=v"(r):"v"(a),"v"(b),"v"(c));return r;}
__device__ __forceinline__ float max2f(float a,float b){float r;asm("v_max_f32_e32 %0, %1, %2":"=v"(r):"v"(a),"v"(b));return r;}
__device__ __forceinline__ float fadd_s(float a,float b){float r;asm("v_add_f32_e32 %0, %1, %2":"=v"(r):"v"(a),"v"(b));return r;}
__device__ __forceinline__ float fsub_s(float a,float b){float r;asm("v_sub_f32_e32 %0, %1, %2":"=v"(r):"v"(a),"v"(b));return r;}
typedef float f32x2_t __attribute__((ext_vector_type(2))); typedef __bf16 bf16x2_t __attribute__((ext_vector_type(2)));
__device__ __forceinline__ unsigned cvtpk_s(float lo,float hi){f32x2_t v={lo,hi};bf16x2_t b=__builtin_convertvector(v,bf16x2_t);return __builtin_bit_cast(unsigned,b);}
#define WAIT_BAR(N) asm volatile("s_waitcnt vmcnt(" #N ") lgkmcnt(0)\n\ts_barrier":::"memory")

__device__ __forceinline__ void qkt(f32x16&p0,f32x16&p1,const char*Kslot,const bf16x8*qr,const f32x16&negm,int r32,int hi){
  const char*kb=Kslot+hi*1024+r32*16;
  #pragma unroll
  for(int d0=0;d0<4;++d0){
    const bf16x8 b0=*reinterpret_cast<const bf16x8*>(kb+d0*2048);
    const bf16x8 b1=*reinterpret_cast<const bf16x8*>(kb+d0*2048+512);
    if(d0==0){p0=__builtin_amdgcn_mfma_f32_32x32x16_bf16(b0,qr[0],negm,0,0,0);p1=__builtin_amdgcn_mfma_f32_32x32x16_bf16(b1,qr[0],negm,0,0,0);}
    else{p0=__builtin_amdgcn_mfma_f32_32x32x16_bf16(b0,qr[d0],p0,0,0,0);p1=__builtin_amdgcn_mfma_f32_32x32x16_bf16(b1,qr[d0],p1,0,0,0);}}
}
typedef __attribute__((address_space(3))) const char* lds_cptr;
typedef short v4i16_t __attribute__((ext_vector_type(4)));
__device__ __forceinline__ void kload8(bf16x8*kf,lds_cptr kp){
  kf[0]=*(const __attribute__((address_space(3))) bf16x8*)(kp);      kf[1]=*(const __attribute__((address_space(3))) bf16x8*)(kp+512);
  kf[2]=*(const __attribute__((address_space(3))) bf16x8*)(kp+2048); kf[3]=*(const __attribute__((address_space(3))) bf16x8*)(kp+2560);
  kf[4]=*(const __attribute__((address_space(3))) bf16x8*)(kp+4096); kf[5]=*(const __attribute__((address_space(3))) bf16x8*)(kp+4608);
  kf[6]=*(const __attribute__((address_space(3))) bf16x8*)(kp+6144); kf[7]=*(const __attribute__((address_space(3))) bf16x8*)(kp+6656);
}
__device__ __forceinline__ void kload2(bf16x8*kf,lds_cptr kp,int j){ kf[2*j]=*(const __attribute__((address_space(3))) bf16x8*)(kp+j*2048); kf[2*j+1]=*(const __attribute__((address_space(3))) bf16x8*)(kp+j*2048+512); }
__device__ __forceinline__ s16x4 vtr(lds_cptr p){ return __builtin_bit_cast(s16x4,__builtin_amdgcn_ds_read_tr16_b64_v4i16((__attribute__((address_space(3))) v4i16_t*)p)); }
__device__ __forceinline__ float rowmax(const f32x16&p0,const f32x16&p1){
  float a=max3f(p0[0],p0[1],p1[0]),b=max3f(p0[2],p0[3],p1[1]);a=max3f(a,p1[2],p1[3]);
  #pragma unroll
  for(int r=4;r<16;r+=4){a=max3f(a,p0[r],p0[r+1]);b=max3f(b,p0[r+2],p0[r+3]);a=max3f(a,p1[r],p1[r+1]);b=max3f(b,p1[r+2],p1[r+3]);}
  const float m=max2f(a,b);
  auto rr=__builtin_amdgcn_permlane32_swap(__float_as_uint(m),__float_as_uint(m),false,false);
  return max2f(__uint_as_float(rr[0]),__uint_as_float(rr[1]));
}
__device__ __forceinline__ void pv(f32x16*o,int vb,bf16x8 pa0,bf16x8 pa1,bf16x8 pa2,bf16x8 pa3){
  #pragma unroll
  for(int d0=0;d0<2;++d0){s16x4 lo[4],hi[4];
    #pragma unroll
    for(int ks=0;ks<4;++ks){
      asm volatile("ds_read_b64_tr_b16 %0,%1 offset:%c2":"=&v"(lo[ks]):"v"(vb),"i"(d0*4096+ks*1024):"memory");
      asm volatile("ds_read_b64_tr_b16 %0,%1 offset:%c2":"=&v"(hi[ks]):"v"(vb),"i"(d0*4096+ks*1024+512):"memory");}
    asm volatile("s_waitcnt lgkmcnt(0)":::"memory");SBAR();
    #define PK(k) (bf16x8){lo[k][0],lo[k][1],lo[k][2],lo[k][3],hi[k][0],hi[k][1],hi[k][2],hi[k][3]}
    o[d0]=__builtin_amdgcn_mfma_f32_32x32x16_bf16(pa0,PK(0),o[d0],0,0,0);
    o[d0]=__builtin_amdgcn_mfma_f32_32x32x16_bf16(pa1,PK(1),o[d0],0,0,0);
    o[d0]=__builtin_amdgcn_mfma_f32_32x32x16_bf16(pa2,PK(2),o[d0],0,0,0);
    o[d0]=__builtin_amdgcn_mfma_f32_32x32x16_bf16(pa3,PK(3),o[d0],0,0,0);
    #undef PK
  }
}

template<int THRL> __device__ __forceinline__ void sel_unit(int qb,const bf16*Qh,const bf16*__restrict__ Kh,const bf16*__restrict__ Vh,bf16*Oh,const unsigned long long*mrow,const bf16*gz,char*shm){
  const int tid=otid(),lane=tid&63,r32=lane&31,hi=lane>>5; const int wid=__builtin_amdgcn_readfirstlane(tid>>6);
  const int q0=qb*QB;
  const bf16*Qw=Qh+(long)(q0+wid*QBLK)*PQ;
  const unsigned lds0=(unsigned)(uintptr_t)shm;
  float*wsf=(float*)(shm+LDS_WS)+wid*64;
  const bf16*ksrc=Kh+(long)lane*PQ+wid*8;
  const bf16*vsrc=Vh+(long)(16*(wid&3)+(lane>>2))*PQ+(wid>>2)*32+(lane&3)*8;
  const unsigned kdst=lds0+LDS_K+wid*1024, vdst=lds0+LDS_V+wid*1024;
  #define DMA_K(t,slot) glds16(ksrc+(long)(t)*KVBLK*PQ,(unsigned)__builtin_amdgcn_readfirstlane(kdst+(slot)))
  #define DMA_V(t,slot) glds16(vsrc+(long)(t)*KVBLK*PQ,(unsigned)__builtin_amdgcn_readfirstlane(vdst+(slot)))
  const int vb0=(int)(lds0+LDS_V)+((lane>>4)&1)*32+(lane&3)*8+(4*hi+((lane&15)>>2))*64;
  const char*Kbase=shm+LDS_K; bf16x8 kf[8];
  const lds_cptr shm3=(lds_cptr)shm; const lds_cptr kp0=shm3+LDS_K+hi*1024+r32*16; const lds_cptr vp0=shm3+LDS_V+((lane>>4)&1)*32+(lane&3)*8+(4*hi+((lane&15)>>2))*64;
  const int NT=(q0+QB)/KVBLK;
  DMA_K(0,0);DMA_V(0,0);DMA_K(1,SLOTB);
  bf16x8 qr[4];
  #pragma unroll
  for(int d0=0;d0<4;++d0){ const u32x4 q8=*reinterpret_cast<const u32x4*>(&Qw[(long)r32*PQ+d0*16+hi*8]); u32x4 w;
    _Pragma("unroll") for(int i=0;i<4;++i) w[i]=cvtpk_s(__uint_as_float(q8[i]<<16)*C2,__uint_as_float(q8[i]&0xffff0000u)*C2);
    qr[d0]=__builtin_bit_cast(bf16x8,w); }
  const unsigned long long mkl=mrow[q0+wid*QBLK+r32];
  float mhat=0.f,l_reg=0.f;f32x16 o[2];o[0]=f32x16{};o[1]=f32x16{};f32x16 csel=f32x16{};
  const int qrel=wid*QBLK+r32;
  #define CMASK(P0,P1,t) do{int jb_=(t)-(NT-4); if(jb_>=0)cmask(P0,P1,jb_,qrel,hi);}while(0)
  bool resc=false;
  #define START(P0,P1) do{ const float rm=rowmax(P0,P1); resc=false; \
    { const float dl=rm; mhat=fadd_s(mhat,dl); \
      _Pragma("unroll") for(int r=0;r<16;++r){P0[r]=fsub_s(P0[r],dl);P1[r]=fsub_s(P1[r],dl);} \
      } \
    _Pragma("unroll") for(int r=0;r<16;++r)P0[r]=__builtin_amdgcn_exp2f(P0[r]); }while(0)
  #define RESC() do{ if(resc){ asm volatile("s_waitcnt lgkmcnt(0)":::"memory"); \
      _Pragma("unroll") for(int d_=0;d_<2;++d_) _Pragma("unroll") for(int r=0;r<16;++r)o[d_][r]*=wsf[crow(r,hi)]; } }while(0)
  f32x16 pA0,pA1,pB0,pB1;
  int sl_prev=0,sl_cur=0,sl_next=SLOTB;
  #define ROT() do{sl_prev=sl_cur;sl_cur=sl_next;sl_next=(sl_next==(NSLOT-1)*SLOTB)?0:sl_next+SLOTB;}while(0)
  DMA_K(2,2*SLOTB);
  WAIT_BAR(3);
  qkt(pA0,pA1,Kbase,qr,csel,r32,hi);asm volatile("s_nop 15\n\ts_nop 7":"+v"(pA0),"+v"(pA1));CMASK(pA0,pA1,0);
  START(pA0,pA1);
  _Pragma("unroll") for(int r=0;r<16;++r)pA1[r]=__builtin_amdgcn_exp2f(pA1[r]);
  WAIT_BAR(0);
  DMA_K(3,0);DMA_V(1,SLOTB);
  ROT();
  kload8(kf,kp0+sl_cur);
  WAIT_BAR(2);
  s16x4 vlo[8],vhi[8]; u32x4 pw0,pw1,pw2,pw3;
  #define PKW(P,B) cvtpk_s(P[B],P[B+1])
  #define PAF(k) __builtin_bit_cast(bf16x8,pw##k)
  #define VFR(i) (bf16x8){vlo[i][0],vlo[i][1],vlo[i][2],vlo[i][3],vhi[i][0],vhi[i][1],vhi[i][2],vhi[i][3]}
  #define PIN(x) asm volatile("":"+v"(x))
  #define MX3(a,b,c) __builtin_fmaxf(__builtin_fmaxf((a),(b)),(c))
  #define GAPA(MF,A0,A1,A2,A3,W0,W1,PW) do{ MF; sacc+=A0; sacc+=A1; sacc+=A2; sacc+=A3; PIN(sacc); W0; W1; PIN(PW); SBAR(); }while(0)
  #define EX(v) __builtin_amdgcn_exp2f(v)
  #define GAPB(MF,X,B) do{ MF; X[B]=EX(X[B]); X[B+1]=EX(X[B+1]); X[B+2]=EX(X[B+2]); X[B+3]=EX(X[B+3]); PIN(X); SBAR(); }while(0)
  #define VRD(i) do{ vlo[i]=vtr(vp_+(((i)>>2)*4096+((i)&3)*1024)); vhi[i]=vtr(vp_+(((i)>>2)*4096+((i)&3)*1024+512)); }while(0)
  #define KRD(G,j) do{ if(G){ kload2(kf,kp0+sl_next,j); SBAR(); } }while(0)
  #define STEP(C0,C1,P0,P1,t,GK,GV,GL) do{ SBAR(); \
    { const float cs_=((mkl>>(t))&1ull)?-mhat:-INFINITY; _Pragma("unroll") for(int r=0;r<16;++r)csel[r]=cs_; asm volatile("":"+v"(csel)); } SBAR(); \
    const lds_cptr vp_=vp0+sl_prev; \
    VRD(0); SBAR(); float sacc=(P0[0]+P0[1]); \
    GAPA(C0=__builtin_amdgcn_mfma_f32_32x32x16_bf16(kf[0],qr[0],csel,0,0,0), P0[2],P0[3],P0[4],P0[5],     pw0[0]=PKW(P0,0), pw0[1]=PKW(P0,2), pw0); \
    VRD(4); SBAR(); GAPA(C1=__builtin_amdgcn_mfma_f32_32x32x16_bf16(kf[1],qr[0],csel,0,0,0), P0[6],P0[7],P0[8],P0[9],     pw0[2]=PKW(P0,4), pw0[3]=PKW(P0,6), pw0); \
    VRD(1); SBAR(); GAPA(C0=__builtin_amdgcn_mfma_f32_32x32x16_bf16(kf[2],qr[1],C0,0,0,0),   P0[10],P0[11],P0[12],P0[13], pw1[0]=PKW(P0,8), pw1[1]=PKW(P0,10), pw1); \
    VRD(5); SBAR(); GAPA(C1=__builtin_amdgcn_mfma_f32_32x32x16_bf16(kf[3],qr[1],C1,0,0,0),   P0[14],P0[15],P1[0],P1[1],   pw1[2]=PKW(P0,12),pw1[3]=PKW(P0,14), pw1); \
    VRD(2); SBAR(); GAPA(C0=__builtin_amdgcn_mfma_f32_32x32x16_bf16(kf[4],qr[2],C0,0,0,0),   P1[2],P1[3],P1[4],P1[5],     pw2[0]=PKW(P1,0), pw2[1]=PKW(P1,2), pw2); \
    VRD(6); SBAR(); GAPA(C1=__builtin_amdgcn_mfma_f32_32x32x16_bf16(kf[5],qr[2],C1,0,0,0),   P1[6],P1[7],P1[8],P1[9],     pw2[2]=PKW(P1,4), pw2[3]=PKW(P1,6), pw2); \
    VRD(3); SBAR(); GAPA(C0=__builtin_amdgcn_mfma_f32_32x32x16_bf16(kf[6],qr[3],C0,0,0,0),   P1[10],P1[11],P1[12],P1[13], pw3[0]=PKW(P1,8), pw3[1]=PKW(P1,10), pw3); \
    VRD(7); SBAR(); GAPA(C1=__builtin_amdgcn_mfma_f32_32x32x16_bf16(kf[7],qr[3],C1,0,0,0),   P1[14],P1[15],0.f,0.f,       pw3[2]=PKW(P1,12),pw3[3]=PKW(P1,14), pw3); \
    l_reg+=sacc; \
    if(GK){DMA_K((t)+3,sl_cur);} if(GV){DMA_V((t)+1,sl_next);} \
    CMASK(C0,C1,t); \
    { float a=MX3(C0[0],C0[1],C1[0]),b=MX3(C0[2],C0[3],C1[1]); a=MX3(a,C1[2],C1[3]); \
      _Pragma("unroll") for(int r=4;r<16;r+=4){a=MX3(a,C0[r],C0[r+1]);b=MX3(b,C0[r+2],C0[r+3]);a=MX3(a,C1[r],C1[r+1]);b=MX3(b,C1[r+2],C1[r+3]);} \
      float rm=__builtin_fmaxf(a,b); { auto rr=__builtin_amdgcn_permlane32_swap(__float_as_uint(rm),__float_as_uint(rm),false,false); rm=__builtin_fmaxf(__uint_as_float(rr[0]),__uint_as_float(rr[1])); } \
      resc=false; \
      if(__builtin_expect(__any(rm>(float)THRL),0)){ const float dl=__builtin_fmaxf(rm,0.f); mhat+=dl; \
        _Pragma("unroll") for(int r=0;r<16;++r){C0[r]-=dl;C1[r]-=dl;} \
        const float f=__builtin_amdgcn_exp2f(-dl); l_reg*=f; if(hi==0)wsf[r32]=f; resc=true; } } \
    SBAR(); \
    GAPB(o[0]=__builtin_amdgcn_mfma_f32_32x32x16_bf16(PAF(0),VFR(0),o[0],0,0,0), C0,0); \
    GAPB(o[1]=__builtin_amdgcn_mfma_f32_32x32x16_bf16(PAF(0),VFR(4),o[1],0,0,0), C0,4); \
    KRD(GL,0); GAPB(o[0]=__builtin_amdgcn_mfma_f32_32x32x16_bf16(PAF(1),VFR(1),o[0],0,0,0), C0,8); \
    KRD(GL,1); GAPB(o[1]=__builtin_amdgcn_mfma_f32_32x32x16_bf16(PAF(1),VFR(5),o[1],0,0,0), C0,12); \
    KRD(GL,2); GAPB(o[0]=__builtin_amdgcn_mfma_f32_32x32x16_bf16(PAF(2),VFR(2),o[0],0,0,0), C1,0); \
    KRD(GL,3); GAPB(o[1]=__builtin_amdgcn_mfma_f32_32x32x16_bf16(PAF(2),VFR(6),o[1],0,0,0), C1,4); \
    GAPB(o[0]=__builtin_amdgcn_mfma_f32_32x32x16_bf16(PAF(3),VFR(3),o[0],0,0,0), C1,8); \
    GAPB(o[1]=__builtin_amdgcn_mfma_f32_32x32x16_bf16(PAF(3),VFR(7),o[1],0,0,0), C1,12); \
    }while(0)
  int t=1;
  #undef CMASK
  #define CMASK(P0,P1,t) do{}while(0)
  for(;t+5<NT;t+=2){
    STEP(pB0,pB1,pA0,pA1,t,true,true,true);     WAIT_BAR(2); RESC(); ROT();
    STEP(pA0,pA1,pB0,pB1,t+1,true,true,true);   WAIT_BAR(2); RESC(); ROT();
  }
  #undef CMASK
  #define CMASK(P0,P1,t) do{int jb_=(t)-(NT-4); if(jb_>=0)cmask(P0,P1,jb_,qrel,hi);}while(0)
  #define ENDW(tt) do{ if((tt)+3<NT){WAIT_BAR(2);} else if((tt)+2<NT){WAIT_BAR(1);} else {WAIT_BAR(0);} }while(0)
  for(;t+1<NT;t+=2){
    STEP(pB0,pB1,pA0,pA1,t,(t+3<NT),(t+1<NT),(t+1<NT));       ENDW(t);   RESC(); ROT();
    STEP(pA0,pA1,pB0,pB1,t+1,(t+4<NT),(t+2<NT),(t+2<NT));     ENDW(t+1); RESC(); ROT();
  }
  STEP(pB0,pB1,pA0,pA1,NT-1,false,false,false); RESC();
  { float sacc=pB0[0]+pB0[1]; _Pragma("unroll") for(int r=2;r<16;++r)sacc+=pB0[r]; _Pragma("unroll") for(int r=0;r<16;++r)sacc+=pB1[r]; l_reg+=sacc;
    pw0=(u32x4){PKW(pB0,0),PKW(pB0,2),PKW(pB0,4),PKW(pB0,6)};pw1=(u32x4){PKW(pB0,8),PKW(pB0,10),PKW(pB0,12),PKW(pB0,14)};pw2=(u32x4){PKW(pB1,0),PKW(pB1,2),PKW(pB1,4),PKW(pB1,6)};pw3=(u32x4){PKW(pB1,8),PKW(pB1,10),PKW(pB1,12),PKW(pB1,14)};
    SBAR(); pv(o,vb0+sl_cur,PAF(0),PAF(1),PAF(2),PAF(3)); }
  #undef PKW
  #undef PAF
  #undef VFR
  #undef PIN
  #undef MX3
  #undef GAPA
  #undef GAPB
  #undef EX
  #undef VRD
  #undef KRD
  #undef STEP
  #undef ENDW
  {auto rr=__builtin_amdgcn_permlane32_swap(__float_as_uint(l_reg),__float_as_uint(l_reg),false,false);l_reg=__uint_as_float(rr[0])+__uint_as_float(rr[1]);}
  { const float gl=__uint_as_float((unsigned)gz[(long)(q0+wid*QBLK+r32)*PQ]<<16); const float gate=__builtin_amdgcn_rcpf(1.f+__expf(-gl));
    if(hi==0)wsf[32+r32]=gate*__builtin_amdgcn_rcpf(fmaxf(l_reg,1e-30f)); }
  asm volatile("s_waitcnt lgkmcnt(0)":::"memory");
  float rli[16];
  #pragma unroll
  for(int r=0;r<16;++r)rli[r]=wsf[32+crow(r,hi)];
  bf16*Ow=Oh+(long)(q0+wid*QBLK)*PO;
  { bf16*stg=(bf16*)(shm+LDS_OST)+wid*2048;
    #pragma unroll
    for(int r=0;r<16;++r){const int orow=crow(r,hi);
      #pragma unroll
      for(int d0=0;d0<2;++d0)stg[orow*64+d0*32+r32]=(bf16)(cvtpk_s(o[d0][r]*rli[r],0.f)&0xffffu);}
    asm volatile("s_waitcnt lgkmcnt(0)":::"memory");
    #pragma unroll
    for(int i=0;i<4;++i){const int row=i*8+(lane>>3),ch=lane&7; const u32x4 v=*(const u32x4*)(stg+row*64+ch*8); bf16*dst=Ow+(long)row*PO+ch*8; const u32x4 p=*(const u32x4*)dst; u32x4 w;
      _Pragma("unroll") for(int e=0;e<4;++e) w[e]=cvtpk_s(__uint_as_float(v[e]<<16)+__uint_as_float(p[e]<<16),__uint_as_float(v[e]&0xffff0000u)+__uint_as_float(p[e]&0xffff0000u));
      *(u32x4*)dst=w;} }
  asm volatile("s_waitcnt lgkmcnt(0)\n\ts_barrier":::"memory");
  #undef DMA_K
  #undef DMA_V
  #undef CMASK
  #undef START
  #undef RESC
  #undef ROT
}
constexpr int SEL_LDS_BYTES=LDS_BYTES;
#undef SBAR
#undef WAIT_BAR
}

DI void sel_attn_unit(unsigned char* lds, int b, int hq, int qb) {
    const Ptrs P = get_ptrs();
    const int g = hq >> 2;
    const bf16* zb = (const bf16*)(P.ws + WS_ZB) + (size_t)b * SEQ * ABP;
    selb::sel_unit<8>(qb, zb + C_QB + hq * 64, zb + C_SEL + g * 64, zb + C_SEL + 128 + g * 64, (bf16*)(P.ws + WS_OC) + (size_t)b * SEQ * D + 512 + hq * 64,
                      (const u64*)(P.ws + WS_MSK) + (size_t)(b * 2 + g) * SEQ, zb + C_GATE + hq * 3 + 1, (char*)lds);
}

DI void mix_unit(unsigned char* lds, int jc, int chunk, int gq) {
    const Ptrs P = get_ptrs();
    const int tid = otid(), wave = tid >> 6, lane = tid & 63, r16 = lane & 15, quad = lane >> 4;
    bf16* Vr = (bf16*)lds; float* mu = (float*)(lds + 128 * 144 * 2); float* rsd = mu + 128;
    const size_t tok0 = (size_t)chunk * 128;
    const bf16* ub = (const bf16*)(P.ws + WS_ZB); const bf16* vb = ub + (size_t)MP * D; const float* vstat = (const float*)(P.ws + WS_VSTAT);
    u32x4 v8[4];
#pragma unroll
    for (int u = 0; u < 4; ++u) { const int idx = tid + 512 * u, s = idx >> 4, ch = idx & 15; v8[u] = *(const u32x4*)(vb + (tok0 + s) * D + gq * 128 + ch * 8); }
    const int t = wave * 16 + r16; u32x2 u4[8];
#pragma unroll
    for (int mt = 0; mt < 8; ++mt) u4[mt] = *(const u32x2*)(ub + (tok0 + t) * D + gq * 128 + mt * 16 + quad * 4);
    if (tid < 128) { const f32x4* p = (const f32x4*)(vstat + (tok0 + tid) * 32); float s1 = 0.f, s2 = 0.f;
#pragma unroll
        for (int i = 0; i < 8; ++i) { const f32x4 v = p[i]; s1 += v.x + v.z; s2 += v.y + v.w; }
        const float mean = s1 * (1.f / 1024.f), var = fmaxf(s2 * (1.f / 1024.f) - mean * mean, 0.f); mu[tid] = mean; rsd[tid] = rsqrtf(var + EPS); }
    __syncthreads();
    { const float* lg = P.ln_c_g + jc * D + gq * 128; const float* lbb = P.ln_c_b + jc * D + gq * 128;
#pragma unroll
      for (int u = 0; u < 4; ++u) { const int idx = tid + 512 * u, s = idx >> 4, ch = idx & 15; const float mm = mu[s], rr = rsd[s]; u32x4 w;
#pragma unroll
          for (int i = 0; i < 4; ++i) { const int c = ch * 8 + 2 * i; w[i] = pk2((bflo(v8[u][i]) - mm) * rr * lg[c] + lbb[c], (bfhi(v8[u][i]) - mm) * rr * lg[c + 1] + lbb[c + 1]); }
          *(u32x4*)(Vr + s * 144 + ch * 8) = w; } }
    __syncthreads();
    f32x4 acc[8];
#pragma unroll
    for (int mt = 0; mt < 8; ++mt) acc[mt] = (f32x4){0.f, 0.f, 0.f, 0.f};
    const bf16* wt = (const bf16*)(P.ws + WS_TRIL) + ((size_t)(jc * 8 + gq) * 128 + t) * 128 + quad * 8;
    const int nks = (wave >> 1) + 1;
    for (int ks = 0; ks < nks; ++ks) { const bf16x8 bb = *(const bf16x8*)(wt + ks * 32);
#pragma unroll
        for (int mt = 0; mt < 8; ++mt) { const bf16x8 a = tr_frag(Vr, 144, ks * 32, mt * 16, r16, quad); acc[mt] = MFMA16(a, bb, acc[mt]); } }
    { const float bs = P.b_s[(jc * 8 + gq) * 128 + t]; bf16* um = (bf16*)(P.ws + WS_OC);
#pragma unroll
      for (int mt = 0; mt < 8; ++mt) { const int c = gq * 128 + mt * 16 + quad * 4;
          u32x2 w; w.x = pk2(bflo(u4[mt].x) * (acc[mt][0] + bs), bfhi(u4[mt].x) * (acc[mt][1] + bs)); w.y = pk2(bflo(u4[mt].y) * (acc[mt][2] + bs), bfhi(u4[mt].y) * (acc[mt][3] + bs));
          *(u32x2*)(um + (tok0 + t) * D + c) = w; } }
    __syncthreads();
}

DI void hgrn_s_unit(unsigned char* lds, int j, int b, int h) {
    const Ptrs P = get_ptrs();
    const int tid = otid(); float* qq = (float*)lds; float* fg = qq + 128; float* kx = fg + 128; float* vv = kx + 128; float* part = vv + 128; float* sq = part + 16 * 128;
    const float* z = (const float*)(P.ws + WS_SMP + SMP_ZS) + (size_t)b * ABP; const float* lb = (const float*)(P.ws + WS_SMALL) + j * 512 + h * 128;
    if (tid < 128) { const float f = z[C_F + h * 128 + tid], lbv = lb[tid], fgv = lbv + (1.f - lbv) * sigmoidf_(f);
        qq[tid] = siluf_(z[C_Q + h * 128 + tid]); fg[tid] = fgv; kx[tid] = 1.f - fgv; vv[tid] = z[C_I + h * 128 + tid]; }
    __syncthreads();
    const int e4 = (tid & 31) * 4, dr = tid >> 5; const size_t sbase = (((size_t)j * DB + b) * 4 + h) * 16384;
    const float* S0 = P.state_hgrn + sbase; float* S1 = P.out + O_HG_S + sbase;
    f32x4 acc = {0.f, 0.f, 0.f, 0.f}; const f32x4 v4 = *(const f32x4*)(vv + e4);
#pragma unroll
    for (int it = 0; it < 8; ++it) { const int d = it * 16 + dr; const f32x4 s0 = *(const f32x4*)(S0 + d * 128 + e4); const f32x4 sn = s0 * fg[d] + v4 * kx[d]; *(f32x4*)(S1 + d * 128 + e4) = sn; acc += sn * qq[d]; }
    *(f32x4*)(part + dr * 128 + e4) = acc;
    __syncthreads();
    float o = 0.f;
    if (tid < 128) { for (int r = 0; r < 16; ++r) o += part[r * 128 + tid]; sq[tid] = o * o; }
    __syncthreads();
    if (tid < 128) { float ss = 0.f; for (int i = 0; i < 128; ++i) ss += sq[i]; const float rs = rsqrtf(ss * (1.f / 128.f) + EPS);
        ((bf16*)(P.ws + WS_SMP + SMP_OCS))[(size_t)b * D + h * 128 + tid] = f2bf(o * rs * P.hgrn_norm[j * 128 + tid] * siluf_(z[C_G + h * 128 + tid])); }
    __syncthreads();
}
DI void sattn_core(const float* const* kp, int nkeys, const float* qL, float* sc, float* red, float* oacc) {
    const int tid = otid(), wave = tid >> 6, lane = tid & 63;
    for (int key = tid; key < nkeys; key += 512) { const float* k = kp[key]; float d0 = -INFINITY, d1 = -INFINITY, d2 = -INFINITY, d3 = -INFINITY;
        if (k) { d0 = d1 = d2 = d3 = 0.f;
#pragma unroll
            for (int i = 0; i < 16; ++i) { const f32x4 kv = *(const f32x4*)(k + 4 * i); const f32x4 a = *(const f32x4*)(qL + 4 * i), b = *(const f32x4*)(qL + 64 + 4 * i), c = *(const f32x4*)(qL + 128 + 4 * i), d = *(const f32x4*)(qL + 192 + 4 * i);
                d0 += (kv.x * a.x + kv.y * a.y) + (kv.z * a.z + kv.w * a.w); d1 += (kv.x * b.x + kv.y * b.y) + (kv.z * b.z + kv.w * b.w);
                d2 += (kv.x * c.x + kv.y * c.y) + (kv.z * c.z + kv.w * c.w); d3 += (kv.x * d.x + kv.y * d.y) + (kv.z * d.z + kv.w * d.w); }
            d0 *= 0.125f; d1 *= 0.125f; d2 *= 0.125f; d3 *= 0.125f; }
        sc[key] = d0; sc[1040 + key] = d1; sc[2080 + key] = d2; sc[3120 + key] = d3; }
    __syncthreads();
    if (wave < 4) { float* row = sc + wave * 1040; float mx = -INFINITY; for (int k = lane; k < nkeys; k += 64) mx = fmaxf(mx, row[k]); mx = wave_max(mx); const float mu = (mx == -INFINITY) ? 0.f : mx;
        float sm = 0.f; for (int k = lane; k < nkeys; k += 64) { const float e = __expf(row[k] - mu); row[k] = e; sm += e; } sm = wave_sum(sm); const float il = 1.f / fmaxf(sm, 1e-30f);
        for (int k = lane; k < nkeys; k += 64) row[k] *= il; }
    __syncthreads();
    {
      const int ks = tid >> 4, d4 = (tid & 15) * 4; f32x4 a0 = {0.f, 0.f, 0.f, 0.f}, a1 = a0, a2 = a0, a3 = a0; const float* safe = kp[0];
      for (int k0 = ks; k0 < nkeys; k0 += 256) {
          f32x4 v[8]; float p0[8], p1[8], p2[8], p3[8];
#pragma unroll
          for (int u = 0; u < 8; ++u) { const int k = k0 + 32 * u; const bool ok = k < nkeys; const float* kv = ok ? kp[k] : nullptr; const bool ld = kv != nullptr; kv = ld ? kv : safe;
              v[u] = *(const f32x4*)(kv + 128 + d4); const int kk = ok ? k : 0;
              p0[u] = ld ? sc[kk] : 0.f; p1[u] = ld ? sc[1040 + kk] : 0.f; p2[u] = ld ? sc[2080 + kk] : 0.f; p3[u] = ld ? sc[3120 + kk] : 0.f; }
#pragma unroll
          for (int u = 0; u < 8; ++u) { a0 += v[u] * p0[u]; a1 += v[u] * p1[u]; a2 += v[u] * p2[u]; a3 += v[u] * p3[u]; }
      }
      *(f32x4*)(red + (ks * 4 + 0) * 64 + d4) = a0; *(f32x4*)(red + (ks * 4 + 1) * 64 + d4) = a1; *(f32x4*)(red + (ks * 4 + 2) * 64 + d4) = a2; *(f32x4*)(red + (ks * 4 + 3) * 64 + d4) = a3; }
    __syncthreads();
    if (tid < 256) { float a = 0.f;
#pragma unroll 8
        for (int ks = 0; ks < 32; ++ks) a += red[ks * 256 + tid];
        oacc[tid] = a; }
    __syncthreads();
}
DI void sattn_unit(unsigned char* lds, int j, int b, int g) {
    const Ptrs P = get_ptrs();
    const int tid = otid(), lane = tid & 63;
    const float** kp = (const float**)lds;
    float* sc = (float*)(lds + 8320);
    float* qL = sc + 4 * 1040; float* red = qL + 256; float* oacc = red + 8192; float* om = oacc + 256; float* imp = om + 256; int* flag = (int*)(imp + 132); int* list = flag + 132;
    const float* z = (const float*)(P.ws + WS_SMP + SMP_ZS) + (size_t)b * ABP;
    if (tid < 256) { qL[tid] = z[C_QB + g * 256 + tid]; om[tid] = 0.f; }
    const float* wbuf = P.state_win + (((size_t)j * DB + b) * 512) * 256 + g * 64;
    for (int k = tid; k < 512; k += 512) kp[k] = (k < 511) ? wbuf + (size_t)(k + 1) * 256 : z + C_WIN + g * 64;
    __syncthreads();
    sattn_core(kp, 512, qL, sc, red, oacc);
    if (tid < 256) { const int r = tid >> 6; om[tid] += sigmoidf_(z[C_GATE + (g * 4 + r) * 3 + 2]) * oacc[tid]; }
    __syncthreads();
    const float* kcs = (const float*)(P.ws + WS_KCS) + (size_t)b * 512 * 256 + g * 64;
    for (int k = tid; k < 511; k += 512) kp[k] = kcs + (size_t)k * 256;
    __syncthreads();
    sattn_core(kp, 511, qL, sc, red, oacc);
    if (tid < 256) { const int r = tid >> 6; om[tid] += sigmoidf_(z[C_GATE + (g * 4 + r) * 3 + 0]) * oacc[tid]; }
    if (tid < 129) { float a = 0.f; const int nlo = (4 * tid - 1 < 0) ? 0 : 4 * tid - 1, nhi = (4 * tid + 3 > 510) ? 510 : 4 * tid + 3;
        for (int r = 0; r < 4; ++r) for (int n = nlo; n <= nhi; ++n) a += sc[r * 1040 + n];
        imp[tid] = a; flag[tid] = (tid == 0 || tid == 127 || tid == 128) ? 1 : 0; }
    __syncthreads();
    if (tid < 64) {
        const int j1 = lane + 1, j2 = lane + 65; float v1 = imp[j1], v2 = (j2 <= 126) ? imp[j2] : -INFINITY; bool t1 = false, t2 = (j2 > 126);
        for (int it = 0; it < 13; ++it) {
            float bv; int bi;
            const float c1 = t1 ? -INFINITY : v1, c2 = t2 ? -INFINITY : v2;
            if (c2 > c1) { bv = c2; bi = j2; } else { bv = c1; bi = j1; }
#pragma unroll
            for (int o_ = 1; o_ < 64; o_ <<= 1) { const float ov = __shfl_xor(bv, o_); const int oi = __shfl_xor(bi, o_); if (ov > bv || (ov == bv && oi < bi)) { bv = ov; bi = oi; } }
            if (bi == j1) { t1 = true; flag[j1] = 1; } else if (bi == j2) { t2 = true; flag[j2] = 1; }
        }
    }
    __syncthreads();
    if (tid == 0) { int n = 0; for (int jb = 0; jb < 129 && n < 16; ++jb) if (flag[jb]) list[n++] = jb; for (; n < 16; ++n) list[n] = -1; }
    __syncthreads();
    for (int k = tid; k < 1024; k += 512) { const int jb = list[k >> 6], i = k & 63; const float* p = nullptr;
        if (jb >= 0) { if (jb < 128) { const int pos = jb * 64 + i, page = P.page_table[b * NPAGES + (pos >> 7)]; p = P.cache_sel + (((size_t)j * NPOOL + page) * 128 + (pos & 127)) * 256 + g * 64; }
                       else if (i == 0) p = z + C_SEL + g * 64; }
        kp[k] = p; }
    __syncthreads();
    sattn_core(kp, 1024, qL, sc, red, oacc);
    if (tid < 256) { const int r = tid >> 6, d = tid & 63; const float v = om[tid] + sigmoidf_(z[C_GATE + (g * 4 + r) * 3 + 1]) * oacc[tid];
        ((bf16*)(P.ws + WS_SMP + SMP_OCS))[(size_t)b * D + 512 + (g * 4 + r) * 64 + d] = f2bf(v); }
    __syncthreads();
}
DI void gmlp_s_unit(unsigned char* lds, int jc, int b) {
    const Ptrs P = get_ptrs();
    const int tid = otid(), wave = tid >> 6, lane = tid & 63; float* red = (float*)lds;
    const float* uv = (const float*)(P.ws + WS_SMP + SMP_UVS) + (size_t)b * 2048;
    const float v0 = uv[1024 + tid], v1 = uv[1024 + 512 + tid];
    float s = wave_sum(v0 + v1); if (lane == 0) red[wave] = s; __syncthreads();
    float mean = 0.f; for (int w = 0; w < 8; ++w) mean += red[w]; mean *= (1.f / 1024.f); __syncthreads();
    const float d0 = v0 - mean, d1 = v1 - mean; s = wave_sum(d0 * d0 + d1 * d1); if (lane == 0) red[wave] = s; __syncthreads();
    float var = 0.f; for (int w = 0; w < 8; ++w) var += red[w]; const float rs = rsqrtf(var * (1.f / 1024.f) + EPS);
#pragma unroll
    for (int k = 0; k < 2; ++k) { const int c = tid + 512 * k, gq = c >> 7; const float vl = (k ? d1 : d0) * rs * P.ln_c_g[jc * D + c] + P.ln_c_b[jc * D + c];
        P.out[O_CV_S + ((size_t)jc * DB + b) * D + c] = vl;
        ((bf16*)(P.ws + WS_SMP + SMP_OCS))[(size_t)b * D + c] = f2bf(uv[c] * (P.w_s[(size_t)(jc * 8 + gq) * 16384] * vl + P.b_s[(jc * 8 + gq) * 128])); }
    __syncthreads();
}
DI void final_norm(int bid, int G) {
    const Ptrs P = get_ptrs();
    const int tid = otid(), wave = tid >> 6, lane = tid & 63; const int gw = bid * 8 + wave, NGW = G * 8;
    const float* hs = (const float*)(P.ws + WS_SMP + SMP_HS);
    f32x4 g4[4];
#pragma unroll
    for (int k = 0; k < 4; ++k) g4[k] = ((const f32x4*)P.norm_final)[lane + 64 * k];
    for (int m = gw; m < MP + DB; m += NGW) {
        f32x4 v[4]; float s = 0.f;
        if (m < MP) { const u32x2* xr = (const u32x2*)((const bf16*)(P.ws + WS_HB) + (size_t)m * D) + lane;
#pragma unroll
            for (int k = 0; k < 4; ++k) { const u32x2 w = xr[64 * k]; v[k] = (f32x4){bflo(w.x), bfhi(w.x), bflo(w.y), bfhi(w.y)}; }
        } else { const f32x4* xr = (const f32x4*)(hs + (size_t)(m - MP) * D) + lane;
#pragma unroll
            for (int k = 0; k < 4; ++k) v[k] = xr[64 * k]; }
        f32x4* o = (f32x4*)((m < MP) ? P.out + O_YP + (size_t)m * D : P.out + O_YS + (size_t)(m - MP) * D) + lane;
#pragma unroll
        for (int k = 0; k < 4; ++k) s += (v[k].x * v[k].x + v[k].y * v[k].y) + (v[k].z * v[k].z + v[k].w * v[k].w);
        const float rs = rsqrtf(wave_sum(s) * (1.f / 1024.f) + EPS);
#pragma unroll
        for (int k = 0; k < 4; ++k) o[64 * k] = v[k] * rs * g4[k];
    }
}
constexpr int N_PHASES = 30;
__global__ void __launch_bounds__(512, 2) mega_fwd(Args args) {
    extern __shared__ __attribute__((aligned(16))) unsigned char lds[];
    const int tid = otid(), bid = blockIdx.x, G = gridDim.x;
    const int lo = args.ph_lo, hi = args.ph_hi;
    volatile LAS unsigned* MISC = (volatile LAS unsigned*)((LAS unsigned char*)lds + MISC_OFF);
    if (tid < 16) MISC[tid] = 0u;
    __syncthreads();
    XcdBarrier bar; bar.bar = (unsigned*)(args.ws + WS_CTL); bar.x = 0; bar.st = nullptr;
    const bool multi = (hi - lo) > 1;
    if (multi) bar = xcd_barrier_post((unsigned*)(args.ws + WS_CTL), MISC + 8);
#ifndef PHM
#define PHM 0x7ff
#endif
#define SITE(s) ((PHM >> (s)) & 1)
#ifndef PROBE_DUP
#define PROBE_DUP 0
#endif
#define NREP(s) (1 + ((PROBE_DUP >> (s)) & 1))
#ifndef FILL_A
#define FILL_A 1
#endif
#ifndef WGM_A
#define WGM_A 4
#endif
#ifndef WGM_C
#define WGM_C 4
#endif
#ifndef WGM_E
#define WGM_E 4
#endif
#ifndef WGM_F
#define WGM_F 4
#endif
#ifndef WGM_G
#define WGM_G 8
#endif
#ifndef PROBE_SK
#define PROBE_SK 0
#endif
#ifndef PROBE_SUB
#define PROBE_SUB 0
#endif
#define IN(k) (lo <= (k) && (k) < hi)
#ifndef PROBE_DBLBAR
#define PROBE_DBLBAR 0
#endif
#define SEAM(k) do { if (multi && (k) + 1 < hi) { xcd_barrier(bar); if (PROBE_DBLBAR) xcd_barrier(bar); } else __syncthreads(); } while (0)
#define LOCALS const Ptrs P = get_ptrs(); unsigned char* ws = P.ws; (void)ws; \
    float* hp = (float*)(ws + WS_HP); bf16* hb = (bf16*)(ws + WS_HB); float* ssq = (float*)(ws + WS_SSQ); bf16* zb = (bf16*)(ws + WS_ZB); bf16* hff = (bf16*)(ws + WS_HFF); bf16* oc = (bf16*)(ws + WS_OC); \
    float* hs = (float*)(ws + WS_SMP + SMP_HS); float* zs = (float*)(ws + WS_SMP + SMP_ZS); bf16* ocs = (bf16*)(ws + WS_SMP + SMP_OCS); bf16* hffs = (bf16*)(ws + WS_SMP + SMP_HFFS); float* uvs = (float*)(ws + WS_SMP + SMP_UVS); bf16* hsb = (bf16*)(ws + WS_SMP + SMP_HSB); (void)hsb; \
    (void)hp; (void)hb; (void)ssq; (void)zb; (void)hff; (void)oc; (void)hs; (void)zs; (void)ocs; (void)hffs; (void)uvs;
    PG8_LAS unsigned char* ring = (PG8_LAS unsigned char*)lds;

    if (SITE(0) && IN(0)) { for (int rep = 0; rep < NREP(0); ++rep) prologue(lds, bid, G); SEAM(0); }

    for (int L = 0; L < 4; ++L) {
        const int pb = 1 + 7 * L, j = L >> 1;
        if ((L & 1) == 0) {
            if (SITE(1) && IN(pb + 0)) {
                LOCALS
                for (int rep = 0; rep < NREP(1); ++rep) {
                { pg8::Gemm g{hb, (const bf16*)(ws + WS_WINAB) + (size_t)j * ABP * D, MP, ABP, D}; pg8::StaticOrder S; S.init(MP, ABP, G, bid, WGM_A);
                  EpiInAB E{zb, ssq, P.out + O_CMP_P + (size_t)j * MP * 256, P.out + O_SEL_P + (size_t)j * MP * 256, P.out + O_WIN_P + (size_t)j * BATCH * 512 * 256};
                  pg8::gemm_phase<EpiInAB, pg8::StaticOrder, true, true>(ring, g, S, E); }
                { SEpiInAB E{zs, P.out + O_CMP_S + (size_t)j * DB * 256, P.out + O_SEL_S + (size_t)j * DB * 256};
                  skinny_gemm<true, 4, SEpiInAB>(lds, hsb, D, (const bf16*)(ws + WS_WINAB) + (size_t)j * ABP * D, ABP, bid, G, E);
                   }
                if (rep == 0 && FILL_A) { const int rem = 896 % G;
                    if (rem != 0 && bid >= rem && bid - rem < 1024) { const int hi_ = bid - rem; compress_unit<true>(lds, j, hi_ >> 5, (hi_ >> 1) & 15, 511, PAST, hi_ & 1, (hi_ & 1) + 1); } }
                }
                SEAM(pb + 0);
            }
            if (SITE(2) && IN(pb + 1)) {
                for (int rep = 0; rep < NREP(2); ++rep) {
                const int rem_ = 896 % G, npre = (FILL_A && rem_ != 0) ? ((G - rem_ < 1024) ? G - rem_ : 1024) : 0, NH = 1024 - npre;
                unsigned* qctr = (unsigned*)(get_ptrs().ws + WS_CTL) + 4096 + 64 * (4 + j * 2 + rep);
                volatile LAS unsigned* qslot = MISC + 4;
                unsigned nxt = 0u;
                if (tid == 0) nxt = __hip_atomic_fetch_add(qctr, 1u, __ATOMIC_RELAXED, __HIP_MEMORY_SCOPE_AGENT);
                for (;;) {
                    if (tid == 0) qslot[0] = nxt;
                    __syncthreads();
                    int it = (int)qslot[0];
                    __syncthreads();
                    if (it >= NH + 736) break;
                    if (tid == 0) nxt = __hip_atomic_fetch_add(qctr, 1u, __ATOMIC_RELAXED, __HIP_MEMORY_SCOPE_AGENT);
                    if (it < NH) { const int hi_ = it + npre; compress_unit<true>(lds, j, hi_ >> 5, (hi_ >> 1) & 15, 511, PAST, hi_ & 1, (hi_ & 1) + 1); continue; }
                    it += 512 - NH;
                    if (it < 544) { const int u = it - 512; compress_unit<false>(lds, j, u >> 3, u & 7, 255, SEQ, 0, 2); }
                    else if (it < 672) { const int u = it - 544; hgrn_s_unit(lds, j, u >> 2, u & 3); }
                    else if (it < 736) {
                        LOCALS
                        const f32x4* src = (const f32x4*)(P.state_win + (size_t)j * DB * 512 * 256); f32x4* dst = (f32x4*)(P.out + O_WIN_S + (size_t)j * DB * 512 * 256);
                        const int i0 = (it - 672) * 16384 + otid();
#pragma unroll 4
                        for (int q = 0; q < 32; ++q) { const int i = i0 + q * 512, c4 = i & 63, s = (i >> 6) & 511, b = i >> 15;
                            dst[i] = (s < 511) ? src[i + 64] : *(const f32x4*)(zs + (size_t)b * ABP + C_WIN + c4 * 4); } }
                    else { const int u = (it - 736) * 2; hgrn_p1_unit(lds, j, u >> 8, u & 63, (u >> 6) & 3); hgrn_p1_unit(lds, j, (u + 1) >> 8, (u + 1) & 63, ((u + 1) >> 6) & 3); }
                }
                }
                SEAM(pb + 1);
            }
            if (SITE(3) && IN(pb + 2)) {
                for (int rep = 0; rep < NREP(3); ++rep) {
                const int myq = (int)(xb_xcc_id() & 7u); bool scan_ok = false;
                volatile LAS unsigned* qslot = MISC + 4;
                for (int off = 0; off < 8; ++off) {
                    const int q = (myq + off) & 7;
                    unsigned* qctr = (unsigned*)(get_ptrs().ws + WS_CTL) + 4096 + 64 * (16 + (j * 2 + rep) * 8 + q);
                    unsigned nxt = 0u;
                    if (tid == 0) nxt = __hip_atomic_fetch_add(qctr, 1u, __ATOMIC_RELAXED, __HIP_MEMORY_SCOPE_AGENT);
                    for (;;) {
                        if (tid == 0) qslot[0] = nxt;
                        __syncthreads();
                        const int it = (int)qslot[0];
                        __syncthreads();
                        if (it >= 216) break;
                        if (tid == 0) nxt = __hip_atomic_fetch_add(qctr, 1u, __ATOMIC_RELAXED, __HIP_MEMORY_SCOPE_AGENT);
                        if (it < 16) { if (rep == 0) hgrn_scan_item(j, q * 16 + it); }
                        else if (it < 24) { if (rep == 0 || PROBE_SUB != 2) { const int u = q * 8 + (it - 16); sattn_unit(lds, j, u >> 1, u & 1); } }
                        else if (it < 88) { if (rep == 0 || PROBE_SUB != 1) { const int qi = 63 - (it - 24); attn_unit(lds, q >> 1, q & 1, qi); if (rep == 0) publish_count(700 + (j * 8 + q) * 16 + (qi >> 2)); } }
                        else if (it < 152) { if (rep != 0) continue; const int i_ = it - 88, qb = 15 - (i_ >> 2);
                            wait_count(700 + (j * 8 + q) * 16 + qb, 4u);
                            sel_attn_unit(lds, q >> 1, (q & 1) * 4 + (i_ & 3), qb); }
                        else {
                            if (rep != 0) continue;
                            if (!scan_ok) { scan_wait(j); scan_ok = true; }
                            const int u = q * 128 + (it - 152) * 2; hgrn_p3_unit(lds, j, u >> 8, u & 63, (u >> 6) & 3); hgrn_p3_unit(lds, j, (u + 1) >> 8, (u + 1) & 63, ((u + 1) >> 6) & 3); }
                    }
                }
                }
                SEAM(pb + 2);
            }
        } else {
            if (SITE(5) && IN(pb + 0)) {
                LOCALS
                for (int rep = 0; rep < NREP(5); ++rep) {
                { pg8::Gemm g{hb, (const bf16*)(ws + WS_WINC) + (size_t)j * 2048 * D, MP, 2048, D}; pg8::StaticOrder S; S.init(MP, 2048, G, bid, WGM_C);
                  EpiInC E{zb, zb + (size_t)MP * D, ssq, (float*)(ws + WS_VSTAT)};
                  pg8::gemm_phase<EpiInC, pg8::StaticOrder, true, true>(ring, g, S, E); }
                { SEpiInC E{uvs}; skinny_gemm<true, 4, SEpiInC>(lds, hsb, D, (const bf16*)(ws + WS_WINC) + (size_t)j * 2048 * D, 2048, bid, G, E); }
                }
                SEAM(pb + 0);
            }
            if (SITE(6) && IN(pb + 1)) {
                for (int rep = 0; rep < NREP(6); ++rep) {
                unsigned* qctr = (unsigned*)(get_ptrs().ws + WS_CTL) + 4096 + 64 * (72 + j * 2 + rep);
                volatile LAS unsigned* qslot = MISC + 4; unsigned nxt = 0u;
                if (tid == 0) nxt = __hip_atomic_fetch_add(qctr, 1u, __ATOMIC_RELAXED, __HIP_MEMORY_SCOPE_AGENT);
                for (;;) {
                    if (tid == 0) qslot[0] = nxt;
                    __syncthreads();
                    const int it = (int)qslot[0];
                    __syncthreads();
                    if (it >= 512 + DB) break;
                    if (tid == 0) nxt = __hip_atomic_fetch_add(qctr, 1u, __ATOMIC_RELAXED, __HIP_MEMORY_SCOPE_AGENT);
                    if (it < DB) gmlp_s_unit(lds, j, it);
                    else { const int u = (it - DB) * 2; mix_unit(lds, j, u >> 3, u & 7); mix_unit(lds, j, (u + 1) >> 3, (u + 1) & 7); }
                }
                }
                SEAM(pb + 1);
            }
        }
        if (SITE(7) && IN(pb + 4)) {
            LOCALS
            const bf16* wo = (L & 1) ? (const bf16*)(ws + WS_WOUTC) + (size_t)j * D * D : (const bf16*)(ws + WS_WOUTAB) + (size_t)j * D * D;
            { pg8::Gemm g{oc, wo, MP, D, D}; pg8::StaticOrder S; S.init(MP, D, G, bid, WGM_E);
              if (NREP(7) == 2) { EpiResid E2{hb, (bf16*)(ws + WS_DUMMY + 64 * MiB), (float*)(ws + WS_DUMMY + 96 * MiB)}; pg8::gemm_phase<EpiResid, pg8::StaticOrder, true, true>(ring, g, S, E2);
                  SEpiResid E3{(float*)(ws + WS_DUMMY + 98 * MiB), (bf16*)(ws + WS_DUMMY + 99 * MiB)}; skinny_gemm<false, 4, SEpiResid>(lds, ocs, D, wo, D, bid, G, E3); }
              EpiResid E{hb, hb, ssq};
              pg8::gemm_phase<EpiResid, pg8::StaticOrder, true, true>(ring, g, S, E); }
            { SEpiResid E{hs, hsb}; skinny_gemm<false, 4, SEpiResid>(lds, ocs, D, wo, D, bid, G, E); }
            SEAM(pb + 4);
        }
        if (SITE(8) && IN(pb + 5)) {
            LOCALS
            const bf16* w1 = (const bf16*)(ws + WS_WF1) + (size_t)L * FF * D;
            for (int rep = 0; rep < NREP(8); ++rep) {
            { pg8::Gemm g{hb, w1, MP, FF, D}; pg8::StaticOrder S; S.init(MP, FF, G, bid, WGM_F); EpiFFN1 E{hff, ssq};
              pg8::gemm_phase<EpiFFN1, pg8::StaticOrder, true, true>(ring, g, S, E); }
            { SEpiFFN1 E{hffs}; skinny_gemm<true, 4, SEpiFFN1>(lds, hsb, D, w1, FF, bid, G, E); }
            }
            SEAM(pb + 5);
        }
        if (SITE(9) && IN(pb + 6)) {
            LOCALS
            const bf16* w2 = (const bf16*)(ws + WS_WF2) + (size_t)L * D * FF;
            { pg8::Gemm g{hff, w2, MP, D, FF}; pg8::StaticOrder S; S.init(MP, D, G, bid, WGM_G);
              if (NREP(9) == 2) { EpiResid E2{hb, (bf16*)(ws + WS_DUMMY + 64 * MiB), (float*)(ws + WS_DUMMY + 96 * MiB)}; pg8::gemm_phase<EpiResid, pg8::StaticOrder, true, true>(ring, g, S, E2);
                  SEpiResid E3{(float*)(ws + WS_DUMMY + 98 * MiB), (bf16*)(ws + WS_DUMMY + 99 * MiB)}; skinny_gemm<false, 16, SEpiResid>(lds, hffs, FF, w2, D, bid, G, E3); }
              EpiResid E{hb, hb, ssq};
              pg8::gemm_phase<EpiResid, pg8::StaticOrder, true, true>(ring, g, S, E); }
            { SEpiResid E{hs, hsb}; skinny_gemm<false, 16, SEpiResid>(lds, hffs, FF, w2, D, bid, G, E); }
            SEAM(pb + 6);
        }
    }
    if (SITE(10) && IN(29)) for (int rep = 0; rep < NREP(10); ++rep) final_norm(bid, G);
#undef IN
#undef SEAM
#undef LOCALS
}

extern "C" void kernel_launch(void* const* d_in, const int* in_sizes, int n_in, void* d_out, int out_size, void* d_ws, size_t ws_size, hipStream_t stream) {
    static int grid = 0;
    if (grid == 0) {
        if (n_in != 25 || (size_t)out_size != O_END || ws_size < WS_END + 100 * MiB) { fprintf(stderr, "kernel_launch: unexpected shapes (n_in %d out %d ws %zu)\n", n_in, out_size, ws_size); grid = -1; return; }
        int dev = 0, cus = 0, per_cu = 0;
        if (hipGetDevice(&dev) != hipSuccess || hipDeviceGetAttribute(&cus, hipDeviceAttributeMultiprocessorCount, dev) != hipSuccess) { grid = -1; return; }
        if (hipFuncSetAttribute((const void*)mega_fwd, hipFuncAttributeMaxDynamicSharedMemorySize, LDS_BYTES) != hipSuccess) { fprintf(stderr, "kernel_launch: hipFuncSetAttribute failed\n"); grid = -1; return; }
        if (hipOccupancyMaxActiveBlocksPerMultiprocessor(&per_cu, (const void*)mega_fwd, 512, LDS_BYTES) != hipSuccess || per_cu < 1) fprintf(stderr, "kernel_launch: occupancy query says %d\n", per_cu);
        (void)hipGetLastError();
        grid = cus;
    }
    if (grid < 0) return;
    (void)hipMemsetAsync((char*)d_ws + WS_CTL, 0, CTL_ZERO_BYTES, stream);
    Args a{};
    for (int i = 0; i < 25; ++i) a.in[i] = d_in[i];
    a.out = (float*)d_out; a.ws = (unsigned char*)d_ws;
#if MK_ONE_LAUNCH
#ifndef PROBE_PRE
#define PROBE_PRE 0
#endif
    if (PROBE_PRE > 0) {
        a.ph_lo = 0; a.ph_hi = PROBE_PRE; hipLaunchKernelGGL(mega_fwd, dim3(grid), dim3(512), LDS_BYTES, stream, a);
        (void)hipMemsetAsync((char*)d_ws + WS_CTL, 0, CTL_ZERO_BYTES, stream); }
    a.ph_lo = 0; a.ph_hi = N_PHASES;
    hipLaunchKernelGGL(mega_fwd, dim3(grid), dim3(512), LDS_BYTES, stream, a);
#else
    for (int ph = 0; ph < N_PHASES; ++ph) {
        if (ph >= 1 && ph <= 28) { const int L = (ph - 1) / 7, loc = (ph - 1) % 7; if ((L & 1) && (loc == 2 || loc == 3)) continue; }
        a.ph_lo = ph; a.ph_hi = ph + 1;
        hipLaunchKernelGGL(mega_fwd, dim3(grid), dim3(512), LDS_BYTES, stream, a);
    }
#endif
}
```

```cpp
#include <hip/hip_runtime.h>
#include <cstdio>
#include <cstdint>

#ifndef MK_ONE_LAUNCH
#define MK_ONE_LAUNCH 1
#endif

#define DI __device__ __forceinline__
#define LAS __attribute__((address_space(3)))
#define GAS __attribute__((address_space(1)))
typedef unsigned short bf16;
typedef short bf16x8 __attribute__((ext_vector_type(8)));
typedef short s16x4 __attribute__((ext_vector_type(4)));
typedef float f32x4 __attribute__((ext_vector_type(4)));
typedef float f32x2 __attribute__((ext_vector_type(2)));
typedef unsigned u32x4 __attribute__((ext_vector_type(4)));
typedef unsigned u32x2 __attribute__((ext_vector_type(2)));
typedef unsigned long long u64;

constexpr int D = 1024, BATCH = 4, SEQ = 4096, MP = BATCH * SEQ, DB = 32, PAST = 8192, NPAGES = 64, NPOOL = 2560;
constexpr int ABC = 3352, ABP = 3584, FF = 4096;
constexpr float EPS = 1e-6f;
constexpr int C_Q = 0, C_F = 512, C_I = 1024, C_G = 1536, C_QB = 2048, C_CMP = 2560, C_SEL = 2816, C_WIN = 3072, C_GATE = 3328;

constexpr size_t O_YP = 0, O_YS = 16777216, O_CMP_P = O_YS + 32768, O_CMP_S = O_CMP_P + 8388608, O_SEL_P = O_CMP_S + 16384, O_SEL_S = O_SEL_P + 8388608,
                 O_WIN_P = O_SEL_S + 16384, O_WIN_S = O_WIN_P + 1048576, O_HG_P = O_WIN_S + 8388608, O_HG_S = O_HG_P + 524288, O_CV_S = O_HG_S + 4194304, O_END = O_CV_S + 65536;

constexpr size_t MiB = 1u << 20;
constexpr size_t WS_CTL = 0, CTL_ZERO_BYTES = 1 * MiB;
constexpr size_t WS_WINAB = 2 * MiB, WS_WOUTAB = 16 * MiB, WS_WINC = 20 * MiB, WS_WOUTC = 28 * MiB, WS_WF1 = 32 * MiB, WS_WF2 = 64 * MiB, WS_WC1 = 96 * MiB, WS_WC2 = 98 * MiB,
                 WS_TRIL = 99 * MiB, WS_SMALL = 100 * MiB, WS_HP = 104 * MiB, WS_HB = 168 * MiB, WS_SSQ = 200 * MiB, WS_VSTAT = 201 * MiB, WS_ZB = 204 * MiB, WS_HFF = 316 * MiB,
                 WS_OC = 444 * MiB, WS_LT = 476 * MiB, WS_DL = 540 * MiB, WS_KCP = 541 * MiB, WS_KCS = 542 * MiB, WS_SMP = 558 * MiB, WS_END = 560 * MiB, WS_DUMMY = 560 * MiB;
constexpr size_t WS_MSK = WS_SMALL + 1 * MiB;
constexpr size_t SMP_HS = 0, SMP_ZS = 128 * 1024, SMP_OCS = 576 * 1024, SMP_HFFS = 704 * 1024, SMP_UVS = 1216 * 1024, SMP_HSB = 1472 * 1024;

constexpr int LDS_BYTES = 163840;
constexpr int MISC_OFF = LDS_BYTES - 64;

DI unsigned pk2(float lo, float hi) { typedef __bf16 bf2 __attribute__((ext_vector_type(2))); f32x2 v = {lo, hi}; bf2 b = __builtin_convertvector(v, bf2); return __builtin_bit_cast(unsigned, b); }
DI bf16 f2bf(float x) { return (bf16)(pk2(x, 0.f) & 0xffffu); }
DI float bf2f(bf16 h) { return __uint_as_float((unsigned)h << 16); }
DI float bflo(unsigned u) { return __uint_as_float(u << 16); }
DI float bfhi(unsigned u) { return __uint_as_float(u & 0xffff0000u); }
DI float sigmoidf_(float x) { return __builtin_amdgcn_rcpf(1.f + __expf(-x)); }
DI float siluf_(float x) { return x * __builtin_amdgcn_rcpf(1.f + __expf(-x)); }
DI float gelu_tanh(float x) { const float u = 0.7978845608028654f * (x + 0.044715f * x * x * x); return x * __builtin_amdgcn_rcpf(1.f + __expf(-2.f * u)); }
DI float wave_sum(float v) {
#pragma unroll
    for (int o = 1; o < 64; o <<= 1) v += __shfl_xor(v, o);
    return v;
}
DI float wave_max(float v) {
#pragma unroll
    for (int o = 1; o < 64; o <<= 1) v = fmaxf(v, __shfl_xor(v, o));
    return v;
}
DI float fmax2(float a, float b) { float r; asm("v_max_f32 %0, %1, %2" : "=v"(r) : "v"(a), "v"(b)); return r; }
DI float fmax3(float a, float b, float c) { float r; asm("v_max3_f32 %0, %1, %2, %3" : "=v"(r) : "v"(a), "v"(b), "v"(c)); return r; }
DI float quad_max(float v) {
    auto a = __builtin_amdgcn_permlane16_swap(__float_as_uint(v), __float_as_uint(v), false, false); v = fmax2(__uint_as_float(a[0]), __uint_as_float(a[1]));
    auto b = __builtin_amdgcn_permlane32_swap(__float_as_uint(v), __float_as_uint(v), false, false); return fmax2(__uint_as_float(b[0]), __uint_as_float(b[1]));
}
DI float quad_sum(float v) {
    auto a = __builtin_amdgcn_permlane16_swap(__float_as_uint(v), __float_as_uint(v), false, false); v = __uint_as_float(a[0]) + __uint_as_float(a[1]);
    auto b = __builtin_amdgcn_permlane32_swap(__float_as_uint(v), __float_as_uint(v), false, false); return __uint_as_float(b[0]) + __uint_as_float(b[1]);
}
DI bf16x8 pack8(f32x4 a, f32x4 b) { u32x4 p; p.x = pk2(a.x, a.y); p.y = pk2(a.z, a.w); p.z = pk2(b.x, b.y); p.w = pk2(b.z, b.w); return __builtin_bit_cast(bf16x8, p); }
DI int otid() { int t = threadIdx.x; asm volatile("" : "+v"(t)); return t; }
#define MFMA16(a, b, c) __builtin_amdgcn_mfma_f32_16x16x32_bf16((a), (b), (c), 0, 0, 0)
DI s16x4 vtr(const bf16* p) { return __builtin_bit_cast(s16x4, __builtin_amdgcn_ds_read_tr16_b64_v4i16((LAS s16x4*)(LAS char*)p)); }
DI bf16x8 tr_frag(const bf16* img, int stride, int k0, int c0, int r16, int quad) {
    const bf16* p = img + (k0 + quad * 8 + (r16 >> 2)) * stride + c0 + (r16 & 3) * 4;
    const s16x4 lo = vtr(p), hi = vtr(p + 4 * stride);
    return __builtin_shufflevector(lo, hi, 0, 1, 2, 3, 4, 5, 6, 7);
}

namespace pg8 {
#define PG8_LAS __attribute__((address_space(3)))
constexpr int BM = 256, BK = 64, HALF = 128, HTB = HALF * BK * 2, STAGE_BYTES = 8 * HTB, NXCD = 8, WGM = 4;
__host__ __device__ __forceinline__ int lds_byte(int r, int c) { const int st = (r >> 4) * 2 + (c >> 5), rr = r & 15, cc = c & 31, ob = rr * 64 + cc * 2; return st * 1024 + (ob ^ (((ob >> 9) & 1) << 5)); }
__host__ __device__ __forceinline__ void stage_rc(int b, int& R, int& C) { const int st = b / 1024, sb = b % 1024, swz = sb ^ (((sb >> 9) & 1) << 5); R = (st >> 1) * 16 + swz / 64; C = (st & 1) * 32 + (swz % 64) / 2; }
__host__ __device__ __forceinline__ int perm32(int rho) { const int n = rho >> 4, i = rho & 15; return 8 * (i >> 2) + 4 * n + (i & 3); }
struct Unit { int pm, pn; };
struct Gemm { const bf16* A; const bf16* Bt; int M, N, K; };
struct StaticOrder {
    int nM, nN, nwg, G, c, wgm;
    __host__ __device__ void init(int M, int N, int G_, int c_, int wgm_ = WGM) { nM = M / BM; nN = N / BM; nwg = nM * nN; G = G_; c = c_; wgm = wgm_; }
    __host__ __device__ bool next(int i, Unit& u) const {
        const long L = (long)i * G + c; if (L >= nwg) return false;
        int wgid = (int)L; { const int q = nwg / NXCD, r = nwg % NXCD, xcd = wgid % NXCD, off = wgid / NXCD; wgid = (xcd < r ? xcd * (q + 1) : r * (q + 1) + (xcd - r) * q) + off; }
        const int nig = wgm * nN, gid = wgid / nig, fm = gid * wgm, gsz = (nM - fm) < wgm ? (nM - fm) : wgm;
        u.pm = fm + ((wgid % nig) % gsz); u.pn = (wgid % nig) / gsz; return true;
    }
    __device__ __forceinline__ void a_ready(const Unit&) const {}
    __device__ __forceinline__ void done(const Unit&) const {}
};
template <class Epi, class Sched, bool ALIGN_EPI = false, bool SP2 = false>
__device__ __forceinline__ void gemm_phase(PG8_LAS unsigned char* lds, const Gemm g, const Sched& S, const Epi& E) {
    const int tid = otid(), wid = __builtin_amdgcn_readfirstlane(tid >> 6), lane = tid & 63, wr = wid >> 2, wc = wid & 3, fr = lane & 15, fq = lane >> 4;
    const int K = g.K, nt = K / BK;
    unsigned voffA[2], voffB[2];
#pragma unroll
    for (int i = 0; i < 2; ++i) { int R, C; stage_rc(tid * 16 + i * 8192, R, C); const int Rb = Epi::PERM ? ((R & ~31) + perm32(R & 31)) : R;
        voffA[i] = (unsigned)(R * K + C) * 2u; voffB[i] = (unsigned)(Rb * K + C) * 2u; }
    const size_t kstep = (size_t)(BK * 2);
    const size_t hstep = (size_t)HALF * K * 2;
    const size_t tstep = 2 * hstep;
    const unsigned ldsw = (unsigned)wid * 1024u;
    const int aoff = lds_byte(wr * 64 + fr, fq * 8), boff = lds_byte(wc * 32 + fr, fq * 8);
#define PG8_SA(b, h) (((b) * 2 + (h)) * HTB)
#define PG8_SB(b, h) ((4 + (b) * 2 + (h)) * HTB)
#define PG8_STAGE(bufoff, gbase, voff) do { _Pragma("unroll") for (int _i = 0; _i < 2; ++_i) \
        __builtin_amdgcn_global_load_lds((const unsigned*)((const char*)(gbase) + (voff)[_i]), (PG8_LAS unsigned*)(lds + (bufoff) + ldsw + _i * 8192), 16, 0, 0); } while (0)
#define PG8_LDA(dst, b, h) do { _Pragma("unroll") for (int m = 0; m < 4; ++m) _Pragma("unroll") for (int k = 0; k < 2; ++k) dst[m][k] = *(const PG8_LAS bf16x8*)(lds + PG8_SA(b, h) + aoff + m * 2048 + k * 1024); } while (0)
#define PG8_LDB(dst, b, h) do { _Pragma("unroll") for (int n = 0; n < 2; ++n) _Pragma("unroll") for (int k = 0; k < 2; ++k) dst[n][k] = *(const PG8_LAS bf16x8*)(lds + PG8_SB(b, h) + boff + n * 2048 + k * 1024); } while (0)
#define PG8_MMA(ai, bj, At, Bt) do { __builtin_amdgcn_s_setprio(1); _Pragma("unroll") for (int m = 0; m < 4; ++m) _Pragma("unroll") for (int n = 0; n < 2; ++n) _Pragma("unroll") for (int k = 0; k < 2; ++k) \
        acc[ai][bj][m][n] = __builtin_amdgcn_mfma_f32_16x16x32_bf16(Bt[n][k], At[m][k], acc[ai][bj][m][n], 0, 0, 0); __builtin_amdgcn_s_setprio(0); } while (0)
#define PG8_WAIT_V(n) asm volatile("s_waitcnt vmcnt(" #n ")" ::: "memory")
#define PG8_WAIT_L(n) asm volatile("s_waitcnt lgkmcnt(" #n ")" ::: "memory")
#define PG8_BAR __builtin_amdgcn_s_barrier()
#define PG8_SCHED __builtin_amdgcn_sched_barrier(0)
    Unit cur, nxt; int ui = 0;
    if (!S.next(0, cur)) return;
    f32x4 acc[2][2][4][2];
#pragma unroll
    for (int a = 0; a < 2; ++a)
#pragma unroll
        for (int b = 0; b < 2; ++b)
#pragma unroll
            for (int m = 0; m < 4; ++m)
#pragma unroll
                for (int n = 0; n < 2; ++n) acc[a][b][m][n] = (f32x4){0.f, 0.f, 0.f, 0.f};
    bf16x8 At[4][2], B0[2][2], B1[2][2];
    const char* cA = (const char*)g.A + (size_t)cur.pm * tstep; const char* cB = (const char*)g.Bt + (size_t)cur.pn * tstep;
    S.a_ready(cur);
    if constexpr (SP2) {
        PG8_STAGE(PG8_SB(0, 0), cB, voffB); PG8_STAGE(PG8_SB(0, 1), cB + hstep, voffB); PG8_STAGE(PG8_SA(0, 0), cA, voffA); PG8_STAGE(PG8_SA(0, 1), cA + hstep, voffA);
        if (wr == 1) PG8_BAR;
        PG8_WAIT_V(2); PG8_BAR;
        PG8_STAGE(PG8_SB(1, 0), cB + kstep, voffB); PG8_STAGE(PG8_SA(1, 0), cA + kstep, voffA); PG8_STAGE(PG8_SB(1, 1), cB + hstep + kstep, voffB);
        PG8_WAIT_V(6); PG8_BAR;
    } else {
        PG8_STAGE(PG8_SB(0, 0), cB, voffB); PG8_STAGE(PG8_SA(0, 0), cA, voffA); PG8_STAGE(PG8_SB(0, 1), cB + hstep, voffB); PG8_STAGE(PG8_SA(0, 1), cA + hstep, voffA);
        if (wr == 1) PG8_BAR;
        PG8_WAIT_V(4); PG8_BAR;
        PG8_STAGE(PG8_SB(1, 0), cB + kstep, voffB); PG8_STAGE(PG8_SA(1, 0), cA + kstep, voffA); PG8_STAGE(PG8_SB(1, 1), cB + hstep + kstep, voffB);
        PG8_WAIT_V(6); PG8_BAR;
    }
    for (;;) {
        const bool has_next = S.next(ui + 1, nxt);
        const char* nA = has_next ? (const char*)g.A + (size_t)nxt.pm * tstep : cA; const char* nB = has_next ? (const char*)g.Bt + (size_t)nxt.pn * tstep : cB;
        for (int t = 0; t < nt; t += 2) {
            const bool last = (t == nt - 2);
            const char* a1 = cA + (size_t)(t + 1) * kstep;
            const char* a2 = last ? nA : cA + (size_t)(t + 2) * kstep; const char* b2 = last ? nB : cB + (size_t)(t + 2) * kstep;
            const char* a3 = a2 + kstep; const char* b3 = b2 + kstep;
            if (last && has_next) S.a_ready(nxt);
            if constexpr (SP2) {
            PG8_LDB(B0, 0, 0); PG8_LDB(B1, 0, 1); PG8_SCHED; PG8_LDA(At, 0, 0); PG8_STAGE(PG8_SA(1, 1), a1 + hstep, voffA);
            PG8_WAIT_V(8); PG8_WAIT_L(0); PG8_BAR; PG8_MMA(0, 0, At, B0); PG8_MMA(0, 1, At, B1); PG8_BAR; PG8_SCHED;
            PG8_LDA(At, 0, 1); PG8_STAGE(PG8_SB(0, 0), b2, voffB); PG8_STAGE(PG8_SB(0, 1), b2 + hstep, voffB); PG8_STAGE(PG8_SA(0, 0), a2, voffA);
            PG8_WAIT_V(8); PG8_WAIT_L(0); PG8_BAR; PG8_MMA(1, 0, At, B0); PG8_MMA(1, 1, At, B1); PG8_BAR; PG8_SCHED;
            PG8_LDB(B0, 1, 0); PG8_LDB(B1, 1, 1); PG8_SCHED; PG8_LDA(At, 1, 0); PG8_STAGE(PG8_SA(0, 1), a2 + hstep, voffA);
            PG8_WAIT_V(8); PG8_WAIT_L(0); PG8_BAR; PG8_MMA(0, 0, At, B0); PG8_MMA(0, 1, At, B1); PG8_BAR; PG8_SCHED;
            PG8_LDA(At, 1, 1); PG8_STAGE(PG8_SB(1, 0), b3, voffB); PG8_STAGE(PG8_SB(1, 1), b3 + hstep, voffB); PG8_STAGE(PG8_SA(1, 0), a3, voffA);
            PG8_WAIT_V(8); PG8_WAIT_L(0); PG8_BAR; PG8_MMA(1, 0, At, B0); PG8_MMA(1, 1, At, B1); PG8_BAR; PG8_SCHED;
            } else {
            PG8_LDB(B0, 0, 0); PG8_SCHED; PG8_LDA(At, 0, 0); PG8_STAGE(PG8_SA(1, 1), a1 + hstep, voffA);
            PG8_WAIT_L(8); PG8_BAR; PG8_WAIT_L(0); PG8_MMA(0, 0, At, B0); PG8_BAR; PG8_SCHED;
            PG8_LDB(B1, 0, 1); PG8_STAGE(PG8_SB(0, 0), b2, voffB);
            PG8_BAR; PG8_WAIT_L(0); PG8_MMA(0, 1, At, B1); PG8_BAR;
            PG8_LDA(At, 0, 1); PG8_STAGE(PG8_SA(0, 0), a2, voffA);
            PG8_BAR; PG8_WAIT_L(0); PG8_MMA(1, 0, At, B0); PG8_BAR; PG8_SCHED;
            PG8_STAGE(PG8_SB(0, 1), b2 + hstep, voffB);
            PG8_WAIT_V(6); PG8_BAR; PG8_MMA(1, 1, At, B1); PG8_BAR;
            PG8_LDB(B0, 1, 0); PG8_SCHED; PG8_LDA(At, 1, 0); PG8_STAGE(PG8_SA(0, 1), a2 + hstep, voffA);
            PG8_WAIT_L(8); PG8_BAR; PG8_WAIT_L(0); PG8_MMA(0, 0, At, B0); PG8_BAR; PG8_SCHED;
            PG8_LDB(B1, 1, 1); PG8_STAGE(PG8_SB(1, 0), b3, voffB);
            PG8_BAR; PG8_WAIT_L(0); PG8_MMA(0, 1, At, B1); PG8_BAR;
            PG8_LDA(At, 1, 1); PG8_STAGE(PG8_SA(1, 0), a3, voffA);
            PG8_BAR; PG8_WAIT_L(0); PG8_MMA(1, 0, At, B0); PG8_BAR; PG8_SCHED;
            PG8_STAGE(PG8_SB(1, 1), b3 + hstep, voffB);
            PG8_WAIT_V(6); PG8_BAR; PG8_MMA(1, 1, At, B1); PG8_BAR;
            }
        }
        if constexpr (ALIGN_EPI) { if (wr == 0) PG8_BAR; }
        if constexpr (!Epi::AFTER_DRAIN) { E(acc, cur, wr, wc, fr, fq); S.done(cur); }
        if (!has_next) break;
#pragma unroll
        for (int a = 0; a < 2; ++a)
#pragma unroll
            for (int b = 0; b < 2; ++b)
#pragma unroll
                for (int m = 0; m < 4; ++m)
#pragma unroll
                    for (int n = 0; n < 2; ++n) acc[a][b][m][n] = (f32x4){0.f, 0.f, 0.f, 0.f};
        cur = nxt; cA = nA; cB = nB; ++ui;
        if constexpr (ALIGN_EPI) { if (wr == 1) PG8_BAR; }
    }
    PG8_WAIT_V(0);
    if constexpr (!ALIGN_EPI) { if (wr == 0) PG8_BAR; }
    PG8_BAR;
#undef PG8_SA
#undef PG8_SB
#undef PG8_STAGE
#undef PG8_LDA
#undef PG8_LDB
#undef PG8_MMA
#undef PG8_WAIT_V
#undef PG8_WAIT_L
#undef PG8_BAR
#undef PG8_SCHED
}
}
using pg8::Unit;

DI float row_rstd16(const float* ssq, int row, int fq) {
    const f32x4 a = *(const f32x4*)(ssq + (size_t)row * 16 + fq * 4);
    const float s = quad_sum((a.x + a.y) + (a.z + a.w));
    return rsqrtf(s * (1.f / 1024.f) + EPS);
}
struct EpiInAB {
    static constexpr bool PERM = true, AFTER_DRAIN = false;
    bf16* zb; const float* ssq; float* o_cmp; float* o_sel; float* o_win;
    DI void operator()(const f32x4 (&acc)[2][2][4][2], const Unit& u, int wr, int wc, int fr, int fq) const {
#pragma unroll
        for (int ai = 0; ai < 2; ++ai)
#pragma unroll
            for (int m = 0; m < 4; ++m) {
                const int row = u.pm * 256 + ai * 128 + wr * 64 + m * 16 + fr; const float rs = row_rstd16(ssq, row, fq);
#pragma unroll
                for (int bj = 0; bj < 2; ++bj) {
                    const int cl = bj * 128 + wc * 32 + fq * 8, col = u.pn * 256 + cl;
                    const f32x4 v0 = acc[ai][bj][m][0] * rs, v1 = acc[ai][bj][m][1] * rs;
                    u32x4 w; w.x = pk2(v0[0], v0[1]); w.y = pk2(v0[2], v0[3]); w.z = pk2(v1[0], v1[1]); w.w = pk2(v1[2], v1[3]);
                    *(u32x4*)(zb + (size_t)row * ABP + col) = w;
                    if (u.pn == 10) { float* o = o_cmp + (size_t)row * 256 + cl; *(f32x4*)o = v0; *(f32x4*)(o + 4) = v1; }
                    else if (u.pn == 11) { float* o = o_sel + (size_t)row * 256 + cl; *(f32x4*)o = v0; *(f32x4*)(o + 4) = v1; }
                    else if (u.pn == 12) { const int t = row & 4095, b = row >> 12; if (t >= SEQ - 512) { float* o = o_win + ((size_t)b * 512 + (t - (SEQ - 512))) * 256 + cl; *(f32x4*)o = v0; *(f32x4*)(o + 4) = v1; } }
                }
            }
    }
};
struct EpiResid {
    static constexpr bool PERM = true, AFTER_DRAIN = false;
    const bf16* res; bf16* hb; float* ssq;
    DI void operator()(const f32x4 (&acc)[2][2][4][2], const Unit& u, int wr, int wc, int fr, int fq) const {
#pragma unroll
        for (int ai = 0; ai < 2; ++ai)
#pragma unroll
            for (int m = 0; m < 4; ++m) {
                const int row = u.pm * 256 + ai * 128 + wr * 64 + m * 16 + fr; float ss = 0.f;
#pragma unroll
                for (int bj = 0; bj < 2; ++bj) {
                    const int col = u.pn * 256 + bj * 128 + wc * 32 + fq * 8; const size_t o = (size_t)row * D + col;
                    const u32x4 r8 = *(const u32x4*)(res + o);
                    const f32x4 v0 = acc[ai][bj][m][0] + (f32x4){bflo(r8.x), bfhi(r8.x), bflo(r8.y), bfhi(r8.y)}, v1 = acc[ai][bj][m][1] + (f32x4){bflo(r8.z), bfhi(r8.z), bflo(r8.w), bfhi(r8.w)};
                    u32x4 w; w.x = pk2(v0[0], v0[1]); w.y = pk2(v0[2], v0[3]); w.z = pk2(v1[0], v1[1]); w.w = pk2(v1[2], v1[3]);
                    *(u32x4*)(hb + o) = w;
                    ss += (v0[0] * v0[0] + v0[1] * v0[1]) + (v0[2] * v0[2] + v0[3] * v0[3]) + (v1[0] * v1[0] + v1[1] * v1[1]) + (v1[2] * v1[2] + v1[3] * v1[3]);
                }
                ss = quad_sum(ss);
                if (fq == 0) ssq[(size_t)row * 16 + u.pn * 4 + wc] = ss;
            }
    }
};
struct EpiFFN1 {
    static constexpr bool PERM = true, AFTER_DRAIN = false;
    bf16* hff; const float* ssq;
    DI void operator()(const f32x4 (&acc)[2][2][4][2], const Unit& u, int wr, int wc, int fr, int fq) const {
#pragma unroll
        for (int ai = 0; ai < 2; ++ai)
#pragma unroll
            for (int m = 0; m < 4; ++m) {
                const int row = u.pm * 256 + ai * 128 + wr * 64 + m * 16 + fr; const float rs = row_rstd16(ssq, row, fq);
#pragma unroll
                for (int bj = 0; bj < 2; ++bj) {
                    const int col = u.pn * 256 + bj * 128 + wc * 32 + fq * 8;
                    f32x4 v0 = acc[ai][bj][m][0] * rs, v1 = acc[ai][bj][m][1] * rs;
#pragma unroll
                    for (int i = 0; i < 4; ++i) { const float a = fmaxf(v0[i], 0.f), b = fmaxf(v1[i], 0.f); v0[i] = a * a; v1[i] = b * b; }
                    u32x4 w; w.x = pk2(v0[0], v0[1]); w.y = pk2(v0[2], v0[3]); w.z = pk2(v1[0], v1[1]); w.w = pk2(v1[2], v1[3]);
                    *(u32x4*)(hff + (size_t)row * FF + col) = w;
                }
            }
    }
};
struct EpiInC {
    static constexpr bool PERM = true, AFTER_DRAIN = false;
    bf16* ub; bf16* vb; const float* ssq; float* vstat;
    DI void operator()(const f32x4 (&acc)[2][2][4][2], const Unit& u, int wr, int wc, int fr, int fq) const {
        const bool isv = u.pn >= 4; bf16* dst = isv ? vb : ub; const int pn = isv ? u.pn - 4 : u.pn;
#pragma unroll
        for (int ai = 0; ai < 2; ++ai)
#pragma unroll
            for (int m = 0; m < 4; ++m) {
                const int row = u.pm * 256 + ai * 128 + wr * 64 + m * 16 + fr; const float rs = row_rstd16(ssq, row, fq); float s1 = 0.f, s2 = 0.f;
#pragma unroll
                for (int bj = 0; bj < 2; ++bj) {
                    const int col = pn * 256 + bj * 128 + wc * 32 + fq * 8;
                    f32x4 v0 = acc[ai][bj][m][0] * rs, v1 = acc[ai][bj][m][1] * rs;
#pragma unroll
                    for (int i = 0; i < 4; ++i) { v0[i] = gelu_tanh(v0[i]); v1[i] = gelu_tanh(v1[i]); s1 += v0[i] + v1[i]; s2 += v0[i] * v0[i] + v1[i] * v1[i]; }
                    u32x4 w; w.x = pk2(v0[0], v0[1]); w.y = pk2(v0[2], v0[3]); w.z = pk2(v1[0], v1[1]); w.w = pk2(v1[2], v1[3]);
                    *(u32x4*)(dst + (size_t)row * D + col) = w;
                }
                if (isv) { s1 = quad_sum(s1); s2 = quad_sum(s2);
                    if (fq == 0) *(f32x2*)(vstat + ((size_t)row * 16 + pn * 4 + wc) * 2) = (f32x2){s1, s2}; }
            }
    }
};

DI unsigned* ctl_words();
DI void publish_count(int idx) {
    asm volatile("s_waitcnt vmcnt(0)" ::: "memory");
    __syncthreads();
    if (threadIdx.x == 0) { __builtin_amdgcn_fence(__ATOMIC_RELEASE, "agent"); asm volatile("s_waitcnt vmcnt(0)" ::: "memory");
        __hip_atomic_fetch_add(ctl_words() + 4096 + 64 * idx, 1u, __ATOMIC_RELAXED, __HIP_MEMORY_SCOPE_AGENT); }
}
DI void wait_count(int idx, unsigned n) {
    if (threadIdx.x == 0) { unsigned* c = ctl_words() + 4096 + 64 * idx; unsigned sp = 0;
        while (__hip_atomic_load(c, __ATOMIC_RELAXED, __HIP_MEMORY_SCOPE_AGENT) < n) { __builtin_amdgcn_s_sleep(2); if (++sp > (1u << 22)) break; }
        __builtin_amdgcn_fence(__ATOMIC_ACQUIRE, "agent"); asm volatile("s_waitcnt vmcnt(0)" ::: "memory"); }
    __syncthreads();
}
DI float dot8sq(bf16x8 x) { const u32x4 u = __builtin_bit_cast(u32x4, x); float s = 0.f;
#pragma unroll
    for (int i = 0; i < 4; ++i) { const float a = bflo(u[i]), b = bfhi(u[i]); s += a * a + b * b; }
    return s; }
template <bool NORM, int KS, class Epi>
DI void skinny_gemm(unsigned char* lds, const bf16* A, int lda, const bf16* Wt, int N, int bid, int G, const Epi& E) {
    constexpr int K = KS * 32 * 8;
    float* red = (float*)lds; float* sred = red + 8 * 2 * 64 * 4;
    const int tid = otid(), wave = tid >> 6, lane = tid & 63, r16 = lane & 15, quad = lane >> 4, ksl = KS * 32;
    for (int task = bid; task < (N >> 4); task += G) {
        const int n0 = task * 16;
        f32x4 acc0 = {0.f, 0.f, 0.f, 0.f}, acc1 = {0.f, 0.f, 0.f, 0.f}; float ss0 = 0.f, ss1 = 0.f;
        const bf16* wrow = Wt + (size_t)(n0 + r16) * K + wave * ksl + quad * 8;
        const bf16* a0 = A + (size_t)r16 * lda + wave * ksl + quad * 8; const bf16* a1 = a0 + (size_t)16 * lda;
#pragma unroll
        for (int k0 = 0; k0 < KS; k0 += 8) {
            constexpr int NB = (KS < 8) ? KS : 8;
            bf16x8 bq[NB], x0[NB], x1[NB];
#pragma unroll
            for (int u = 0; u < NB; ++u) { bq[u] = *(const bf16x8*)(wrow + (k0 + u) * 32); x0[u] = *(const bf16x8*)(a0 + (k0 + u) * 32); x1[u] = *(const bf16x8*)(a1 + (k0 + u) * 32); }
#pragma unroll
            for (int u = 0; u < NB; ++u) { if (NORM) { ss0 += dot8sq(x0[u]); ss1 += dot8sq(x1[u]); } acc0 = MFMA16(x0[u], bq[u], acc0); acc1 = MFMA16(x1[u], bq[u], acc1); }
        }
        if (NORM) { ss0 = quad_sum(ss0); ss1 = quad_sum(ss1); if (quad == 0) { sred[wave * 32 + r16] = ss0; sred[wave * 32 + 16 + r16] = ss1; } }
        *(f32x4*)(red + ((wave * 2 + 0) * 64 + lane) * 4) = acc0; *(f32x4*)(red + ((wave * 2 + 1) * 64 + lane) * 4) = acc1;
        __syncthreads();
        if (tid < 128) {
            const int rt = tid >> 6, l = tid & 63; f32x4 s = {0.f, 0.f, 0.f, 0.f};
#pragma unroll
            for (int w = 0; w < 8; ++w) s += *(const f32x4*)(red + ((w * 2 + rt) * 64 + l) * 4);
#pragma unroll
            for (int i = 0; i < 4; ++i) { const int row = rt * 16 + (l >> 4) * 4 + i, col = n0 + (l & 15); float sc = 1.f;
                if (NORM) { float q = 0.f;
#pragma unroll
                    for (int w = 0; w < 8; ++w) q += sred[w * 32 + row];
                    sc = rsqrtf(q / (float)K + EPS); }
                E(row, col, s[i] * sc); }
        }
        __syncthreads();
    }
}
struct SEpiInAB { float* zs; float* o_cmp; float* o_sel;
    DI void operator()(int row, int col, float v) const { zs[row * ABP + col] = v; if (col >= C_CMP && col < C_SEL) o_cmp[row * 256 + col - C_CMP] = v; else if (col >= C_SEL && col < C_WIN) o_sel[row * 256 + col - C_SEL] = v; } };
struct SEpiResid { float* hs; bf16* hsb; DI void operator()(int row, int col, float v) const { const float r = hs[row * D + col] + v; hs[row * D + col] = r; hsb[row * D + col] = f2bf(r); } };
struct SEpiFFN1 { bf16* h; DI void operator()(int row, int col, float v) const { const float a = fmaxf(v, 0.f); h[row * FF + col] = f2bf(a * a); } };
struct SEpiInC { float* uv; DI void operator()(int row, int col, float v) const { uv[row * 2048 + col] = gelu_tanh(v); } };

#define XB_TMO      128
#define XB_XCNT(j)  (256  + 64 * (j))
#define XB_XSUB(j)  (1280 + 64 * (j))
#define XB_XGEN(j)  (2304 + 64 * (j))
#define XB_TOP      3328
#define XB_TOPGEN   3392
#define XCD_BAR_WORDS 3456
#define XB_SPIN_CAP (1u << 18)
__device__ __forceinline__ unsigned xb_ld(unsigned* p)              { return __hip_atomic_load(p, __ATOMIC_RELAXED, __HIP_MEMORY_SCOPE_AGENT); }
__device__ __forceinline__ unsigned xb_add(unsigned* p, unsigned v) { return __hip_atomic_fetch_add(p, v, __ATOMIC_RELAXED, __HIP_MEMORY_SCOPE_AGENT); }
__device__ __forceinline__ unsigned xb_xcc_id() { return (unsigned)__builtin_amdgcn_s_getreg((3 << 11) | 20) & 0xFu; }
#define XB_SPIN(cond, bar) do { unsigned _sp = 0; while (cond) { __builtin_amdgcn_s_sleep(1); \
    if ((++_sp & 255u) == 0u) { if (xb_ld(&(bar)[XB_TMO])) break; if (_sp > XB_SPIN_CAP) { atomicAdd(&(bar)[XB_TMO], 1u); break; } } } } while (0)
struct XcdBarrier { unsigned* bar; unsigned x; volatile LAS unsigned* st; };
__device__ __forceinline__ XcdBarrier xcd_barrier_post(unsigned* bar, volatile LAS unsigned* st) {
    XcdBarrier b; b.bar = bar; b.x = xb_xcc_id(); b.st = st;
    if (threadIdx.x == 0) (void)xb_add(&bar[XB_XCNT(b.x)], 1u);
    return b;
}
__device__ __forceinline__ void xcd_barrier_complete(unsigned* bar, unsigned x, unsigned& nloc, unsigned& nx) {
    const unsigned G = gridDim.x * gridDim.y * gridDim.z;
    unsigned sum, cnt, mine, sp = 0u;
    for (;;) {
        sum = 0u; cnt = 0u; mine = 0u;
#pragma unroll
        for (unsigned j = 0; j < 16; ++j) { const unsigned c = xb_ld(&bar[XB_XCNT(j)]); sum += c; cnt += (c > 0u) ? 1u : 0u; mine = (j == x) ? c : mine; }
        if (sum == G) break;
        __builtin_amdgcn_s_sleep(1);
        if ((++sp & 255u) == 0u) { if (xb_ld(&bar[XB_TMO])) break; if (sp > XB_SPIN_CAP) { atomicAdd(&bar[XB_TMO], 1u); break; } }
    }
    nloc = mine > 0u ? mine : 1u; nx = cnt > 0u ? cnt : 1u;
}
__device__ __forceinline__ void xcd_barrier(const XcdBarrier& b) {
    asm volatile("s_waitcnt vmcnt(0)" ::: "memory");
    __syncthreads();
    if (threadIdx.x == 0) {
        unsigned* bar = b.bar;
        __builtin_amdgcn_s_waitcnt(0);
        unsigned nloc = b.st[0], nx = b.st[1];
        if (nloc == 0u) { xcd_barrier_complete(bar, b.x, nloc, nx); b.st[0] = nloc; b.st[1] = nx; }
        const unsigned old = xb_add(&bar[XB_XSUB(b.x)], 1u);
        const unsigned gen = old / nloc;
        if (old + 1u == (gen + 1u) * nloc) {
            __builtin_amdgcn_fence(__ATOMIC_RELEASE, "agent");
            asm volatile("s_waitcnt vmcnt(0)" ::: "memory");
            const unsigned og = xb_add(&bar[XB_TOP], 1u);
            const unsigned tg = og / nx;
            if (og + 1u == (tg + 1u) * nx) xb_add(&bar[XB_TOPGEN], 1u);
            else XB_SPIN(xb_ld(&bar[XB_TOPGEN]) == tg, bar);
            __builtin_amdgcn_fence(__ATOMIC_ACQUIRE, "agent");
            xb_add(&bar[XB_XGEN(b.x)], 1u);
            asm volatile("s_waitcnt vmcnt(0)" ::: "memory");
        } else {
            XB_SPIN(xb_ld(&bar[XB_XGEN(b.x)]) == gen, bar);
            __builtin_amdgcn_fence(__ATOMIC_ACQUIRE, "agent");
            asm volatile("s_waitcnt vmcnt(0)" ::: "memory");
        }
    }
    __syncthreads();
}

DI void transpose_item(const float* W, int K, int N, bf16* WT, const float* gain, float* scr, int item, int nblk, int lane) {
    const int kb = item / nblk, nb = item % nblk, k0 = 64 * kb, n0 = 64 * nb;
    const int kr = lane >> 4, nc = (lane & 15) * 4; const bool ok = (n0 + nc) < N;
    f32x4 v[16];
#pragma unroll
    for (int i = 0; i < 16; ++i) v[i] = ok ? *(const f32x4*)(W + (size_t)(k0 + 4 * i + kr) * N + n0 + nc) : (f32x4){0.f, 0.f, 0.f, 0.f};
#pragma unroll
    for (int i = 0; i < 16; ++i) { const int kk = 4 * i + kr; f32x4 x = v[i]; if (gain) x = x * gain[k0 + kk]; *(f32x4*)(scr + kk * 68 + nc) = x; }
    asm volatile("s_waitcnt lgkmcnt(0)" ::: "memory");
    const int c = lane & 7;
#pragma unroll
    for (int j = 0; j < 8; ++j) { const int nn = (lane >> 3) + 8 * j; const float* s = scr + (8 * c) * 68 + nn;
        u32x4 o; o.x = pk2(s[0 * 68], s[1 * 68]); o.y = pk2(s[2 * 68], s[3 * 68]); o.z = pk2(s[4 * 68], s[5 * 68]); o.w = pk2(s[6 * 68], s[7 * 68]);
        *(u32x4*)(WT + (size_t)(n0 + nn) * K + k0 + 8 * c) = o; }
    asm volatile("s_waitcnt lgkmcnt(0)" ::: "memory");
}

struct Args { const void* in[25]; float* out; unsigned char* ws; int ph_lo, ph_hi; };
struct Ptrs {
    const float *x_prompt, *x_sample, *cache_cmp, *cache_sel, *state_win, *state_hgrn; const int* page_table;
    const float *norm_mix, *norm_ffn, *norm_final, *w_in_ab, *w_out_ab, *hgrn_lb, *hgrn_norm, *cmp_pe, *cmp_w1, *cmp_w2, *w_in_c, *ln_c_g, *ln_c_b, *w_s, *b_s, *w_out_c, *w_ffn1, *w_ffn2;
    float* out; unsigned char* ws;
};
typedef const __attribute__((address_space(4))) Args* KArgs;
DI Ptrs get_ptrs() {
    KArgs a = (KArgs)__builtin_amdgcn_kernarg_segment_ptr(); asm volatile("" : "+s"(a));
    Ptrs P;
    P.x_prompt = (const float*)a->in[0]; P.x_sample = (const float*)a->in[1]; P.cache_cmp = (const float*)a->in[2]; P.cache_sel = (const float*)a->in[3];
    P.state_win = (const float*)a->in[4]; P.state_hgrn = (const float*)a->in[5]; P.page_table = (const int*)a->in[6];
    P.norm_mix = (const float*)a->in[7]; P.norm_ffn = (const float*)a->in[8]; P.norm_final = (const float*)a->in[9]; P.w_in_ab = (const float*)a->in[10]; P.w_out_ab = (const float*)a->in[11];
    P.hgrn_lb = (const float*)a->in[12]; P.hgrn_norm = (const float*)a->in[13]; P.cmp_pe = (const float*)a->in[14]; P.cmp_w1 = (const float*)a->in[15]; P.cmp_w2 = (const float*)a->in[16];
    P.w_in_c = (const float*)a->in[17]; P.ln_c_g = (const float*)a->in[18]; P.ln_c_b = (const float*)a->in[19]; P.w_s = (const float*)a->in[20]; P.b_s = (const float*)a->in[21];
    P.w_out_c = (const float*)a->in[22]; P.w_ffn1 = (const float*)a->in[23]; P.w_ffn2 = (const float*)a->in[24]; P.out = a->out; P.ws = a->ws;
    return P;
}

DI unsigned* ctl_words() { return (unsigned*)(get_ptrs().ws + WS_CTL); }
DI void prologue(unsigned char* lds, int bid, int G) {
    const Ptrs P = get_ptrs();
    const int tid = otid(), wave = tid >> 6, lane = tid & 63;
    float* scr = (float*)lds + wave * (64 * 68);
    const int gw = bid * 8 + wave, NGW = G * 8;
    unsigned char* ws = P.ws;
    for (int t = bid; t < 128; t += G) {
        const int q = t >> 5, part = t & 31;
        float* part_l = (float*)lds + 8 * 64 * 68;
        const float* pe = P.cmp_pe + (size_t)q * 2048 + part * 64 + wave * 8; const float* w1 = P.cmp_w1 + ((size_t)q * 2048 + part * 64 + wave * 8) * 128;
        float a0 = 0.f, a1 = 0.f;
#pragma unroll
        for (int f = 0; f < 8; ++f) { const float p = pe[f]; a0 += p * w1[(size_t)f * 128 + lane]; a1 += p * w1[(size_t)f * 128 + 64 + lane]; }
        part_l[wave * 128 + lane] = a0; part_l[wave * 128 + 64 + lane] = a1;
        __syncthreads();
        if (tid < 128) { float s = 0.f; for (int w = 0; w < 8; ++w) s += part_l[w * 128 + tid]; ((float*)(ws + WS_SMALL + 8192))[(size_t)t * 128 + tid] = s; }
        publish_count(980 + q);
    }
    constexpr int I_INAB = 16 * 56, I_OUTAB = 16 * 16, I_INC = 16 * 32, I_OUTC = 16 * 16, I_F1 = 16 * 64, I_F2 = 64 * 16, I_C1 = 32 * 2, I_C2 = 2 * 1;
    constexpr int NITEMS = 2 * (I_INAB + I_OUTAB + I_INC + I_OUTC) + 4 * (I_F1 + I_F2) + 4 * I_C1;
    for (int it = gw; it < NITEMS; it += NGW) {
        int r = it;
        if (r < 4 * I_F1) { const int l = r / I_F1; transpose_item(P.w_ffn1 + (size_t)l * D * FF, D, FF, (bf16*)(ws + WS_WF1) + (size_t)l * FF * D, P.norm_ffn + l * D, scr, r % I_F1, 64, lane); continue; } r -= 4 * I_F1;
        if (r < 4 * I_F2) { const int l = r / I_F2; transpose_item(P.w_ffn2 + (size_t)l * FF * D, FF, D, (bf16*)(ws + WS_WF2) + (size_t)l * D * FF, nullptr, scr, r % I_F2, 16, lane); continue; } r -= 4 * I_F2;
        if (r < 2 * I_INAB) { const int j = r / I_INAB; transpose_item(P.w_in_ab + (size_t)j * D * ABC, D, ABC, (bf16*)(ws + WS_WINAB) + (size_t)j * ABP * D, P.norm_mix + (2 * j) * D, scr, r % I_INAB, 56, lane); continue; } r -= 2 * I_INAB;
        if (r < 2 * I_OUTAB) { const int j = r / I_OUTAB; transpose_item(P.w_out_ab + (size_t)j * D * D, D, D, (bf16*)(ws + WS_WOUTAB) + (size_t)j * D * D, nullptr, scr, r % I_OUTAB, 16, lane); continue; } r -= 2 * I_OUTAB;
        if (r < 2 * I_INC) { const int j = r / I_INC; transpose_item(P.w_in_c + (size_t)j * D * 2048, D, 2048, (bf16*)(ws + WS_WINC) + (size_t)j * 2048 * D, P.norm_mix + (2 * j + 1) * D, scr, r % I_INC, 32, lane); continue; } r -= 2 * I_INC;
        if (r < 2 * I_OUTC) { const int j = r / I_OUTC; transpose_item(P.w_out_c + (size_t)j * D * D, D, D, (bf16*)(ws + WS_WOUTC) + (size_t)j * D * D, nullptr, scr, r % I_OUTC, 16, lane); continue; } r -= 2 * I_OUTC;
        { const int q = r / I_C1; transpose_item(P.cmp_w1 + (size_t)q * 2048 * 128, 2048, 128, (bf16*)(ws + WS_WC1) + (size_t)q * 128 * 2048, nullptr, scr, r % I_C1, 2, lane); }
    }
    for (int r = (G - 1 - bid) * 8 + wave; r < 4 * I_C2; r += NGW) { const int q = r / I_C2; transpose_item(P.cmp_w2 + (size_t)q * 128 * 64, 128, 64, (bf16*)(ws + WS_WC2) + (size_t)q * 64 * 128, nullptr, scr, r % I_C2, 1, lane); }
    {
        bf16* hb = (bf16*)(ws + WS_HB); float* ssq = (float*)(ws + WS_SSQ);
        for (int m = gw; m < MP; m += NGW) {
            const f32x4* xr = (const f32x4*)(P.x_prompt + (size_t)m * D) + lane; float s = 0.f; u64* o8 = (u64*)(hb + (size_t)m * D) + lane;
#pragma unroll
            for (int j = 0; j < 4; ++j) { const f32x4 v = xr[64 * j]; s += (v.x * v.x + v.y * v.y) + (v.z * v.z + v.w * v.w); o8[64 * j] = (u64)pk2(v.x, v.y) | ((u64)pk2(v.z, v.w) << 32); }
            s = wave_sum(s);
            if (lane < 16) ssq[(size_t)m * 16 + lane] = (lane == 0) ? s : 0.f;
        }
    }
    { float* hs = (float*)(ws + WS_SMP + SMP_HS); bf16* hsb = (bf16*)(ws + WS_SMP + SMP_HSB); for (int i = bid * 512 + tid; i < DB * D; i += G * 512) { const float v = P.x_sample[i]; hs[i] = v; hsb[i] = f2bf(v); } }
    { float* lbs = (float*)(ws + WS_SMALL);
      for (int i = bid * 512 + tid; i < 512; i += G * 512) { const float a = P.hgrn_lb[i], b = P.hgrn_lb[512 + i], mx = fmaxf(a, b), ea = __expf(a - mx), eb = __expf(b - mx); lbs[i] = 0.f; lbs[512 + i] = eb / (ea + eb); } }
    { bf16* tr = (bf16*)(ws + WS_TRIL);
      for (int i = bid * 512 + tid; i < 2 * 8 * 128 * 128; i += G * 512) { const int s = i & 127, t = (i >> 7) & 127; tr[i] = (s <= t) ? f2bf(P.w_s[i]) : (bf16)0; } }
    {
        float* cb = (float*)(ws + WS_SMALL + 4096);
        for (int q = G - 2 - bid; q >= 0 && q < 4; q += G) {
            wait_count(980 + q, 32u);
            if (tid < 128) { const float* cbp = (const float*)(ws + WS_SMALL + 8192) + (size_t)q * 32 * 128 + tid; float s = 0.f;
#pragma unroll 8
                for (int p = 0; p < 32; ++p) s += __builtin_nontemporal_load(cbp + p * 128);
                cb[q * 128 + tid] = s; }
        }
    }
}

#ifndef CU_VAR
#define CU_VAR 0
#endif
template <bool SAMPLE>
DI void compress_unit(unsigned char* lds, int j, int b, int ub, int ncmp, int L, int kv_lo, int kv_hi) {
    const Ptrs P = get_ptrs();
    const int tid = otid(), wave = tid >> 6, lane = tid & 63, r16 = lane & 15, quad = lane >> 4;
    unsigned char* rowsL = lds; bf16* hid = (bf16*)(lds + 135168);
    int* pg = (int*)(lds + 135168 + 17408);
    const bf16* w1t = (const bf16*)(P.ws + WS_WC1) + (size_t)j * 2 * 128 * 2048; const bf16* w2t = (const bf16*)(P.ws + WS_WC2) + (size_t)j * 2 * 64 * 128;
    const float* cb = (const float*)(P.ws + WS_SMALL + 4096) + j * 256;
    const int n0 = ub * 32, row0 = n0 * 16;
    if (SAMPLE) { if (tid < 5) { const int pi = (row0 >> 7) + tid; pg[tid] = (pi < NPAGES) ? P.page_table[b * NPAGES + pi] : 0; } __syncthreads(); }
    for (int kv = kv_lo; kv < kv_hi; ++kv) {
        for (int rp_ = 0; rp_ < ((CU_VAR == 1 && SAMPLE) ? 2 : 1); ++rp_) {
            asm volatile("" ::: "memory");
            f32x4 fa[17], fc[17]; u32x4 w[17];
#pragma unroll
            for (int u = 0; u < 17; ++u) { const int idx = u * 512 + tid, row = idx >> 4, ch = idx & 15, sr = row0 + row; const bool ok = (u < 16 || tid < 256) && (sr < L);
                if (SAMPLE) { const float* src = P.cache_cmp + (((size_t)j * NPOOL + (ok ? pg[row >> 7] : 0)) * 128 + (sr & 127)) * 256 + kv * 128 + ch * 8;
                    fa[u] = ok ? *(const f32x4*)src : (f32x4){0.f, 0.f, 0.f, 0.f}; fc[u] = ok ? *(const f32x4*)(src + 4) : (f32x4){0.f, 0.f, 0.f, 0.f};
                } else w[u] = ok ? *(const u32x4*)((const bf16*)(P.ws + WS_ZB) + ((size_t)b * SEQ + sr) * ABP + C_CMP + kv * 128 + ch * 8) : (u32x4){0u, 0u, 0u, 0u}; }
#pragma unroll
            for (int u = 0; u < 17; ++u) { const int idx = u * 512 + tid, row = idx >> 4, ch = idx & 15;
                if (SAMPLE) { w[u].x = pk2(fa[u].x, fa[u].y); w[u].y = pk2(fa[u].z, fa[u].w); w[u].z = pk2(fc[u].x, fc[u].y); w[u].w = pk2(fc[u].z, fc[u].w); }
                if (u < 16 || tid < 256) *(u32x4*)(rowsL + row * 256 + ((ch ^ ((row >> 4) & 15)) << 4)) = w[u]; }
        }
        __syncthreads();
        f32x4 acc[2][2];
        for (int rp_ = 0; rp_ < ((CU_VAR == 2 && SAMPLE) ? 2 : 1); ++rp_) {
        asm volatile("" ::: "memory");
#pragma unroll
        for (int g = 0; g < 2; ++g) { acc[g][0] = (f32x4){0.f, 0.f, 0.f, 0.f}; acc[g][1] = (f32x4){0.f, 0.f, 0.f, 0.f}; }
        const bf16* wp = w1t + ((size_t)kv * 128 + wave * 16 + r16) * 2048 + quad * 8;
        bf16x8 bq[4][8];
#pragma unroll
        for (int pb_ = 0; pb_ < 3; ++pb_)
#pragma unroll
            for (int u = 0; u < 8; ++u) bq[pb_][u] = *(const bf16x8*)(wp + (pb_ * 8 + u) * 32);
#pragma unroll
        for (int bt8 = 0; bt8 < 8; ++bt8) {
            if (bt8 + 3 < 8) {
#pragma unroll
                for (int u = 0; u < 8; ++u) bq[(bt8 + 3) & 3][u] = *(const bf16x8*)(wp + ((bt8 + 3) * 8 + u) * 32); }
#pragma unroll
            for (int u = 0; u < 8; ++u) { const int ks = bt8 * 8 + u, r = ks >> 1, c0 = (ks & 1) * 4 + quad, sw = (r16 + (r >> 4)) & 15;
#pragma unroll
                for (int bt = 0; bt < 2; ++bt) { const int row = 256 * bt + 16 * r16 + r;
#pragma unroll
                    for (int g = 0; g < 2; ++g) { const bf16x8 a = *(const bf16x8*)(rowsL + row * 256 + (((g * 8 + c0) ^ sw) << 4)); acc[g][bt] = MFMA16(a, bq[bt8 & 3][u], acc[g][bt]); } } }
        }
        asm volatile("" : "+v"(acc[0][0]), "+v"(acc[0][1]), "+v"(acc[1][0]), "+v"(acc[1][1]));
        }
#pragma unroll
        for (int g = 0; g < 2; ++g)
#pragma unroll
            for (int bt = 0; bt < 2; ++bt)
#pragma unroll
                for (int i = 0; i < 4; ++i) { const int h = wave * 16 + r16; hid[(g * 32 + bt * 16 + quad * 4 + i) * 136 + h] = f2bf(gelu_tanh(acc[g][bt][i] + cb[kv * 128 + h])); }
        __syncthreads();
        { const int rt = wave >> 1, g2 = rt >> 1; f32x4 a2[2] = {{0.f, 0.f, 0.f, 0.f}, {0.f, 0.f, 0.f, 0.f}};
#pragma unroll
          for (int ks = 0; ks < 4; ++ks) { const bf16x8 a = *(const bf16x8*)(hid + (rt * 16 + r16) * 136 + ks * 32 + quad * 8);
#pragma unroll
              for (int x = 0; x < 2; ++x) { const int ct = (wave & 1) * 2 + x; const bf16x8 bfr = *(const bf16x8*)(w2t + ((size_t)kv * 64 + ct * 16 + r16) * 128 + ks * 32 + quad * 8); a2[x] = MFMA16(a, bfr, a2[x]); } }
#pragma unroll
          for (int x = 0; x < 2; ++x)
#pragma unroll
              for (int i = 0; i < 4; ++i) { const int n = n0 + (rt & 1) * 16 + quad * 4 + i, d = ((wave & 1) * 2 + x) * 16 + r16;
                  if (n < ncmp) { if (SAMPLE) ((float*)(P.ws + WS_KCS))[(((size_t)b * 512 + n) * 4 + kv * 2 + g2) * 64 + d] = a2[x][i];
                                  else ((bf16*)(P.ws + WS_KCP))[(((size_t)b * 256 + n) * 4 + kv * 2 + g2) * 64 + d] = f2bf(a2[x][i]); } }
        }
        __syncthreads();
    }
}

DI void hgrn_p1_unit(unsigned char* lds, int j, int b, int c, int h) {
    const Ptrs P = get_ptrs();
    const int tid = otid(), wave = tid >> 6, lane = tid & 63, r16 = lane & 15, quad = lane >> 4;
    float* bl = (float*)lds; float* kk = bl + 8192; bf16* Vr = (bf16*)(lds + 65536); bf16* KD = Vr + 64 * 144; float* tot = (float*)(lds + 65536 + 2 * 64 * 144 * 2);
    const bf16* zb = (const bf16*)(P.ws + WS_ZB) + ((size_t)b * SEQ + c * 64) * ABP; const float* lb = (const float*)(P.ws + WS_SMALL) + j * 512 + h * 128;
    const int unit = (b * 4 + h) * 64 + c;
    u32x4 f8[2], v8[2];
#pragma unroll
    for (int u = 0; u < 2; ++u) { const int idx = tid + 512 * u, t = idx >> 4, ch = idx & 15; f8[u] = *(const u32x4*)(zb + (size_t)t * ABP + C_F + h * 128 + ch * 8); v8[u] = *(const u32x4*)(zb + (size_t)t * ABP + C_I + h * 128 + ch * 8); }
#pragma unroll
    for (int u = 0; u < 2; ++u) { const int idx = tid + 512 * u, t = idx >> 4, ch = idx & 15;
#pragma unroll
        for (int i = 0; i < 4; ++i) { const unsigned fw = f8[u][i]; const int d = ch * 8 + 2 * i;
            { const float lbv = lb[d], fg = lbv + (1.f - lbv) * sigmoidf_(bflo(fw)); bl[t * 128 + d] = __logf(fg); kk[t * 128 + d] = 1.f - fg; }
            { const float lbv = lb[d + 1], fg = lbv + (1.f - lbv) * sigmoidf_(bfhi(fw)); bl[t * 128 + d + 1] = __logf(fg); kk[t * 128 + d + 1] = 1.f - fg; } }
        *(u32x4*)(Vr + t * 144 + ch * 8) = v8[u]; }
    __syncthreads();
    { const int seg = tid >> 7, d = tid & 127; float run = 0.f;
#pragma unroll
      for (int i = 0; i < 16; ++i) { run += bl[(seg * 16 + i) * 128 + d]; bl[(seg * 16 + i) * 128 + d] = run; }
      tot[seg * 128 + d] = run; }
    __syncthreads();
    for (int idx = tid; idx < 4096; idx += 512) { const int t = idx >> 6, d = (idx & 63) * 2, seg = t >> 4; float e0 = 0.f, e1 = 0.f;
        e0 = tot[seg * 128 + d] - bl[t * 128 + d]; e1 = tot[seg * 128 + d + 1] - bl[t * 128 + d + 1];
        for (int s = seg + 1; s < 4; ++s) { e0 += tot[s * 128 + d]; e1 += tot[s * 128 + d + 1]; }
        *(unsigned*)(KD + t * 144 + d) = pk2(kk[t * 128 + d] * __expf(e0), kk[t * 128 + d + 1] * __expf(e1)); }
    if (tid < 128) ((float*)(P.ws + WS_DL))[(size_t)unit * 128 + tid] = __expf((tot[tid] + tot[128 + tid]) + (tot[256 + tid] + tot[384 + tid]));
    __syncthreads();
    f32x4 acc[8];
#pragma unroll
    for (int nt = 0; nt < 8; ++nt) acc[nt] = (f32x4){0.f, 0.f, 0.f, 0.f};
#pragma unroll
    for (int ks = 0; ks < 2; ++ks) { const bf16x8 a = tr_frag(Vr, 144, ks * 32, wave * 16, r16, quad);
#pragma unroll
        for (int nt = 0; nt < 8; ++nt) { const bf16x8 bb = tr_frag(KD, 144, ks * 32, nt * 16, r16, quad); acc[nt] = MFMA16(a, bb, acc[nt]); } }
    float* LT = (float*)(P.ws + WS_LT) + (size_t)unit * 16384;
#pragma unroll
    for (int nt = 0; nt < 8; ++nt)
#pragma unroll
        for (int i = 0; i < 4; ++i) LT[(wave * 16 + quad * 4 + i) * 128 + nt * 16 + r16] = acc[nt][i];
    __syncthreads();
}
DI void hgrn_scan_item(int j, int item) {
    const Ptrs P = get_ptrs();
    float* LT = (float*)(P.ws + WS_LT); const float* DL = (const float*)(P.ws + WS_DL);
    { const int gi = item * 512 + otid();
        const int bh = gi >> 12, q4 = gi & 4095, e = q4 >> 5, d4 = (q4 & 31) * 4;
        float* p = LT + (size_t)bh * 64 * 16384 + q4 * 4; const float* dp = DL + (size_t)bh * 64 * 128 + d4;
        f32x4 S = {0.f, 0.f, 0.f, 0.f};
        for (int c0 = 0; c0 < 64; c0 += 16) {
            f32x4 Lv[16], dv[16];
#pragma unroll
            for (int u = 0; u < 16; ++u) { Lv[u] = *(const f32x4*)(p + (size_t)(c0 + u) * 16384); dv[u] = *(const f32x4*)(dp + (c0 + u) * 128); }
#pragma unroll
            for (int u = 0; u < 16; ++u) { *(f32x4*)(p + (size_t)(c0 + u) * 16384) = S; S = dv[u] * S + Lv[u]; }
        }
        float* o = P.out + O_HG_P + ((size_t)j * 16 + bh) * 16384;
#pragma unroll
        for (int i = 0; i < 4; ++i) o[(d4 + i) * 128 + e] = S[i];
    }
    asm volatile("s_waitcnt vmcnt(0)" ::: "memory");
    __syncthreads();
    if (threadIdx.x == 0) { __builtin_amdgcn_fence(__ATOMIC_RELEASE, "agent"); asm volatile("s_waitcnt vmcnt(0)" ::: "memory");
        __hip_atomic_fetch_add((unsigned*)(P.ws + WS_CTL) + 4096 + 64 * (120 + j), 1u, __ATOMIC_RELAXED, __HIP_MEMORY_SCOPE_AGENT); }
}
DI void scan_wait(int j) {
    const Ptrs P = get_ptrs();
    if (threadIdx.x == 0) { unsigned* c = (unsigned*)(P.ws + WS_CTL) + 4096 + 64 * (120 + j); unsigned sp = 0;
        while (__hip_atomic_load(c, __ATOMIC_RELAXED, __HIP_MEMORY_SCOPE_AGENT) < 128u) { __builtin_amdgcn_s_sleep(2); if (++sp > (1u << 22)) break; }
        __builtin_amdgcn_fence(__ATOMIC_ACQUIRE, "agent"); asm volatile("s_waitcnt vmcnt(0)" ::: "memory"); }
    __syncthreads();
}
DI void hgrn_p3_unit(unsigned char* lds, int j, int b, int c, int h) {
    const Ptrs P = get_ptrs();
    const int tid = otid(), wave = tid >> 6, lane = tid & 63, r16 = lane & 15, quad = lane >> 4;
    float* bl = (float*)lds; unsigned char* Sb = lds;
    bf16* Qt = (bf16*)(lds + 32768); bf16* Qh = Qt + 64 * 136; bf16* Kt = Qh + 64 * 136; bf16* Vr = Kt + 160 * 136; bf16* att = Vr + 64 * 144; float* tot = (float*)(att + 64 * 72);
    float* obuf = (float*)Kt;
    const bf16* zb = (const bf16*)(P.ws + WS_ZB) + ((size_t)b * SEQ + c * 64) * ABP; const float* lb = (const float*)(P.ws + WS_SMALL) + j * 512 + h * 128;
    const int unit = (b * 4 + h) * 64 + c;
    u32x4 f8[2], v8[2], q8[2];
#pragma unroll
    for (int u = 0; u < 2; ++u) { const int idx = tid + 512 * u, t = idx >> 4, ch = idx & 15; const bf16* zr = zb + (size_t)t * ABP + h * 128 + ch * 8;
        f8[u] = *(const u32x4*)(zr + C_F); v8[u] = *(const u32x4*)(zr + C_I); q8[u] = *(const u32x4*)(zr + C_Q); }
#pragma unroll
    for (int u = 0; u < 2; ++u) { const int idx = tid + 512 * u, t = idx >> 4, ch = idx & 15;
#pragma unroll
        for (int i = 0; i < 4; ++i) { const unsigned fw = f8[u][i]; const int d = ch * 8 + 2 * i;
            { const float lbv = lb[d]; bl[t * 128 + d] = __logf(lbv + (1.f - lbv) * sigmoidf_(bflo(fw))); }
            { const float lbv = lb[d + 1]; bl[t * 128 + d + 1] = __logf(lbv + (1.f - lbv) * sigmoidf_(bfhi(fw))); } }
        *(u32x4*)(Vr + t * 144 + ch * 8) = v8[u]; }
    __syncthreads();
    { const int seg = tid >> 7, d = tid & 127; float run = 0.f;
#pragma unroll
      for (int i = 0; i < 16; ++i) { run += bl[(seg * 16 + i) * 128 + d]; bl[(seg * 16 + i) * 128 + d] = run; }
      tot[seg * 128 + d] = run; }
    __syncthreads();
#pragma unroll
    for (int u = 0; u < 2; ++u) { const int idx = tid + 512 * u, t = idx >> 4, ch = idx & 15, I = t >> 4;
        u32x4 wqt, wqh; float kv_[8], ex[8], pre[8];
#pragma unroll
        for (int i = 0; i < 8; ++i) { const int d = ch * 8 + i; float p = 0.f; for (int s = 0; s < I; ++s) p += tot[s * 128 + d]; pre[i] = p; }
#pragma unroll
        for (int i = 0; i < 4; ++i) {
            const int d = ch * 8 + 2 * i; const float q0 = siluf_(bflo(q8[u][i])), q1 = siluf_(bfhi(q8[u][i]));
            const float b0 = bl[t * 128 + d], b1 = bl[t * 128 + d + 1], e0 = __expf(b0), e1 = __expf(b1);
            wqt[i] = pk2(q0 * e0, q1 * e1); wqh[i] = pk2(q0 * e0 * __expf(pre[2 * i]), q1 * e1 * __expf(pre[2 * i + 1]));
            const float l0 = lb[d], l1 = lb[d + 1];
            kv_[2 * i] = 1.f - (l0 + (1.f - l0) * sigmoidf_(bflo(f8[u][i]))); kv_[2 * i + 1] = 1.f - (l1 + (1.f - l1) * sigmoidf_(bfhi(f8[u][i]))); ex[2 * i] = -b0; ex[2 * i + 1] = -b1;
        }
        *(u32x4*)(Qt + t * 136 + ch * 8) = wqt; *(u32x4*)(Qh + t * 136 + ch * 8) = wqh;
        for (int I2 = I; I2 < 4; ++I2) {
            u32x4 wk;
#pragma unroll
            for (int i = 0; i < 4; ++i) wk[i] = pk2(kv_[2 * i] * __expf(ex[2 * i]), kv_[2 * i + 1] * __expf(ex[2 * i + 1]));
            *(u32x4*)(Kt + (8 * I2 * (I2 + 1) + t) * 136 + ch * 8) = wk;
#pragma unroll
            for (int i = 0; i < 8; ++i) ex[i] += tot[I2 * 128 + ch * 8 + i];
        }
    }
    __syncthreads();
    { const float* St = (const float*)(P.ws + WS_LT) + (size_t)unit * 16384; f32x4 sa[4], sc4[4];
#pragma unroll
      for (int u = 0; u < 4; ++u) { const int idx = tid + 512 * u, e = idx >> 4, ch = idx & 15; sa[u] = *(const f32x4*)(St + e * 128 + ch * 8); sc4[u] = *(const f32x4*)(St + e * 128 + ch * 8 + 4); }
#pragma unroll
      for (int u = 0; u < 4; ++u) { const int idx = tid + 512 * u, e = idx >> 4, ch = idx & 15;
          u32x4 w; w.x = pk2(sa[u].x, sa[u].y); w.y = pk2(sa[u].z, sa[u].w); w.z = pk2(sc4[u].x, sc4[u].y); w.w = pk2(sc4[u].z, sc4[u].w); *(u32x4*)(Sb + e * 256 + ((ch ^ (e & 15)) << 4)) = w; } }
    { const int I = wave >> 1;
#pragma unroll
      for (int jj = 0; jj < 2; ++jj) { const int J = 2 * (wave & 1) + jj; f32x4 a4 = {0.f, 0.f, 0.f, 0.f};
          if (J <= I) {
#pragma unroll
              for (int ks = 0; ks < 4; ++ks) { const bf16x8 a = *(const bf16x8*)(Qt + (16 * I + r16) * 136 + ks * 32 + quad * 8);
                  const bf16x8 bb = *(const bf16x8*)(Kt + (8 * I * (I + 1) + 16 * J + r16) * 136 + ks * 32 + quad * 8); a4 = MFMA16(a, bb, a4); } }
#pragma unroll
          for (int i = 0; i < 4; ++i) { const int t = 16 * I + quad * 4 + i, s = 16 * J + r16; att[t * 72 + s] = (s <= t) ? f2bf(a4[i]) : (bf16)0; } } }
    __syncthreads();
    { const int I = wave >> 1; f32x4 acc[4];
#pragma unroll
      for (int x = 0; x < 4; ++x) acc[x] = (f32x4){0.f, 0.f, 0.f, 0.f};
#pragma unroll
      for (int ks = 0; ks < 4; ++ks) { const bf16x8 a = *(const bf16x8*)(Qh + (16 * I + r16) * 136 + ks * 32 + quad * 8);
#pragma unroll
          for (int x = 0; x < 4; ++x) { const int e = ((wave & 1) * 4 + x) * 16 + r16; const bf16x8 bb = *(const bf16x8*)(Sb + e * 256 + (((ks * 4 + quad) ^ (e & 15)) << 4)); acc[x] = MFMA16(a, bb, acc[x]); } }
      const int nks = (I >= 2) ? 2 : 1;
      for (int ks = 0; ks < nks; ++ks) { const bf16x8 a = *(const bf16x8*)(att + (16 * I + r16) * 72 + ks * 32 + quad * 8);
#pragma unroll
          for (int x = 0; x < 4; ++x) { const bf16x8 bb = tr_frag(Vr, 144, ks * 32, ((wave & 1) * 4 + x) * 16, r16, quad); acc[x] = MFMA16(a, bb, acc[x]); } }
#pragma unroll
      for (int x = 0; x < 4; ++x)
#pragma unroll
          for (int i = 0; i < 4; ++i) obuf[(16 * I + quad * 4 + i) * 132 + ((wave & 1) * 4 + x) * 16 + r16] = acc[x][i];
    }
    __syncthreads();
    { const float* hn = P.hgrn_norm + j * 128; bf16* oc = (bf16*)(P.ws + WS_OC) + ((size_t)b * SEQ + c * 64) * D + h * 128;
      const float h0 = hn[2 * lane], h1 = hn[2 * lane + 1]; unsigned gw[8];
#pragma unroll
      for (int i = 0; i < 8; ++i) gw[i] = *(const unsigned*)(zb + (size_t)(wave * 8 + i) * ABP + C_G + h * 128 + 2 * lane);
#pragma unroll
      for (int i = 0; i < 8; ++i) { const int t = wave * 8 + i; const f32x2 v = *(const f32x2*)(obuf + t * 132 + 2 * lane); const float ss = wave_sum(v.x * v.x + v.y * v.y), rs = rsqrtf(ss * (1.f / 128.f) + EPS);
          *(unsigned*)(oc + (size_t)t * D + 2 * lane) = pk2(v.x * rs * h0 * siluf_(bflo(gw[i])), v.y * rs * h1 * siluf_(bfhi(gw[i]))); } }
    __syncthreads();
}

DI float ex2(float x) { return __builtin_amdgcn_exp2f(x); }
DI void attn_fetch(u32x4& k8, u32x4& v8, const bf16* kbase, const bf16* vbase, size_t stride, int nvalid, int tid) {
    const int key = tid >> 3, ch = tid & 7; k8 = (u32x4){0u, 0u, 0u, 0u}; v8 = k8;
    if (key < nvalid) { k8 = *(const u32x4*)(kbase + (size_t)key * stride + ch * 8); v8 = *(const u32x4*)(vbase + (size_t)key * stride + ch * 8); }
}
DI void attn_put(bf16* Ks, const u32x4& k8, const u32x4& v8, int tid) {
    const int key = tid >> 3, ch = tid & 7; *(u32x4*)(Ks + key * 72 + ch * 8) = k8; *(u32x4*)(Ks + 64 * 72 + key * 72 + ch * 8) = v8;
}
DI void attn_qk(f32x4 (&s)[4][2], const bf16* Ks, const bf16x8 (&qf)[2][2], int r16, int quad, bool en0, bool en1) {
    if (en0 && en1) {
        bf16x8 kf[4][2];
#pragma unroll
        for (int kt = 0; kt < 4; ++kt)
#pragma unroll
            for (int ks = 0; ks < 2; ++ks) kf[kt][ks] = *(const bf16x8*)(Ks + (kt * 16 + r16) * 72 + ks * 32 + quad * 8);
#pragma unroll
        for (int kt = 0; kt < 4; ++kt) {
            s[kt][0] = MFMA16(kf[kt][0], qf[0][0], ((f32x4){0.f, 0.f, 0.f, 0.f})); s[kt][1] = MFMA16(kf[kt][0], qf[1][0], ((f32x4){0.f, 0.f, 0.f, 0.f}));
            s[kt][0] = MFMA16(kf[kt][1], qf[0][1], s[kt][0]); s[kt][1] = MFMA16(kf[kt][1], qf[1][1], s[kt][1]);
        }
    } else {
#pragma unroll
        for (int qt = 0; qt < 2; ++qt) {
            if (qt ? en1 : en0) {
#pragma unroll
                for (int kt = 0; kt < 4; ++kt) {
                    s[kt][qt] = (f32x4){0.f, 0.f, 0.f, 0.f};
#pragma unroll
                    for (int ks = 0; ks < 2; ++ks) { const bf16x8 a = *(const bf16x8*)(Ks + (kt * 16 + r16) * 72 + ks * 32 + quad * 8); s[kt][qt] = MFMA16(a, qf[qt][ks], s[kt][qt]); }
                }
            }
        }
    }
}
DI void attn_pv(f32x4 (&o)[4][2], const bf16* Vs, const bf16x8 (&pb)[2][2], int r16, int quad, bool en0, bool en1) {
    const bf16* vb = Vs + (quad * 4 + (r16 >> 2)) * 72 + (r16 & 3) * 4;
    if (en0 && en1) {
        s16x4 vf[4][2][2];
#pragma unroll
        for (int dt = 0; dt < 4; ++dt)
#pragma unroll
            for (int kk = 0; kk < 2; ++kk) { vf[dt][kk][0] = vtr(vb + (2 * kk) * 16 * 72 + dt * 16); vf[dt][kk][1] = vtr(vb + (2 * kk + 1) * 16 * 72 + dt * 16); }
#pragma unroll
        for (int dt = 0; dt < 4; ++dt)
#pragma unroll
            for (int kk = 0; kk < 2; ++kk) {
                const bf16x8 a = __builtin_shufflevector(vf[dt][kk][0], vf[dt][kk][1], 0, 1, 2, 3, 4, 5, 6, 7);
                o[dt][0] = MFMA16(a, pb[kk][0], o[dt][0]); o[dt][1] = MFMA16(a, pb[kk][1], o[dt][1]);
            }
    } else {
#pragma unroll
        for (int qt = 0; qt < 2; ++qt) {
            if (qt ? en1 : en0) {
#pragma unroll
                for (int dt = 0; dt < 4; ++dt)
#pragma unroll
                    for (int kk = 0; kk < 2; ++kk) {
                        const s16x4 lo = vtr(vb + (2 * kk) * 16 * 72 + dt * 16), hi = vtr(vb + (2 * kk + 1) * 16 * 72 + dt * 16);
                        const bf16x8 a = __builtin_shufflevector(lo, hi, 0, 1, 2, 3, 4, 5, 6, 7);
                        o[dt][qt] = MFMA16(a, pb[kk][qt], o[dt][qt]);
                    }
            }
        }
    }
}
template <int MODE>
DI void attn_branch(bf16* KV, const unsigned char* tl, int n, const bf16* zb, const bf16* kc, int g, int qi, int tid, int wave, int r16, int quad,
                    const bf16x8 (&qf)[2][2], const int (&tpos)[2], f32x4 (&o)[4][2], float (&m)[2], float (&l)[2], const u64 (&mk)[2], const u64 (&wq)[2], float* impA, float* impB) {
    const int q0 = qi * 64, rh = (r16 >> 2) & 3;
    u32x4 k8, v8;
#define AB_FETCH(i_) do { const int jb_ = tl[i_]; if (MODE <= 1) attn_fetch(k8, v8, kc + (size_t)jb_ * 64 * 256, kc + (size_t)jb_ * 64 * 256 + 128, 256, 255 - jb_ * 64, tid); \
        else { const int co_ = (MODE == 2) ? C_WIN : C_SEL; attn_fetch(k8, v8, zb + (size_t)jb_ * 64 * ABP + co_ + g * 64, zb + (size_t)jb_ * 64 * ABP + co_ + 128 + g * 64, ABP, 64, tid); } } while (0)
    if (n <= 0) return;
    AB_FETCH(0); attn_put(KV, k8, v8, tid);
    if (n > 1) AB_FETCH(1);
    __syncthreads();
    for (int i = 0; i < n; ++i) {
        bf16* Ks = KV + (i & 1) * (128 * 72);
        if (i + 1 < n) attn_put(KV + ((i + 1) & 1) * (128 * 72), k8, v8, tid);
        if (i + 2 < n) AB_FETCH(i + 2);
        const int jb = tl[i];
        bool en0 = true, en1 = true;
        if (MODE == 3) { en0 = (wq[0] >> jb) & 1ull; en1 = (wq[1] >> jb) & 1ull; }
        if (en0 || en1) {
            f32x4 s[4][2];
            attn_qk(s, Ks, qf, r16, quad, en0, en1);
            bool partial;
            if (MODE <= 1) partial = !(16 * (jb * 64 + 63) + 31 <= q0);
            else if (MODE == 2) partial = (jb == qi) || (jb + 8 == qi);
            else partial = (jb == qi);
            bf16x8 pb[2][2];
#pragma unroll
            for (int qt = 0; qt < 2; ++qt) {
                if (!(qt ? en1 : en0)) continue;
                if (partial) {
#pragma unroll
                    for (int kt = 0; kt < 4; ++kt)
#pragma unroll
                        for (int i2 = 0; i2 < 4; ++i2) { const int kp = jb * 64 + kt * 16 + quad * 4 + i2; bool ok;
                            if (MODE <= 1) ok = (16 * kp + 31 <= tpos[qt]); else if (MODE == 2) { const int dd = tpos[qt] - kp; ok = (dd >= 0 && dd < 512); } else ok = (kp <= tpos[qt]);
                            s[kt][qt][i2] = ok ? s[kt][qt][i2] : -INFINITY; }
                }
                if (MODE == 1) {
                    const float mu = m[qt], il = (l[qt] > 0.f) ? 1.f / l[qt] : 0.f; const int tokl = 8 * wave + 4 * qt + (r16 & 3);
#pragma unroll
                    for (int kt = 0; kt < 4; ++kt) {
#pragma unroll
                        for (int i2 = 0; i2 < 4; ++i2) s[kt][qt][i2] = ex2(s[kt][qt][i2] - mu) * il;
                        float v = (s[kt][qt][0] + s[kt][qt][1]) + (s[kt][qt][2] + s[kt][qt][3]), v3 = s[kt][qt][3];
                        v += __shfl_xor(v, 4); v += __shfl_xor(v, 8); v3 += __shfl_xor(v3, 4); v3 += __shfl_xor(v3, 8);
                        if (rh == 0) { const int c = jb * 16 + kt * 4 + quad; impA[tokl * 65 + c] = v; if (c + 1 < 64) impB[tokl * 65 + c + 1] = v3; }
                    }
                } else {
                    const bool lsel = (MODE == 3) ? ((mk[qt] >> jb) & 1ull) : true;
                    float mx = fmax3(s[0][qt][0], s[0][qt][1], s[0][qt][2]);
                    mx = fmax3(mx, s[0][qt][3], s[1][qt][0]); mx = fmax3(mx, s[1][qt][1], s[1][qt][2]); mx = fmax3(mx, s[1][qt][3], s[2][qt][0]); mx = fmax3(mx, s[2][qt][1], s[2][qt][2]);
                    mx = fmax3(mx, s[2][qt][3], s[3][qt][0]); mx = fmax3(mx, s[3][qt][1], s[3][qt][2]); mx = fmax2(mx, s[3][qt][3]);
                    if (MODE == 3) mx = lsel ? mx : -INFINITY;
                    mx = quad_max(mx);
                    const bool slow = (m[qt] != 0.f) || (mx > 8.f) || (l[qt] == 0.f && mx < -8.f && mx > -INFINITY);
                    f32x2 r2 = {0.f, 0.f};
                    if (__any(slow)) {
                        const bool fresh = (l[qt] == 0.f);
                        const float mn = (mx == -INFINITY) ? m[qt] : (fresh ? mx : fmax2(m[qt], mx)), alpha = fresh ? 1.f : ex2(m[qt] - mn);
#pragma unroll
                        for (int kt = 0; kt < 4; ++kt) {
#pragma unroll
                            for (int i2 = 0; i2 < 4; ++i2) s[kt][qt][i2] = ex2(s[kt][qt][i2] - mn);
                            r2 += (f32x2){s[kt][qt][0], s[kt][qt][1]}; r2 += (f32x2){s[kt][qt][2], s[kt][qt][3]}; }
                        float rs = r2.x + r2.y; if (MODE == 3) rs = lsel ? rs : 0.f;
                        l[qt] = l[qt] * alpha + quad_sum(rs); m[qt] = mn;
                        if (MODE != 0) {
#pragma unroll
                            for (int dt = 0; dt < 4; ++dt) o[dt][qt] = o[dt][qt] * alpha; }
                    } else {
#pragma unroll
                        for (int kt = 0; kt < 4; ++kt) {
#pragma unroll
                            for (int i2 = 0; i2 < 4; ++i2) s[kt][qt][i2] = ex2(s[kt][qt][i2]);
                            r2 += (f32x2){s[kt][qt][0], s[kt][qt][1]}; r2 += (f32x2){s[kt][qt][2], s[kt][qt][3]}; }
                        float rs = r2.x + r2.y; if (MODE == 3) rs = lsel ? rs : 0.f;
                        l[qt] += quad_sum(rs);
                    }
                }
                if (MODE != 0) {
#pragma unroll
                    for (int kk = 0; kk < 2; ++kk) { pb[kk][qt] = pack8(s[2 * kk][qt], s[2 * kk + 1][qt]);
                        if (MODE == 3) { const bool lsel = (mk[qt] >> jb) & 1ull; const bf16x8 z = {0, 0, 0, 0, 0, 0, 0, 0}; pb[kk][qt] = lsel ? pb[kk][qt] : z; } }
                }
            }
            if (MODE != 0) attn_pv(o, Ks + 64 * 72, pb, r16, quad, en0, en1);
        }
        __syncthreads();
    }
#undef AB_FETCH
}
DI void attn_unit(unsigned char* lds, int b, int g, int qi) {
    const Ptrs P = get_ptrs();
    const int tid = otid(), wave = tid >> 6, lane = tid & 63, r16 = lane & 15, quad = lane >> 4;
    bf16* Qs = (bf16*)lds; bf16* KV = (bf16*)(lds + 36864);
    float* impA = (float*)(lds + 73728); float* impB = impA + 64 * 65; u64* msk = (u64*)(lds + 107008);
    unsigned char* tl = lds + 107584;
    f32x4* obLo = (f32x4*)lds + tid; f32x4* obHi = (f32x4*)(lds + 73728) + tid;
    const bf16* zb = (const bf16*)(P.ws + WS_ZB) + (size_t)b * SEQ * ABP; const int q0 = qi * 64;
    const bf16* kc = (const bf16*)(P.ws + WS_KCP) + (size_t)b * 256 * 256 + g * 64;
    const int ntc = ((q0 + 32) >> 4) / 64 + 1;
    for (int idx = tid; idx < 2048; idx += 512) { const int tok = idx >> 5, r = (idx >> 3) & 3, ch = idx & 7; const float qs = 0.18033688011112042f;
        const u32x4 q8 = *(const u32x4*)(zb + (size_t)(q0 + tok) * ABP + C_QB + (g * 4 + r) * 64 + ch * 8); u32x4 w;
#pragma unroll
        for (int i = 0; i < 4; ++i) w[i] = pk2(bflo(q8[i]) * qs, bfhi(q8[i]) * qs);
        *(u32x4*)(Qs + (tok * 4 + r) * 72 + ch * 8) = w; }
    for (int idx = tid; idx < 2 * 64 * 65; idx += 512) impA[idx] = 0.f;
    if (tid < 4) tl[tid] = (unsigned char)tid;
    __syncthreads();
    bf16x8 qf[2][2]; int tpos[2]; float gate[2][3];
    const int rh = (r16 >> 2) & 3;
#pragma unroll
    for (int qt = 0; qt < 2; ++qt) { const int tokl = 8 * wave + 4 * qt + (r16 & 3); tpos[qt] = q0 + tokl;
#pragma unroll
        for (int ks = 0; ks < 2; ++ks) qf[qt][ks] = *(const bf16x8*)(Qs + (tokl * 4 + rh) * 72 + ks * 32 + quad * 8);
#pragma unroll
        for (int br = 0; br < 3; ++br) gate[qt][br] = sigmoidf_(bf2f(zb[(size_t)tpos[qt] * ABP + C_GATE + (g * 4 + rh) * 3 + br])); }
    f32x4 o[4][2]; float m[2], l[2]; u64 mk[2] = {0ull, 0ull}, wq[2] = {0ull, 0ull};
    m[0] = m[1] = 0.f; l[0] = l[1] = 0.f;
#pragma unroll
    for (int dt = 0; dt < 4; ++dt) { o[dt][0] = (f32x4){0.f, 0.f, 0.f, 0.f}; o[dt][1] = (f32x4){0.f, 0.f, 0.f, 0.f}; }
    attn_branch<0>(KV, tl, ntc, zb, kc, g, qi, tid, wave, r16, quad, qf, tpos, o, m, l, mk, wq, impA, impB);
    attn_branch<1>(KV, tl, ntc, zb, kc, g, qi, tid, wave, r16, quad, qf, tpos, o, m, l, mk, wq, impA, impB);
    {
        const int tok = tid >> 3, sub = tid & 7, cur = qi; u64 mkk;
        if (cur < 16) mkk = (1ull << (cur + 1)) - 1ull;
        else {
            float v[8]; unsigned taken = 0u;
#pragma unroll
            for (int i = 0; i < 8; ++i) { const int jb = sub + 8 * i; v[i] = (jb >= 1 && jb <= cur - 2) ? impA[tok * 65 + jb] + impB[tok * 65 + jb] : -INFINITY; }
            for (int it = 0; it < 13; ++it) {
                float bv = -INFINITY; int bi = 64;
#pragma unroll
                for (int i = 0; i < 8; ++i) { const bool c = !((taken >> i) & 1u) && v[i] > bv; bv = c ? v[i] : bv; bi = c ? sub + 8 * i : bi; }
#pragma unroll
                for (int o_ = 1; o_ < 8; o_ <<= 1) { const float ov = __shfl_xor(bv, o_); const int oi = __shfl_xor(bi, o_); const bool c = ov > bv || (ov == bv && oi < bi); bv = c ? ov : bv; bi = c ? oi : bi; }
                if ((bi & 7) == sub && bi < 64) taken |= 1u << (bi >> 3);
            }
            unsigned lo = 0u, hi = 0u;
#pragma unroll
            for (int i = 0; i < 8; ++i) if ((taken >> i) & 1u) { const int jb = sub + 8 * i; if (jb < 32) lo |= 1u << jb; else hi |= 1u << (jb - 32); }
#pragma unroll
            for (int o_ = 1; o_ < 8; o_ <<= 1) { lo |= __shfl_xor(lo, o_); hi |= __shfl_xor(hi, o_); }
            mkk = (((u64)hi << 32) | lo) | 1ull | (1ull << cur) | (1ull << (cur - 1));
        }
        if (sub == 0) msk[tok] = mkk;
        unsigned ul = (unsigned)mkk, uh = (unsigned)(mkk >> 32);
#pragma unroll
        for (int o_ = 8; o_ < 64; o_ <<= 1) { ul |= __shfl_xor(ul, o_); uh |= __shfl_xor(uh, o_); }
        if (lane == 0) msk[64 + wave] = ((u64)uh << 32) | ul;
    }
    __syncthreads();
#pragma unroll
    for (int qt = 0; qt < 2; ++qt) { obLo[(0 * 2 + qt) * 512] = o[0][qt] * gate[qt][0]; obLo[(1 * 2 + qt) * 512] = o[1][qt] * gate[qt][0]; }
    u64 uni = 0;
    {
#pragma unroll
      for (int t = 0; t < 8; ++t) uni |= msk[64 + t];
      uni &= (qi == 63) ? ~0ull : ((1ull << (qi + 1)) - 1ull);
#pragma unroll
      for (int qt = 0; qt < 2; ++qt) { mk[qt] = msk[8 * wave + 4 * qt + (r16 & 3)]; u64 w_ = 0; for (int t = 0; t < 4; ++t) w_ |= msk[8 * wave + 4 * qt + t];
          wq[qt] = ((u64)__builtin_amdgcn_readfirstlane((unsigned)(w_ >> 32)) << 32) | (unsigned)__builtin_amdgcn_readfirstlane((unsigned)w_); } }
    __syncthreads();
#pragma unroll
    for (int qt = 0; qt < 2; ++qt) { obHi[(0 * 2 + qt) * 512] = o[2][qt] * gate[qt][0]; obHi[(1 * 2 + qt) * 512] = o[3][qt] * gate[qt][0]; }
    const int jw0 = (qi > 8 ? qi - 8 : 0), nw = qi - jw0 + 1;
    if (tid < nw) tl[tid] = (unsigned char)(jw0 + tid);
    __syncthreads();
    m[0] = m[1] = 0.f; l[0] = l[1] = 0.f;
#pragma unroll
    for (int dt = 0; dt < 4; ++dt) { o[dt][0] = (f32x4){0.f, 0.f, 0.f, 0.f}; o[dt][1] = (f32x4){0.f, 0.f, 0.f, 0.f}; }
    attn_branch<2>(KV, tl, nw, zb, kc, g, qi, tid, wave, r16, quad, qf, tpos, o, m, l, mk, wq, impA, impB);
#pragma unroll
    for (int qt = 0; qt < 2; ++qt) { const float sc = gate[qt][2] / fmaxf(l[qt], 1e-30f);
        obLo[(0 * 2 + qt) * 512] += o[0][qt] * sc; obLo[(1 * 2 + qt) * 512] += o[1][qt] * sc; obHi[(0 * 2 + qt) * 512] += o[2][qt] * sc; obHi[(1 * 2 + qt) * 512] += o[3][qt] * sc; }
    if (tid < 64) ((u64*)(P.ws + WS_MSK))[(size_t)(b * 2 + g) * SEQ + q0 + tid] = msk[tid];
    { bf16* oc = (bf16*)(P.ws + WS_OC) + (size_t)b * SEQ * D;
#pragma unroll
      for (int qt = 0; qt < 2; ++qt)
#pragma unroll
          for (int dt = 0; dt < 4; ++dt) { const f32x4 acc = (dt < 2) ? obLo[(dt * 2 + qt) * 512] : obHi[((dt - 2) * 2 + qt) * 512];
              u32x2 w; w.x = pk2(acc[0], acc[1]); w.y = pk2(acc[2], acc[3]);
              *(u32x2*)(oc + (size_t)tpos[qt] * D + 512 + (g * 4 + rh) * 64 + dt * 16 + quad * 4) = w; } }
    __syncthreads();
}

namespace selb {
typedef unsigned short bf16;
using bf16x8=__attribute__((ext_vector_type(8)))short;
using s16x4=__attribute__((ext_vector_type(4)))short;
using f32x16=__attribute__((ext_vector_type(16)))float;
using u32x4=__attribute__((ext_vector_type(4)))unsigned;
constexpr int D=64,PQ=3584,PO=1024;
constexpr int NW=8,QBLK=32,QB=QBLK*NW,KVBLK=64;
__device__ __forceinline__ int crow(int r,int hi){return (r&3)+8*(r>>2)+4*hi;}
#define SBAR() __builtin_amdgcn_sched_barrier(0)
__device__ __forceinline__ void cmask(f32x16&p0,f32x16&p1,int jb,int qrel,int hi){
  const float NEG=-INFINITY; int kb=64*jb+4*hi;
  #pragma unroll
  for(int r=0;r<16;++r){int kv=kb+(r&3)+8*(r>>2); if(kv>qrel)p0[r]=NEG; if(kv+32>qrel)p1[r]=NEG;}
}

constexpr int NSLOT=3, SLOTB=8192;
constexpr int LDS_K=0, LDS_V=NSLOT*SLOTB, LDS_WS=2*NSLOT*SLOTB, LDS_OST=LDS_WS+NW*64*4, LDS_BYTES=LDS_OST+NW*4096;
constexpr float C2=0.125f*1.4426950408889634f;
__device__ __forceinline__ void glds16(const void*gsrc,unsigned lds_dst){unsigned keep;
  asm volatile("s_mov_b32 %0, m0\n\ts_mov_b32 m0, %2\n\ts_nop 0\n\tglobal_load_lds_dwordx4 %1, off\n\ts_mov_b32 m0, %0":"=&s"(keep):"v"(gsrc),"s"(lds_dst):"memory");}
__device__ __forceinline__ float max3f(float a,float b,float c){float r;asm("v_max3_f32 %0, %1, %2, %3":"=v"(r):"v"(a),"v"(b),"v"(c));return r;}
__device__ __forceinline__ float max2f(float a,float b){float r;asm("v_max_f32_e32 %0, %1, %2":"=v"(r):"v"(a),"v"(b));return r;}
__device__ __forceinline__ float fadd_s(float a,float b){float r;asm("v_add_f32_e32 %0, %1, %2":"=v"(r):"v"(a),"v"(b));return r;}
__device__ __forceinline__ float fsub_s(float a,float b){float r;asm("v_sub_f32_e32 %0, %1, %2":"=v"(r):"v"(a),"v"(b));return r;}
typedef float f32x2_t __attribute__((ext_vector_type(2))); typedef __bf16 bf16x2_t __attribute__((ext_vector_type(2)));
__device__ __forceinline__ unsigned cvtpk_s(float lo,float hi){f32x2_t v={lo,hi};bf16x2_t b=__builtin_convertvector(v,bf16x2_t);return __builtin_bit_cast(unsigned,b);}
#define WAIT_BAR(N) asm volatile("s_waitcnt vmcnt(" #N ") lgkmcnt(0)\n\ts_barrier":::"memory")

__device__ __forceinline__ void qkt(f32x16&p0,f32x16&p1,const char*Kslot,const bf16x8*qr,const f32x16&negm,int r32,int hi){
  const char*kb=Kslot+hi*1024+r32*16;
  #pragma unroll
  for(int d0=0;d0<4;++d0){
    const bf16x8 b0=*reinterpret_cast<const bf16x8*>(kb+d0*2048);
    const bf16x8 b1=*reinterpret_cast<const bf16x8*>(kb+d0*2048+512);
    if(d0==0){p0=__builtin_amdgcn_mfma_f32_32x32x16_bf16(b0,qr[0],negm,0,0,0);p1=__builtin_amdgcn_mfma_f32_32x32x16_bf16(b1,qr[0],negm,0,0,0);}
    else{p0=__builtin_amdgcn_mfma_f32_32x32x16_bf16(b0,qr[d0],p0,0,0,0);p1=__builtin_amdgcn_mfma_f32_32x32x16_bf16(b1,qr[d0],p1,0,0,0);}}
}
typedef __attribute__((address_space(3))) const char* lds_cptr;
typedef short v4i16_t __attribute__((ext_vector_type(4)));
__device__ __forceinline__ void kload8(bf16x8*kf,lds_cptr kp){
  kf[0]=*(const __attribute__((address_space(3))) bf16x8*)(kp);      kf[1]=*(const __attribute__((address_space(3))) bf16x8*)(kp+512);
  kf[2]=*(const __attribute__((address_space(3))) bf16x8*)(kp+2048); kf[3]=*(const __attribute__((address_space(3))) bf16x8*)(kp+2560);
  kf[4]=*(const __attribute__((address_space(3))) bf16x8*)(kp+4096); kf[5]=*(const __attribute__((address_space(3))) bf16x8*)(kp+4608);
  kf[6]=*(const __attribute__((address_space(3))) bf16x8*)(kp+6144); kf[7]=*(const __attribute__((address_space(3))) bf16x8*)(kp+6656);
}
__device__ __forceinline__ void kload2(bf16x8*kf,lds_cptr kp,int j){ kf[2*j]=*(const __attribute__((address_space(3))) bf16x8*)(kp+j*2048); kf[2*j+1]=*(const __attribute__((address_space(3))) bf16x8*)(kp+j*2048+512); }
__device__ __forceinline__ s16x4 vtr(lds_cptr p){ return __builtin_bit_cast(s16x4,__builtin_amdgcn_ds_read_tr16_b64_v4i16((__attribute__((address_space(3))) v4i16_t*)p)); }
__device__ __forceinline__ float rowmax(const f32x16&p0,const f32x16&p1){
  float a=max3f(p0[0],p0[1],p1[0]),b=max3f(p0[2],p0[3],p1[1]);a=max3f(a,p1[2],p1[3]);
  #pragma unroll
  for(int r=4;r<16;r+=4){a=max3f(a,p0[r],p0[r+1]);b=max3f(b,p0[r+2],p0[r+3]);a=max3f(a,p1[r],p1[r+1]);b=max3f(b,p1[r+2],p1[r+3]);}
  const float m=max2f(a,b);
  auto rr=__builtin_amdgcn_permlane32_swap(__float_as_uint(m),__float_as_uint(m),false,false);
  return max2f(__uint_as_float(rr[0]),__uint_as_float(rr[1]));
}
__device__ __forceinline__ void pv(f32x16*o,int vb,bf16x8 pa0,bf16x8 pa1,bf16x8 pa2,bf16x8 pa3){
  #pragma unroll
  for(int d0=0;d0<2;++d0){s16x4 lo[4],hi[4];
    #pragma unroll
    for(int ks=0;ks<4;++ks){
      asm volatile("ds_read_b64_tr_b16 %0,%1 offset:%c2":"=&v"(lo[ks]):"v"(vb),"i"(d0*4096+ks*1024):"memory");
      asm volatile("ds_read_b64_tr_b16 %0,%1 offset:%c2":"=&v"(hi[ks]):"v"(vb),"i"(d0*4096+ks*1024+512):"memory");}
    asm volatile("s_waitcnt lgkmcnt(0)":::"memory");SBAR();
    #define PK(k) (bf16x8){lo[k][0],lo[k][1],lo[k][2],lo[k][3],hi[k][0],hi[k][1],hi[k][2],hi[k][3]}
    o[d0]=__builtin_amdgcn_mfma_f32_32x32x16_bf16(pa0,PK(0),o[d0],0,0,0);
    o[d0]=__builtin_amdgcn_mfma_f32_32x32x16_bf16(pa1,PK(1),o[d0],0,0,0);
    o[d0]=__builtin_amdgcn_mfma_f32_32x32x16_bf16(pa2,PK(2),o[d0],0,0,0);
    o[d0]=__builtin_amdgcn_mfma_f32_32x32x16_bf16(pa3,PK(3),o[d0],0,0,0);
    #undef PK
  }
}

template<int THRL> __device__ __forceinline__ void sel_unit(int qb,const bf16*Qh,const bf16*__restrict__ Kh,const bf16*__restrict__ Vh,bf16*Oh,const unsigned long long*mrow,const bf16*gz,char*shm){
  const int tid=otid(),lane=tid&63,r32=lane&31,hi=lane>>5; const int wid=__builtin_amdgcn_readfirstlane(tid>>6);
  const int q0=qb*QB;
  const bf16*Qw=Qh+(long)(q0+wid*QBLK)*PQ;
  const unsigned lds0=(unsigned)(uintptr_t)shm;
  float*wsf=(float*)(shm+LDS_WS)+wid*64;
  const bf16*ksrc=Kh+(long)lane*PQ+wid*8;
  const bf16*vsrc=Vh+(long)(16*(wid&3)+(lane>>2))*PQ+(wid>>2)*32+(lane&3)*8;
  const unsigned kdst=lds0+LDS_K+wid*1024, vdst=lds0+LDS_V+wid*1024;
  #define DMA_K(t,slot) glds16(ksrc+(long)(t)*KVBLK*PQ,(unsigned)__builtin_amdgcn_readfirstlane(kdst+(slot)))
  #define DMA_V(t,slot) glds16(vsrc+(long)(t)*KVBLK*PQ,(unsigned)__builtin_amdgcn_readfirstlane(vdst+(slot)))
  const int vb0=(int)(lds0+LDS_V)+((lane>>4)&1)*32+(lane&3)*8+(4*hi+((lane&15)>>2))*64;
  const char*Kbase=shm+LDS_K; bf16x8 kf[8];
  const lds_cptr shm3=(lds_cptr)shm; const lds_cptr kp0=shm3+LDS_K+hi*1024+r32*16; const lds_cptr vp0=shm3+LDS_V+((lane>>4)&1)*32+(lane&3)*8+(4*hi+((lane&15)>>2))*64;
  const int NT=(q0+QB)/KVBLK;
  DMA_K(0,0);DMA_V(0,0);DMA_K(1,SLOTB);
  bf16x8 qr[4];
  #pragma unroll
  for(int d0=0;d0<4;++d0){ const u32x4 q8=*reinterpret_cast<const u32x4*>(&Qw[(long)r32*PQ+d0*16+hi*8]); u32x4 w;
    _Pragma("unroll") for(int i=0;i<4;++i) w[i]=cvtpk_s(__uint_as_float(q8[i]<<16)*C2,__uint_as_float(q8[i]&0xffff0000u)*C2);
    qr[d0]=__builtin_bit_cast(bf16x8,w); }
  const unsigned long long mkl=mrow[q0+wid*QBLK+r32];
  float mhat=0.f,l_reg=0.f;f32x16 o[2];o[0]=f32x16{};o[1]=f32x16{};f32x16 csel=f32x16{};
  const int qrel=wid*QBLK+r32;
  #define CMASK(P0,P1,t) do{int jb_=(t)-(NT-4); if(jb_>=0)cmask(P0,P1,jb_,qrel,hi);}while(0)
  bool resc=false;
  #define START(P0,P1) do{ const float rm=rowmax(P0,P1); resc=false; \
    { const float dl=rm; mhat=fadd_s(mhat,dl); \
      _Pragma("unroll") for(int r=0;r<16;++r){P0[r]=fsub_s(P0[r],dl);P1[r]=fsub_s(P1[r],dl);} \
      } \
    _Pragma("unroll") for(int r=0;r<16;++r)P0[r]=__builtin_amdgcn_exp2f(P0[r]); }while(0)
  #define RESC() do{ if(resc){ asm volatile("s_waitcnt lgkmcnt(0)":::"memory"); \
      _Pragma("unroll") for(int d_=0;d_<2;++d_) _Pragma("unroll") for(int r=0;r<16;++r)o[d_][r]*=wsf[crow(r,hi)]; } }while(0)
  f32x16 pA0,pA1,pB0,pB1;
  int sl_prev=0,sl_cur=0,sl_next=SLOTB;
  #define ROT() do{sl_prev=sl_cur;sl_cur=sl_next;sl_next=(sl_next==(NSLOT-1)*SLOTB)?0:sl_next+SLOTB;}while(0)
  DMA_K(2,2*SLOTB);
  WAIT_BAR(3);
  qkt(pA0,pA1,Kbase,qr,csel,r32,hi);asm volatile("s_nop 15\n\ts_nop 7":"+v"(pA0),"+v"(pA1));CMASK(pA0,pA1,0);
  START(pA0,pA1);
  _Pragma("unroll") for(int r=0;r<16;++r)pA1[r]=__builtin_amdgcn_exp2f(pA1[r]);
  WAIT_BAR(0);
  DMA_K(3,0);DMA_V(1,SLOTB);
  ROT();
  kload8(kf,kp0+sl_cur);
  WAIT_BAR(2);
  s16x4 vlo[8],vhi[8]; u32x4 pw0,pw1,pw2,pw3;
  #define PKW(P,B) cvtpk_s(P[B],P[B+1])
  #define PAF(k) __builtin_bit_cast(bf16x8,pw##k)
  #define VFR(i) (bf16x8){vlo[i][0],vlo[i][1],vlo[i][2],vlo[i][3],vhi[i][0],vhi[i][1],vhi[i][2],vhi[i][3]}
  #define PIN(x) asm volatile("":"+v"(x))
  #define MX3(a,b,c) __builtin_fmaxf(__builtin_fmaxf((a),(b)),(c))
  #define GAPA(MF,A0,A1,A2,A3,W0,W1,PW) do{ MF; sacc+=A0; sacc+=A1; sacc+=A2; sacc+=A3; PIN(sacc); W0; W1; PIN(PW); SBAR(); }while(0)
  #define EX(v) __builtin_amdgcn_exp2f(v)
  #define GAPB(MF,X,B) do{ MF; X[B]=EX(X[B]); X[B+1]=EX(X[B+1]); X[B+2]=EX(X[B+2]); X[B+3]=EX(X[B+3]); PIN(X); SBAR(); }while(0)
  #define VRD(i) do{ vlo[i]=vtr(vp_+(((i)>>2)*4096+((i)&3)*1024)); vhi[i]=vtr(vp_+(((i)>>2)*4096+((i)&3)*1024+512)); }while(0)
  #define KRD(G,j) do{ if(G){ kload2(kf,kp0+sl_next,j); SBAR(); } }while(0)
  #define STEP(C0,C1,P0,P1,t,GK,GV,GL) do{ SBAR(); \
    { const float cs_=((mkl>>(t))&1ull)?-mhat:-INFINITY; _Pragma("unroll") for(int r=0;r<16;++r)csel[r]=cs_; asm volatile("":"+v"(csel)); } SBAR(); \
    const lds_cptr vp_=vp0+sl_prev; \
    VRD(0); SBAR(); float sacc=(P0[0]+P0[1]); \
    GAPA(C0=__builtin_amdgcn_mfma_f32_32x32x16_bf16(kf[0],qr[0],csel,0,0,0), P0[2],P0[3],P0[4],P0[5],     pw0[0]=PKW(P0,0), pw0[1]=PKW(P0,2), pw0); \
    VRD(4); SBAR(); GAPA(C1=__builtin_amdgcn_mfma_f32_32x32x16_bf16(kf[1],qr[0],csel,0,0,0), P0[6],P0[7],P0[8],P0[9],     pw0[2]=PKW(P0,4), pw0[3]=PKW(P0,6), pw0); \
    VRD(1); SBAR(); GAPA(C0=__builtin_amdgcn_mfma_f32_32x32x16_bf16(kf[2],qr[1],C0,0,0,0),   P0[10],P0[11],P0[12],P0[13], pw1[0]=PKW(P0,8), pw1[1]=PKW(P0,10), pw1); \
    VRD(5); SBAR(); GAPA(C1=__builtin_amdgcn_mfma_f32_32x32x16_bf16(kf[3],qr[1],C1,0,0,0),   P0[14],P0[15],P1[0],P1[1],   pw1[2]=PKW(P0,12),pw1[3]=PKW(P0,14), pw1); \
    VRD(2); SBAR(); GAPA(C0=__builtin_amdgcn_mfma_f32_32x32x16_bf16(kf[4],qr[2],C0,0,0,0),   P1[2],P1[3],P1[4],P1[5],     pw2[0]=PKW(P1,0), pw2[1]=PKW(P1,2), pw2); \
    VRD(6); SBAR(); GAPA(C1=__builtin_amdgcn_mfma_f32_32x32x16_bf16(kf[5],qr[2],C1,0,0,0),   P1[6],P1[7],P1[8],P1[9],     pw2[2]=PKW(P1,4), pw2[3]=PKW(P1,6), pw2); \
    VRD(3); SBAR(); GAPA(C0=__builtin_amdgcn_mfma_f32_32x32x16_bf16(kf[6],qr[3],C0,0,0,0),   P1[10],P1[11],P1[12],P1[13], pw3[0]=PKW(P1,8), pw3[1]=PKW(P1,10), pw3); \
    VRD(7); SBAR(); GAPA(C1=__builtin_amdgcn_mfma_f32_32x32x16_bf16(kf[7],qr[3],C1,0,0,0),   P1[14],P1[15],0.f,0.f,       pw3[2]=PKW(P1,12),pw3[3]=PKW(P1,14), pw3); \
    l_reg+=sacc; \
    if(GK){DMA_K((t)+3,sl_cur);} if(GV){DMA_V((t)+1,sl_next);} \
    CMASK(C0,C1,t); \
    { float a=MX3(C0[0],C0[1],C1[0]),b=MX3(C0[2],C0[3],C1[1]); a=MX3(a,C1[2],C1[3]); \
      _Pragma("unroll") for(int r=4;r<16;r+=4){a=MX3(a,C0[r],C0[r+1]);b=MX3(b,C0[r+2],C0[r+3]);a=MX3(a,C1[r],C1[r+1]);b=MX3(b,C1[r+2],C1[r+3]);} \
      float rm=__builtin_fmaxf(a,b); { auto rr=__builtin_amdgcn_permlane32_swap(__float_as_uint(rm),__float_as_uint(rm),false,false); rm=__builtin_fmaxf(__uint_as_float(rr[0]),__uint_as_float(rr[1])); } \
      resc=false; \
      if(__builtin_expect(__any(rm>(float)THRL),0)){ const float dl=__builtin_fmaxf(rm,0.f); mhat+=dl; \
        _Pragma("unroll") for(int r=0;r<16;++r){C0[r]-=dl;C1[r]-=dl;} \
        const float f=__builtin_amdgcn_exp2f(-dl); l_reg*=f; if(hi==0)wsf[r32]=f; resc=true; } } \
    SBAR(); \
    GAPB(o[0]=__builtin_amdgcn_mfma_f32_32x32x16_bf16(PAF(0),VFR(0),o[0],0,0,0), C0,0); \
    GAPB(o[1]=__builtin_amdgcn_mfma_f32_32x32x16_bf16(PAF(0),VFR(4),o[1],0,0,0), C0,4); \
    KRD(GL,0); GAPB(o[0]=__builtin_amdgcn_mfma_f32_32x32x16_bf16(PAF(1),VFR(1),o[0],0,0,0), C0,8); \
    KRD(GL,1); GAPB(o[1]=__builtin_amdgcn_mfma_f32_32x32x16_bf16(PAF(1),VFR(5),o[1],0,0,0), C0,12); \
    KRD(GL,2); GAPB(o[0]=__builtin_amdgcn_mfma_f32_32x32x16_bf16(PAF(2),VFR(2),o[0],0,0,0), C1,0); \
    KRD(GL,3); GAPB(o[1]=__builtin_amdgcn_mfma_f32_32x32x16_bf16(PAF(2),VFR(6),o[1],0,0,0), C1,4); \
    GAPB(o[0]=__builtin_amdgcn_mfma_f32_32x32x16_bf16(PAF(3),VFR(3),o[0],0,0,0), C1,8); \
    GAPB(o[1]=__builtin_amdgcn_mfma_f32_32x32x16_bf16(PAF(3),VFR(7),o[1],0,0,0), C1,12); \
    }while(0)
  int t=1;
  #undef CMASK
  #define CMASK(P0,P1,t) do{}while(0)
  for(;t+5<NT;t+=2){
    STEP(pB0,pB1,pA0,pA1,t,true,true,true);     WAIT_BAR(2); RESC(); ROT();
    STEP(pA0,pA1,pB0,pB1,t+1,true,true,true);   WAIT_BAR(2); RESC(); ROT();
  }
  #undef CMASK
  #define CMASK(P0,P1,t) do{int jb_=(t)-(NT-4); if(jb_>=0)cmask(P0,P1,jb_,qrel,hi);}while(0)
  #define ENDW(tt) do{ if((tt)+3<NT){WAIT_BAR(2);} else if((tt)+2<NT){WAIT_BAR(1);} else {WAIT_BAR(0);} }while(0)
  for(;t+1<NT;t+=2){
    STEP(pB0,pB1,pA0,pA1,t,(t+3<NT),(t+1<NT),(t+1<NT));       ENDW(t);   RESC(); ROT();
    STEP(pA0,pA1,pB0,pB1,t+1,(t+4<NT),(t+2<NT),(t+2<NT));     ENDW(t+1); RESC(); ROT();
  }
  STEP(pB0,pB1,pA0,pA1,NT-1,false,false,false); RESC();
  { float sacc=pB0[0]+pB0[1]; _Pragma("unroll") for(int r=2;r<16;++r)sacc+=pB0[r]; _Pragma("unroll") for(int r=0;r<16;++r)sacc+=pB1[r]; l_reg+=sacc;
    pw0=(u32x4){PKW(pB0,0),PKW(pB0,2),PKW(pB0,4),PKW(pB0,6)};pw1=(u32x4){PKW(pB0,8),PKW(pB0,10),PKW(pB0,12),PKW(pB0,14)};pw2=(u32x4){PKW(pB1,0),PKW(pB1,2),PKW(pB1,4),PKW(pB1,6)};pw3=(u32x4){PKW(pB1,8),PKW(pB1,10),PKW(pB1,12),PKW(pB1,14)};
    SBAR(); pv(o,vb0+sl_cur,PAF(0),PAF(1),PAF(2),PAF(3)); }
  #undef PKW
  #undef PAF
  #undef VFR
  #undef PIN
  #undef MX3
  #undef GAPA
  #undef GAPB
  #undef EX
  #undef VRD
  #undef KRD
  #undef STEP
  #undef ENDW
  {auto rr=__builtin_amdgcn_permlane32_swap(__float_as_uint(l_reg),__float_as_uint(l_reg),false,false);l_reg=__uint_as_float(rr[0])+__uint_as_float(rr[1]);}
  { const float gl=__uint_as_float((unsigned)gz[(long)(q0+wid*QBLK+r32)*PQ]<<16); const float gate=__builtin_amdgcn_rcpf(1.f+__expf(-gl));
    if(hi==0)wsf[32+r32]=gate*__builtin_amdgcn_rcpf(fmaxf(l_reg,1e-30f)); }
  asm volatile("s_waitcnt lgkmcnt(0)":::"memory");
  float rli[16];
  #pragma unroll
  for(int r=0;r<16;++r)rli[r]=wsf[32+crow(r,hi)];
  bf16*Ow=Oh+(long)(q0+wid*QBLK)*PO;
  { bf16*stg=(bf16*)(shm+LDS_OST)+wid*2048;
    #pragma unroll
    for(int r=0;r<16;++r){const int orow=crow(r,hi);
      #pragma unroll
      for(int d0=0;d0<2;++d0)stg[orow*64+d0*32+r32]=(bf16)(cvtpk_s(o[d0][r]*rli[r],0.f)&0xffffu);}
    asm volatile("s_waitcnt lgkmcnt(0)":::"memory");
    #pragma unroll
    for(int i=0;i<4;++i){const int row=i*8+(lane>>3),ch=lane&7; const u32x4 v=*(const u32x4*)(stg+row*64+ch*8); bf16*dst=Ow+(long)row*PO+ch*8; const u32x4 p=*(const u32x4*)dst; u32x4 w;
      _Pragma("unroll") for(int e=0;e<4;++e) w[e]=cvtpk_s(__uint_as_float(v[e]<<16)+__uint_as_float(p[e]<<16),__uint_as_float(v[e]&0xffff0000u)+__uint_as_float(p[e]&0xffff0000u));
      *(u32x4*)dst=w;} }
  asm volatile("s_waitcnt lgkmcnt(0)\n\ts_barrier":::"memory");
  #undef DMA_K
  #undef DMA_V
  #undef CMASK
  #undef START
  #undef RESC
  #undef ROT
}
constexpr int SEL_LDS_BYTES=LDS_BYTES;
#undef SBAR
#undef WAIT_BAR
}

DI void sel_attn_unit(unsigned char* lds, int b, int hq, int qb) {
    const Ptrs P = get_ptrs();
    const int g = hq >> 2;
    const bf16* zb = (const bf16*)(P.ws + WS_ZB) + (size_t)b * SEQ * ABP;
    selb::sel_unit<8>(qb, zb + C_QB + hq * 64, zb + C_SEL + g * 64, zb + C_SEL + 128 + g * 64, (bf16*)(P.ws + WS_OC) + (size_t)b * SEQ * D + 512 + hq * 64,
                      (const u64*)(P.ws + WS_MSK) + (size_t)(b * 2 + g) * SEQ, zb + C_GATE + hq * 3 + 1, (char*)lds);
}

DI void mix_unit(unsigned char* lds, int jc, int chunk, int gq) {
    const Ptrs P = get_ptrs();
    const int tid = otid(), wave = tid >> 6, lane = tid & 63, r16 = lane & 15, quad = lane >> 4;
    bf16* Vr = (bf16*)lds; float* mu = (float*)(lds + 128 * 144 * 2); float* rsd = mu + 128;
    const size_t tok0 = (size_t)chunk * 128;
    const bf16* ub = (const bf16*)(P.ws + WS_ZB); const bf16* vb = ub + (size_t)MP * D; const float* vstat = (const float*)(P.ws + WS_VSTAT);
    u32x4 v8[4];
#pragma unroll
    for (int u = 0; u < 4; ++u) { const int idx = tid + 512 * u, s = idx >> 4, ch = idx & 15; v8[u] = *(const u32x4*)(vb + (tok0 + s) * D + gq * 128 + ch * 8); }
    const int t = wave * 16 + r16; u32x2 u4[8];
#pragma unroll
    for (int mt = 0; mt < 8; ++mt) u4[mt] = *(const u32x2*)(ub + (tok0 + t) * D + gq * 128 + mt * 16 + quad * 4);
    if (tid < 128) { const f32x4* p = (const f32x4*)(vstat + (tok0 + tid) * 32); float s1 = 0.f, s2 = 0.f;
#pragma unroll
        for (int i = 0; i < 8; ++i) { const f32x4 v = p[i]; s1 += v.x + v.z; s2 += v.y + v.w; }
        const float mean = s1 * (1.f / 1024.f), var = fmaxf(s2 * (1.f / 1024.f) - mean * mean, 0.f); mu[tid] = mean; rsd[tid] = rsqrtf(var + EPS); }
    __syncthreads();
    { const float* lg = P.ln_c_g + jc * D + gq * 128; const float* lbb = P.ln_c_b + jc * D + gq * 128;
#pragma unroll
      for (int u = 0; u < 4; ++u) { const int idx = tid + 512 * u, s = idx >> 4, ch = idx & 15; const float mm = mu[s], rr = rsd[s]; u32x4 w;
#pragma unroll
          for (int i = 0; i < 4; ++i) { const int c = ch * 8 + 2 * i; w[i] = pk2((bflo(v8[u][i]) - mm) * rr * lg[c] + lbb[c], (bfhi(v8[u][i]) - mm) * rr * lg[c + 1] + lbb[c + 1]); }
          *(u32x4*)(Vr + s * 144 + ch * 8) = w; } }
    __syncthreads();
    f32x4 acc[8];
#pragma unroll
    for (int mt = 0; mt < 8; ++mt) acc[mt] = (f32x4){0.f, 0.f, 0.f, 0.f};
    const bf16* wt = (const bf16*)(P.ws + WS_TRIL) + ((size_t)(jc * 8 + gq) * 128 + t) * 128 + quad * 8;
    const int nks = (wave >> 1) + 1;
    for (int ks = 0; ks < nks; ++ks) { const bf16x8 bb = *(const bf16x8*)(wt + ks * 32);
#pragma unroll
        for (int mt = 0; mt < 8; ++mt) { const bf16x8 a = tr_frag(Vr, 144, ks * 32, mt * 16, r16, quad); acc[mt] = MFMA16(a, bb, acc[mt]); } }
    { const float bs = P.b_s[(jc * 8 + gq) * 128 + t]; bf16* um = (bf16*)(P.ws + WS_OC);
#pragma unroll
      for (int mt = 0; mt < 8; ++mt) { const int c = gq * 128 + mt * 16 + quad * 4;
          u32x2 w; w.x = pk2(bflo(u4[mt].x) * (acc[mt][0] + bs), bfhi(u4[mt].x) * (acc[mt][1] + bs)); w.y = pk2(bflo(u4[mt].y) * (acc[mt][2] + bs), bfhi(u4[mt].y) * (acc[mt][3] + bs));
          *(u32x2*)(um + (tok0 + t) * D + c) = w; } }
    __syncthreads();
}

DI void hgrn_s_unit(unsigned char* lds, int j, int b, int h) {
    const Ptrs P = get_ptrs();
    const int tid = otid(); float* qq = (float*)lds; float* fg = qq + 128; float* kx = fg + 128; float* vv = kx + 128; float* part = vv + 128; float* sq = part + 16 * 128;
    const float* z = (const float*)(P.ws + WS_SMP + SMP_ZS) + (size_t)b * ABP; const float* lb = (const float*)(P.ws + WS_SMALL) + j * 512 + h * 128;
    if (tid < 128) { const float f = z[C_F + h * 128 + tid], lbv = lb[tid], fgv = lbv + (1.f - lbv) * sigmoidf_(f);
        qq[tid] = siluf_(z[C_Q + h * 128 + tid]); fg[tid] = fgv; kx[tid] = 1.f - fgv; vv[tid] = z[C_I + h * 128 + tid]; }
    __syncthreads();
    const int e4 = (tid & 31) * 4, dr = tid >> 5; const size_t sbase = (((size_t)j * DB + b) * 4 + h) * 16384;
    const float* S0 = P.state_hgrn + sbase; float* S1 = P.out + O_HG_S + sbase;
    f32x4 acc = {0.f, 0.f, 0.f, 0.f}; const f32x4 v4 = *(const f32x4*)(vv + e4);
#pragma unroll
    for (int it = 0; it < 8; ++it) { const int d = it * 16 + dr; const f32x4 s0 = *(const f32x4*)(S0 + d * 128 + e4); const f32x4 sn = s0 * fg[d] + v4 * kx[d]; *(f32x4*)(S1 + d * 128 + e4) = sn; acc += sn * qq[d]; }
    *(f32x4*)(part + dr * 128 + e4) = acc;
    __syncthreads();
    float o = 0.f;
    if (tid < 128) { for (int r = 0; r < 16; ++r) o += part[r * 128 + tid]; sq[tid] = o * o; }
    __syncthreads();
    if (tid < 128) { float ss = 0.f; for (int i = 0; i < 128; ++i) ss += sq[i]; const float rs = rsqrtf(ss * (1.f / 128.f) + EPS);
        ((bf16*)(P.ws + WS_SMP + SMP_OCS))[(size_t)b * D + h * 128 + tid] = f2bf(o * rs * P.hgrn_norm[j * 128 + tid] * siluf_(z[C_G + h * 128 + tid])); }
    __syncthreads();
}
DI void sattn_core(const float* const* kp, int nkeys, const float* qL, float* sc, float* red, float* oacc) {
    const int tid = otid(), wave = tid >> 6, lane = tid & 63;
    for (int key = tid; key < nkeys; key += 512) { const float* k = kp[key]; float d0 = -INFINITY, d1 = -INFINITY, d2 = -INFINITY, d3 = -INFINITY;
        if (k) { d0 = d1 = d2 = d3 = 0.f;
#pragma unroll
            for (int i = 0; i < 16; ++i) { const f32x4 kv = *(const f32x4*)(k + 4 * i); const f32x4 a = *(const f32x4*)(qL + 4 * i), b = *(const f32x4*)(qL + 64 + 4 * i), c = *(const f32x4*)(qL + 128 + 4 * i), d = *(const f32x4*)(qL + 192 + 4 * i);
                d0 += (kv.x * a.x + kv.y * a.y) + (kv.z * a.z + kv.w * a.w); d1 += (kv.x * b.x + kv.y * b.y) + (kv.z * b.z + kv.w * b.w);
                d2 += (kv.x * c.x + kv.y * c.y) + (kv.z * c.z + kv.w * c.w); d3 += (kv.x * d.x + kv.y * d.y) + (kv.z * d.z + kv.w * d.w); }
            d0 *= 0.125f; d1 *= 0.125f; d2 *= 0.125f; d3 *= 0.125f; }
        sc[key] = d0; sc[1040 + key] = d1; sc[2080 + key] = d2; sc[3120 + key] = d3; }
    __syncthreads();
    if (wave < 4) { float* row = sc + wave * 1040; float mx = -INFINITY; for (int k = lane; k < nkeys; k += 64) mx = fmaxf(mx, row[k]); mx = wave_max(mx); const float mu = (mx == -INFINITY) ? 0.f : mx;
        float sm = 0.f; for (int k = lane; k < nkeys; k += 64) { const float e = __expf(row[k] - mu); row[k] = e; sm += e; } sm = wave_sum(sm); const float il = 1.f / fmaxf(sm, 1e-30f);
        for (int k = lane; k < nkeys; k += 64) row[k] *= il; }
    __syncthreads();
    {
      const int ks = tid >> 4, d4 = (tid & 15) * 4; f32x4 a0 = {0.f, 0.f, 0.f, 0.f}, a1 = a0, a2 = a0, a3 = a0; const float* safe = kp[0];
      for (int k0 = ks; k0 < nkeys; k0 += 256) {
          f32x4 v[8]; float p0[8], p1[8], p2[8], p3[8];
#pragma unroll
          for (int u = 0; u < 8; ++u) { const int k = k0 + 32 * u; const bool ok = k < nkeys; const float* kv = ok ? kp[k] : nullptr; const bool ld = kv != nullptr; kv = ld ? kv : safe;
              v[u] = *(const f32x4*)(kv + 128 + d4); const int kk = ok ? k : 0;
              p0[u] = ld ? sc[kk] : 0.f; p1[u] = ld ? sc[1040 + kk] : 0.f; p2[u] = ld ? sc[2080 + kk] : 0.f; p3[u] = ld ? sc[3120 + kk] : 0.f; }
#pragma unroll
          for (int u = 0; u < 8; ++u) { a0 += v[u] * p0[u]; a1 += v[u] * p1[u]; a2 += v[u] * p2[u]; a3 += v[u] * p3[u]; }
      }
      *(f32x4*)(red + (ks * 4 + 0) * 64 + d4) = a0; *(f32x4*)(red + (ks * 4 + 1) * 64 + d4) = a1; *(f32x4*)(red + (ks * 4 + 2) * 64 + d4) = a2; *(f32x4*)(red + (ks * 4 + 3) * 64 + d4) = a3; }
    __syncthreads();
    if (tid < 256) { float a = 0.f;
#pragma unroll 8
        for (int ks = 0; ks < 32; ++ks) a += red[ks * 256 + tid];
        oacc[tid] = a; }
    __syncthreads();
}
DI void sattn_unit(unsigned char* lds, int j, int b, int g) {
    const Ptrs P = get_ptrs();
    const int tid = otid(), lane = tid & 63;
    const float** kp = (const float**)lds;
    float* sc = (float*)(lds + 8320);
    float* qL = sc + 4 * 1040; float* red = qL + 256; float* oacc = red + 8192; float* om = oacc + 256; float* imp = om + 256; int* flag = (int*)(imp + 132); int* list = flag + 132;
    const float* z = (const float*)(P.ws + WS_SMP + SMP_ZS) + (size_t)b * ABP;
    if (tid < 256) { qL[tid] = z[C_QB + g * 256 + tid]; om[tid] = 0.f; }
    const float* wbuf = P.state_win + (((size_t)j * DB + b) * 512) * 256 + g * 64;
    for (int k = tid; k < 512; k += 512) kp[k] = (k < 511) ? wbuf + (size_t)(k + 1) * 256 : z + C_WIN + g * 64;
    __syncthreads();
    sattn_core(kp, 512, qL, sc, red, oacc);
    if (tid < 256) { const int r = tid >> 6; om[tid] += sigmoidf_(z[C_GATE + (g * 4 + r) * 3 + 2]) * oacc[tid]; }
    __syncthreads();
    const float* kcs = (const float*)(P.ws + WS_KCS) + (size_t)b * 512 * 256 + g * 64;
    for (int k = tid; k < 511; k += 512) kp[k] = kcs + (size_t)k * 256;
    __syncthreads();
    sattn_core(kp, 511, qL, sc, red, oacc);
    if (tid < 256) { const int r = tid >> 6; om[tid] += sigmoidf_(z[C_GATE + (g * 4 + r) * 3 + 0]) * oacc[tid]; }
    if (tid < 129) { float a = 0.f; const int nlo = (4 * tid - 1 < 0) ? 0 : 4 * tid - 1, nhi = (4 * tid + 3 > 510) ? 510 : 4 * tid + 3;
        for (int r = 0; r < 4; ++r) for (int n = nlo; n <= nhi; ++n) a += sc[r * 1040 + n];
        imp[tid] = a; flag[tid] = (tid == 0 || tid == 127 || tid == 128) ? 1 : 0; }
    __syncthreads();
    if (tid < 64) {
        const int j1 = lane + 1, j2 = lane + 65; float v1 = imp[j1], v2 = (j2 <= 126) ? imp[j2] : -INFINITY; bool t1 = false, t2 = (j2 > 126);
        for (int it = 0; it < 13; ++it) {
            float bv; int bi;
            const float c1 = t1 ? -INFINITY : v1, c2 = t2 ? -INFINITY : v2;
            if (c2 > c1) { bv = c2; bi = j2; } else { bv = c1; bi = j1; }
#pragma unroll
            for (int o_ = 1; o_ < 64; o_ <<= 1) { const float ov = __shfl_xor(bv, o_); const int oi = __shfl_xor(bi, o_); if (ov > bv || (ov == bv && oi < bi)) { bv = ov; bi = oi; } }
            if (bi == j1) { t1 = true; flag[j1] = 1; } else if (bi == j2) { t2 = true; flag[j2] = 1; }
        }
    }
    __syncthreads();
    if (tid == 0) { int n = 0; for (int jb = 0; jb < 129 && n < 16; ++jb) if (flag[jb]) list[n++] = jb; for (; n < 16; ++n) list[n] = -1; }
    __syncthreads();
    for (int k = tid; k < 1024; k += 512) { const int jb = list[k >> 6], i = k & 63; const float* p = nullptr;
        if (jb >= 0) { if (jb < 128) { const int pos = jb * 64 + i, page = P.page_table[b * NPAGES + (pos >> 7)]; p = P.cache_sel + (((size_t)j * NPOOL + page) * 128 + (pos & 127)) * 256 + g * 64; }
                       else if (i == 0) p = z + C_SEL + g * 64; }
        kp[k] = p; }
    __syncthreads();
    sattn_core(kp, 1024, qL, sc, red, oacc);
    if (tid < 256) { const int r = tid >> 6, d = tid & 63; const float v = om[tid] + sigmoidf_(z[C_GATE + (g * 4 + r) * 3 + 1]) * oacc[tid];
        ((bf16*)(P.ws + WS_SMP + SMP_OCS))[(size_t)b * D + 512 + (g * 4 + r) * 64 + d] = f2bf(v); }
    __syncthreads();
}
DI void gmlp_s_unit(unsigned char* lds, int jc, int b) {
    const Ptrs P = get_ptrs();
    const int tid = otid(), wave = tid >> 6, lane = tid & 63; float* red = (float*)lds;
    const float* uv = (const float*)(P.ws + WS_SMP + SMP_UVS) + (size_t)b * 2048;
    const float v0 = uv[1024 + tid], v1 = uv[1024 + 512 + tid];
    float s = wave_sum(v0 + v1); if (lane == 0) red[wave] = s; __syncthreads();
    float mean = 0.f; for (int w = 0; w < 8; ++w) mean += red[w]; mean *= (1.f / 1024.f); __syncthreads();
    const float d0 = v0 - mean, d1 = v1 - mean; s = wave_sum(d0 * d0 + d1 * d1); if (lane == 0) red[wave] = s; __syncthreads();
    float var = 0.f; for (int w = 0; w < 8; ++w) var += red[w]; const float rs = rsqrtf(var * (1.f / 1024.f) + EPS);
#pragma unroll
    for (int k = 0; k < 2; ++k) { const int c = tid + 512 * k, gq = c >> 7; const float vl = (k ? d1 : d0) * rs * P.ln_c_g[jc * D + c] + P.ln_c_b[jc * D + c];
        P.out[O_CV_S + ((size_t)jc * DB + b) * D + c] = vl;
        ((bf16*)(P.ws + WS_SMP + SMP_OCS))[(size_t)b * D + c] = f2bf(uv[c] * (P.w_s[(size_t)(jc * 8 + gq) * 16384] * vl + P.b_s[(jc * 8 + gq) * 128])); }
    __syncthreads();
}
DI void final_norm(int bid, int G) {
    const Ptrs P = get_ptrs();
    const int tid = otid(), wave = tid >> 6, lane = tid & 63; const int gw = bid * 8 + wave, NGW = G * 8;
    const float* hs = (const float*)(P.ws + WS_SMP + SMP_HS);
    f32x4 g4[4];
#pragma unroll
    for (int k = 0; k < 4; ++k) g4[k] = ((const f32x4*)P.norm_final)[lane + 64 * k];
    for (int m = gw; m < MP + DB; m += NGW) {
        f32x4 v[4]; float s = 0.f;
        if (m < MP) { const u32x2* xr = (const u32x2*)((const bf16*)(P.ws + WS_HB) + (size_t)m * D) + lane;
#pragma unroll
            for (int k = 0; k < 4; ++k) { const u32x2 w = xr[64 * k]; v[k] = (f32x4){bflo(w.x), bfhi(w.x), bflo(w.y), bfhi(w.y)}; }
        } else { const f32x4* xr = (const f32x4*)(hs + (size_t)(m - MP) * D) + lane;
#pragma unroll
            for (int k = 0; k < 4; ++k) v[k] = xr[64 * k]; }
        f32x4* o = (f32x4*)((m < MP) ? P.out + O_YP + (size_t)m * D : P.out + O_YS + (size_t)(m - MP) * D) + lane;
#pragma unroll
        for (int k = 0; k < 4; ++k) s += (v[k].x * v[k].x + v[k].y * v[k].y) + (v[k].z * v[k].z + v[k].w * v[k].w);
        const float rs = rsqrtf(wave_sum(s) * (1.f / 1024.f) + EPS);
#pragma unroll
        for (int k = 0; k < 4; ++k) o[64 * k] = v[k] * rs * g4[k];
    }
}
constexpr int N_PHASES = 30;
__global__ void __launch_bounds__(512, 2) mega_fwd(Args args) {
    extern __shared__ __attribute__((aligned(16))) unsigned char lds[];
    const int tid = otid(), bid = blockIdx.x, G = gridDim.x;
    const int lo = args.ph_lo, hi = args.ph_hi;
    volatile LAS unsigned* MISC = (volatile LAS unsigned*)((LAS unsigned char*)lds + MISC_OFF);
    if (tid < 16) MISC[tid] = 0u;
    __syncthreads();
    XcdBarrier bar; bar.bar = (unsigned*)(args.ws + WS_CTL); bar.x = 0; bar.st = nullptr;
    const bool multi = (hi - lo) > 1;
    if (multi) bar = xcd_barrier_post((unsigned*)(args.ws + WS_CTL), MISC + 8);
#ifndef PHM
#define PHM 0x7ff
#endif
#define SITE(s) ((PHM >> (s)) & 1)
#ifndef PROBE_DUP
#define PROBE_DUP 0
#endif
#define NREP(s) (1 + ((PROBE_DUP >> (s)) & 1))
#ifndef FILL_A
#define FILL_A 1
#endif
#ifndef WGM_A
#define WGM_A 4
#endif
#ifndef WGM_C
#define WGM_C 4
#endif
#ifndef WGM_E
#define WGM_E 4
#endif
#ifndef WGM_F
#define WGM_F 4
#endif
#ifndef WGM_G
#define WGM_G 8
#endif
#ifndef PROBE_SK
#define PROBE_SK 0
#endif
#ifndef PROBE_SUB
#define PROBE_SUB 0
#endif
#define IN(k) (lo <= (k) && (k) < hi)
#ifndef PROBE_DBLBAR
#define PROBE_DBLBAR 0
#endif
#define SEAM(k) do { if (multi && (k) + 1 < hi) { xcd_barrier(bar); if (PROBE_DBLBAR) xcd_barrier(bar); } else __syncthreads(); } while (0)
#define LOCALS const Ptrs P = get_ptrs(); unsigned char* ws = P.ws; (void)ws; \
    float* hp = (float*)(ws + WS_HP); bf16* hb = (bf16*)(ws + WS_HB); float* ssq = (float*)(ws + WS_SSQ); bf16* zb = (bf16*)(ws + WS_ZB); bf16* hff = (bf16*)(ws + WS_HFF); bf16* oc = (bf16*)(ws + WS_OC); \
    float* hs = (float*)(ws + WS_SMP + SMP_HS); float* zs = (float*)(ws + WS_SMP + SMP_ZS); bf16* ocs = (bf16*)(ws + WS_SMP + SMP_OCS); bf16* hffs = (bf16*)(ws + WS_SMP + SMP_HFFS); float* uvs = (float*)(ws + WS_SMP + SMP_UVS); bf16* hsb = (bf16*)(ws + WS_SMP + SMP_HSB); (void)hsb; \
    (void)hp; (void)hb; (void)ssq; (void)zb; (void)hff; (void)oc; (void)hs; (void)zs; (void)ocs; (void)hffs; (void)uvs;
    PG8_LAS unsigned char* ring = (PG8_LAS unsigned char*)lds;

    if (SITE(0) && IN(0)) { for (int rep = 0; rep < NREP(0); ++rep) prologue(lds, bid, G); SEAM(0); }

    for (int L = 0; L < 4; ++L) {
        const int pb = 1 + 7 * L, j = L >> 1;
        if ((L & 1) == 0) {
            if (SITE(1) && IN(pb + 0)) {
                LOCALS
                for (int rep = 0; rep < NREP(1); ++rep) {
                { pg8::Gemm g{hb, (const bf16*)(ws + WS_WINAB) + (size_t)j * ABP * D, MP, ABP, D}; pg8::StaticOrder S; S.init(MP, ABP, G, bid, WGM_A);
                  EpiInAB E{zb, ssq, P.out + O_CMP_P + (size_t)j * MP * 256, P.out + O_SEL_P + (size_t)j * MP * 256, P.out + O_WIN_P + (size_t)j * BATCH * 512 * 256};
                  pg8::gemm_phase<EpiInAB, pg8::StaticOrder, true, true>(ring, g, S, E); }
                { SEpiInAB E{zs, P.out + O_CMP_S + (size_t)j * DB * 256, P.out + O_SEL_S + (size_t)j * DB * 256};
                  skinny_gemm<true, 4, SEpiInAB>(lds, hsb, D, (const bf16*)(ws + WS_WINAB) + (size_t)j * ABP * D, ABP, bid, G, E);
                   }
                if (rep == 0 && FILL_A) { const int rem = 896 % G;
                    if (rem != 0 && bid >= rem && bid - rem < 1024) { const int hi_ = bid - rem; compress_unit<true>(lds, j, hi_ >> 5, (hi_ >> 1) & 15, 511, PAST, hi_ & 1, (hi_ & 1) + 1); } }
                }
                SEAM(pb + 0);
            }
            if (SITE(2) && IN(pb + 1)) {
                for (int rep = 0; rep < NREP(2); ++rep) {
                const int rem_ = 896 % G, npre = (FILL_A && rem_ != 0) ? ((G - rem_ < 1024) ? G - rem_ : 1024) : 0, NH = 1024 - npre;
                unsigned* qctr = (unsigned*)(get_ptrs().ws + WS_CTL) + 4096 + 64 * (4 + j * 2 + rep);
                volatile LAS unsigned* qslot = MISC + 4;
                unsigned nxt = 0u;
                if (tid == 0) nxt = __hip_atomic_fetch_add(qctr, 1u, __ATOMIC_RELAXED, __HIP_MEMORY_SCOPE_AGENT);
                for (;;) {
                    if (tid == 0) qslot[0] = nxt;
                    __syncthreads();
                    int it = (int)qslot[0];
                    __syncthreads();
                    if (it >= NH + 736) break;
                    if (tid == 0) nxt = __hip_atomic_fetch_add(qctr, 1u, __ATOMIC_RELAXED, __HIP_MEMORY_SCOPE_AGENT);
                    if (it < NH) { const int hi_ = it + npre; compress_unit<true>(lds, j, hi_ >> 5, (hi_ >> 1) & 15, 511, PAST, hi_ & 1, (hi_ & 1) + 1); continue; }
                    it += 512 - NH;
                    if (it < 544) { const int u = it - 512; compress_unit<false>(lds, j, u >> 3, u & 7, 255, SEQ, 0, 2); }
                    else if (it < 672) { const int u = it - 544; hgrn_s_unit(lds, j, u >> 2, u & 3); }
                    else if (it < 736) {
                        LOCALS
                        const f32x4* src = (const f32x4*)(P.state_win + (size_t)j * DB * 512 * 256); f32x4* dst = (f32x4*)(P.out + O_WIN_S + (size_t)j * DB * 512 * 256);
                        const int i0 = (it - 672) * 16384 + otid();
#pragma unroll 4
                        for (int q = 0; q < 32; ++q) { const int i = i0 + q * 512, c4 = i & 63, s = (i >> 6) & 511, b = i >> 15;
                            dst[i] = (s < 511) ? src[i + 64] : *(const f32x4*)(zs + (size_t)b * ABP + C_WIN + c4 * 4); } }
                    else { const int u = (it - 736) * 2; hgrn_p1_unit(lds, j, u >> 8, u & 63, (u >> 6) & 3); hgrn_p1_unit(lds, j, (u + 1) >> 8, (u + 1) & 63, ((u + 1) >> 6) & 3); }
                }
                }
                SEAM(pb + 1);
            }
            if (SITE(3) && IN(pb + 2)) {
                for (int rep = 0; rep < NREP(3); ++rep) {
                const int myq = (int)(xb_xcc_id() & 7u); bool scan_ok = false;
                volatile LAS unsigned* qslot = MISC + 4;
                for (int off = 0; off < 8; ++off) {
                    const int q = (myq + off) & 7;
                    unsigned* qctr = (unsigned*)(get_ptrs().ws + WS_CTL) + 4096 + 64 * (16 + (j * 2 + rep) * 8 + q);
                    unsigned nxt = 0u;
                    if (tid == 0) nxt = __hip_atomic_fetch_add(qctr, 1u, __ATOMIC_RELAXED, __HIP_MEMORY_SCOPE_AGENT);
                    for (;;) {
                        if (tid == 0) qslot[0] = nxt;
                        __syncthreads();
                        const int it = (int)qslot[0];
                        __syncthreads();
                        if (it >= 216) break;
                        if (tid == 0) nxt = __hip_atomic_fetch_add(qctr, 1u, __ATOMIC_RELAXED, __HIP_MEMORY_SCOPE_AGENT);
                        if (it < 16) { if (rep == 0) hgrn_scan_item(j, q * 16 + it); }
                        else if (it < 24) { if (rep == 0 || PROBE_SUB != 2) { const int u = q * 8 + (it - 16); sattn_unit(lds, j, u >> 1, u & 1); } }
                        else if (it < 88) { if (rep == 0 || PROBE_SUB != 1) { const int qi = 63 - (it - 24); attn_unit(lds, q >> 1, q & 1, qi); if (rep == 0) publish_count(700 + (j * 8 + q) * 16 + (qi >> 2)); } }
                        else if (it < 152) { if (rep != 0) continue; const int i_ = it - 88, qb = 15 - (i_ >> 2);
                            wait_count(700 + (j * 8 + q) * 16 + qb, 4u);
                            sel_attn_unit(lds, q >> 1, (q & 1) * 4 + (i_ & 3), qb); }
                        else {
                            if (rep != 0) continue;
                            if (!scan_ok) { scan_wait(j); scan_ok = true; }
                            const int u = q * 128 + (it - 152) * 2; hgrn_p3_unit(lds, j, u >> 8, u & 63, (u >> 6) & 3); hgrn_p3_unit(lds, j, (u + 1) >> 8, (u + 1) & 63, ((u + 1) >> 6) & 3); }
                    }
                }
                }
                SEAM(pb + 2);
            }
        } else {
            if (SITE(5) && IN(pb + 0)) {
                LOCALS
                for (int rep = 0; rep < NREP(5); ++rep) {
                { pg8::Gemm g{hb, (const bf16*)(ws + WS_WINC) + (size_t)j * 2048 * D, MP, 2048, D}; pg8::StaticOrder S; S.init(MP, 2048, G, bid, WGM_C);
                  EpiInC E{zb, zb + (size_t)MP * D, ssq, (float*)(ws + WS_VSTAT)};
                  pg8::gemm_phase<EpiInC, pg8::StaticOrder, true, true>(ring, g, S, E); }
                { SEpiInC E{uvs}; skinny_gemm<true, 4, SEpiInC>(lds, hsb, D, (const bf16*)(ws + WS_WINC) + (size_t)j * 2048 * D, 2048, bid, G, E); }
                }
                SEAM(pb + 0);
            }
            if (SITE(6) && IN(pb + 1)) {
                for (int rep = 0; rep < NREP(6); ++rep) {
                unsigned* qctr = (unsigned*)(get_ptrs().ws + WS_CTL) + 4096 + 64 * (72 + j * 2 + rep);
                volatile LAS unsigned* qslot = MISC + 4; unsigned nxt = 0u;
                if (tid == 0) nxt = __hip_atomic_fetch_add(qctr, 1u, __ATOMIC_RELAXED, __HIP_MEMORY_SCOPE_AGENT);
                for (;;) {
                    if (tid == 0) qslot[0] = nxt;
                    __syncthreads();
                    const int it = (int)qslot[0];
                    __syncthreads();
                    if (it >= 512 + DB) break;
                    if (tid == 0) nxt = __hip_atomic_fetch_add(qctr, 1u, __ATOMIC_RELAXED, __HIP_MEMORY_SCOPE_AGENT);
                    if (it < DB) gmlp_s_unit(lds, j, it);
                    else { const int u = (it - DB) * 2; mix_unit(lds, j, u >> 3, u & 7); mix_unit(lds, j, (u + 1) >> 3, (u + 1) & 7); }
                }
                }
                SEAM(pb + 1);
            }
        }
        if (SITE(7) && IN(pb + 4)) {
            LOCALS
            const bf16* wo = (L & 1) ? (const bf16*)(ws + WS_WOUTC) + (size_t)j * D * D : (const bf16*)(ws + WS_WOUTAB) + (size_t)j * D * D;
            { pg8::Gemm g{oc, wo, MP, D, D}; pg8::StaticOrder S; S.init(MP, D, G, bid, WGM_E);
              if (NREP(7) == 2) { EpiResid E2{hb, (bf16*)(ws + WS_DUMMY + 64 * MiB), (float*)(ws + WS_DUMMY + 96 * MiB)}; pg8::gemm_phase<EpiResid, pg8::StaticOrder, true, true>(ring, g, S, E2);
                  SEpiResid E3{(float*)(ws + WS_DUMMY + 98 * MiB), (bf16*)(ws + WS_DUMMY + 99 * MiB)}; skinny_gemm<false, 4, SEpiResid>(lds, ocs, D, wo, D, bid, G, E3); }
              EpiResid E{hb, hb, ssq};
              pg8::gemm_phase<EpiResid, pg8::StaticOrder, true, true>(ring, g, S, E); }
            { SEpiResid E{hs, hsb}; skinny_gemm<false, 4, SEpiResid>(lds, ocs, D, wo, D, bid, G, E); }
            SEAM(pb + 4);
        }
        if (SITE(8) && IN(pb + 5)) {
            LOCALS
            const bf16* w1 = (const bf16*)(ws + WS_WF1) + (size_t)L * FF * D;
            for (int rep = 0; rep < NREP(8); ++rep) {
            { pg8::Gemm g{hb, w1, MP, FF, D}; pg8::StaticOrder S; S.init(MP, FF, G, bid, WGM_F); EpiFFN1 E{hff, ssq};
              pg8::gemm_phase<EpiFFN1, pg8::StaticOrder, true, true>(ring, g, S, E); }
            { SEpiFFN1 E{hffs}; skinny_gemm<true, 4, SEpiFFN1>(lds, hsb, D, w1, FF, bid, G, E); }
            }
            SEAM(pb + 5);
        }
        if (SITE(9) && IN(pb + 6)) {
            LOCALS
            const bf16* w2 = (const bf16*)(ws + WS_WF2) + (size_t)L * D * FF;
            { pg8::Gemm g{hff, w2, MP, D, FF}; pg8::StaticOrder S; S.init(MP, D, G, bid, WGM_G);
              if (NREP(9) == 2) { EpiResid E2{hb, (bf16*)(ws + WS_DUMMY + 64 * MiB), (float*)(ws + WS_DUMMY + 96 * MiB)}; pg8::gemm_phase<EpiResid, pg8::StaticOrder, true, true>(ring, g, S, E2);
                  SEpiResid E3{(float*)(ws + WS_DUMMY + 98 * MiB), (bf16*)(ws + WS_DUMMY + 99 * MiB)}; skinny_gemm<false, 16, SEpiResid>(lds, hffs, FF, w2, D, bid, G, E3); }
              EpiResid E{hb, hb, ssq};
              pg8::gemm_phase<EpiResid, pg8::StaticOrder, true, true>(ring, g, S, E); }
            { SEpiResid E{hs, hsb}; skinny_gemm<false, 16, SEpiResid>(lds, hffs, FF, w2, D, bid, G, E); }
            SEAM(pb + 6);
        }
    }
    if (SITE(10) && IN(29)) for (int rep = 0; rep < NREP(10); ++rep) final_norm(bid, G);
#undef IN
#undef SEAM
#undef LOCALS
}

extern "C" void kernel_launch(void* const* d_in, const int* in_sizes, int n_in, void* d_out, int out_size, void* d_ws, size_t ws_size, hipStream_t stream) {
    static int grid = 0;
    if (grid == 0) {
        if (n_in != 25 || (size_t)out_size != O_END || ws_size < WS_END + 100 * MiB) { fprintf(stderr, "kernel_launch: unexpected shapes (n_in %d out %d ws %zu)\n", n_in, out_size, ws_size); grid = -1; return; }
        int dev = 0, cus = 0, per_cu = 0;
        if (hipGetDevice(&dev) != hipSuccess || hipDeviceGetAttribute(&cus, hipDeviceAttributeMultiprocessorCount, dev) != hipSuccess) { grid = -1; return; }
        if (hipFuncSetAttribute((const void*)mega_fwd, hipFuncAttributeMaxDynamicSharedMemorySize, LDS_BYTES) != hipSuccess) { fprintf(stderr, "kernel_launch: hipFuncSetAttribute failed\n"); grid = -1; return; }
        if (hipOccupancyMaxActiveBlocksPerMultiprocessor(&per_cu, (const void*)mega_fwd, 512, LDS_BYTES) != hipSuccess || per_cu < 1) fprintf(stderr, "kernel_launch: occupancy query says %d\n", per_cu);
        (void)hipGetLastError();
        grid = cus;
    }
    if (grid < 0) return;
    (void)hipMemsetAsync((char*)d_ws + WS_CTL, 0, CTL_ZERO_BYTES, stream);
    Args a{};
    for (int i = 0; i < 25; ++i) a.in[i] = d_in[i];
    a.out = (float*)d_out; a.ws = (unsigned char*)d_ws;
#if MK_ONE_LAUNCH
#ifndef PROBE_PRE
#define PROBE_PRE 0
#endif
    if (PROBE_PRE > 0) {
        a.ph_lo = 0; a.ph_hi = PROBE_PRE; hipLaunchKernelGGL(mega_fwd, dim3(grid), dim3(512), LDS_BYTES, stream, a);
        (void)hipMemsetAsync((char*)d_ws + WS_CTL, 0, CTL_ZERO_BYTES, stream); }
    a.ph_lo = 0; a.ph_hi = N_PHASES;
    hipLaunchKernelGGL(mega_fwd, dim3(grid), dim3(512), LDS_BYTES, stream, a);
#else
    for (int ph = 0; ph < N_PHASES; ++ph) {
        if (ph >= 1 && ph <= 28) { const int L = (ph - 1) / 7, loc = (ph - 1) % 7; if ((L & 1) && (loc == 2 || loc == 3)) continue; }
        a.ph_lo = ph; a.ph_hi = ph + 1;
        hipLaunchKernelGGL(mega_fwd, dim3(grid), dim3(512), LDS_BYTES, stream, a);
    }
#endif
}
```

```cpp
#include <hip/hip_runtime.h>
#include <cstdio>
#include <cstdint>

#ifndef MK_ONE_LAUNCH
#define MK_ONE_LAUNCH 1
#endif

#define DI __device__ __forceinline__
#define LAS __attribute__((address_space(3)))
#define GAS __attribute__((address_space(1)))
typedef unsigned short bf16;
typedef short bf16x8 __attribute__((ext_vector_type(8)));
typedef short s16x4 __attribute__((ext_vector_type(4)));
typedef float f32x4 __attribute__((ext_vector_type(4)));
typedef float f32x2 __attribute__((ext_vector_type(2)));
typedef unsigned u32x4 __attribute__((ext_vector_type(4)));
typedef unsigned u32x2 __attribute__((ext_vector_type(2)));
typedef unsigned long long u64;

constexpr int D = 1024, BATCH = 4, SEQ = 4096, MP = BATCH * SEQ, DB = 32, PAST = 8192, NPAGES = 64, NPOOL = 2560;
constexpr int ABC = 3352, ABP = 3584, FF = 4096;
constexpr float EPS = 1e-6f;
constexpr int C_Q = 0, C_F = 512, C_I = 1024, C_G = 1536, C_QB = 2048, C_CMP = 2560, C_SEL = 2816, C_WIN = 3072, C_GATE = 3328;

constexpr size_t O_YP = 0, O_YS = 16777216, O_CMP_P = O_YS + 32768, O_CMP_S = O_CMP_P + 8388608, O_SEL_P = O_CMP_S + 16384, O_SEL_S = O_SEL_P + 8388608,
                 O_WIN_P = O_SEL_S + 16384, O_WIN_S = O_WIN_P + 1048576, O_HG_P = O_WIN_S + 8388608, O_HG_S = O_HG_P + 524288, O_CV_S = O_HG_S + 4194304, O_END = O_CV_S + 65536;

constexpr size_t MiB = 1u << 20;
constexpr size_t WS_CTL = 0, CTL_ZERO_BYTES = 1 * MiB;
constexpr size_t WS_WINAB = 2 * MiB, WS_WOUTAB = 16 * MiB, WS_WINC = 20 * MiB, WS_WOUTC = 28 * MiB, WS_WF1 = 32 * MiB, WS_WF2 = 64 * MiB, WS_WC1 = 96 * MiB, WS_WC2 = 98 * MiB,
                 WS_TRIL = 99 * MiB, WS_SMALL = 100 * MiB, WS_HP = 104 * MiB, WS_HB = 168 * MiB, WS_SSQ = 200 * MiB, WS_VSTAT = 201 * MiB, WS_ZB = 204 * MiB, WS_HFF = 316 * MiB,
                 WS_OC = 444 * MiB, WS_LT = 476 * MiB, WS_DL = 540 * MiB, WS_KCP = 541 * MiB, WS_KCS = 542 * MiB, WS_SMP = 558 * MiB, WS_END = 560 * MiB, WS_DUMMY = 560 * MiB;
constexpr size_t WS_MSK = WS_SMALL + 1 * MiB;
constexpr size_t SMP_HS = 0, SMP_ZS = 128 * 1024, SMP_OCS = 576 * 1024, SMP_HFFS = 704 * 1024, SMP_UVS = 1216 * 1024, SMP_HSB = 1472 * 1024;

constexpr int LDS_BYTES = 163840;
constexpr int MISC_OFF = LDS_BYTES - 64;

DI unsigned pk2(float lo, float hi) { typedef __bf16 bf2 __attribute__((ext_vector_type(2))); f32x2 v = {lo, hi}; bf2 b = __builtin_convertvector(v, bf2); return __builtin_bit_cast(unsigned, b); }
DI bf16 f2bf(float x) { return (bf16)(pk2(x, 0.f) & 0xffffu); }
DI float bf2f(bf16 h) { return __uint_as_float((unsigned)h << 16); }
DI float bflo(unsigned u) { return __uint_as_float(u << 16); }
DI float bfhi(unsigned u) { return __uint_as_float(u & 0xffff0000u); }
DI float sigmoidf_(float x) { return __builtin_amdgcn_rcpf(1.f + __expf(-x)); }
DI float siluf_(float x) { return x * __builtin_amdgcn_rcpf(1.f + __expf(-x)); }
DI float gelu_tanh(float x) { const float u = 0.7978845608028654f * (x + 0.044715f * x * x * x); return x * __builtin_amdgcn_rcpf(1.f + __expf(-2.f * u)); }
DI float wave_sum(float v) {
#pragma unroll
    for (int o = 1; o < 64; o <<= 1) v += __shfl_xor(v, o);
    return v;
}
DI float wave_max(float v) {
#pragma unroll
    for (int o = 1; o < 64; o <<= 1) v = fmaxf(v, __shfl_xor(v, o));
    return v;
}
DI float fmax2(float a, float b) { float r; asm("v_max_f32 %0, %1, %2" : "=v"(r) : "v"(a), "v"(b)); return r; }
DI float fmax3(float a, float b, float c) { float r; asm("v_max3_f32 %0, %1, %2, %3" : "=v"(r) : "v"(a), "v"(b), "v"(c)); return r; }
DI float quad_max(float v) {
    auto a = __builtin_amdgcn_permlane16_swap(__float_as_uint(v), __float_as_uint(v), false, false); v = fmax2(__uint_as_float(a[0]), __uint_as_float(a[1]));
    auto b = __builtin_amdgcn_permlane32_swap(__float_as_uint(v), __float_as_uint(v), false, false); return fmax2(__uint_as_float(b[0]), __uint_as_float(b[1]));
}
DI float quad_sum(float v) {
    auto a = __builtin_amdgcn_permlane16_swap(__float_as_uint(v), __float_as_uint(v), false, false); v = __uint_as_float(a[0]) + __uint_as_float(a[1]);
    auto b = __builtin_amdgcn_permlane32_swap(__float_as_uint(v), __float_as_uint(v), false, false); return __uint_as_float(b[0]) + __uint_as_float(b[1]);
}
DI bf16x8 pack8(f32x4 a, f32x4 b) { u32x4 p; p.x = pk2(a.x, a.y); p.y = pk2(a.z, a.w); p.z = pk2(b.x, b.y); p.w = pk2(b.z, b.w); return __builtin_bit_cast(bf16x8, p); }
DI int otid() { int t = threadIdx.x; asm volatile("" : "+v"(t)); return t; }
#define MFMA16(a, b, c) __builtin_amdgcn_mfma_f32_16x16x32_bf16((a), (b), (c), 0, 0, 0)
DI s16x4 vtr(const bf16* p) { return __builtin_bit_cast(s16x4, __builtin_amdgcn_ds_read_tr16_b64_v4i16((LAS s16x4*)(LAS char*)p)); }
DI bf16x8 tr_frag(const bf16* img, int stride, int k0, int c0, int r16, int quad) {
    const bf16* p = img + (k0 + quad * 8 + (r16 >> 2)) * stride + c0 + (r16 & 3) * 4;
    const s16x4 lo = vtr(p), hi = vtr(p + 4 * stride);
    return __builtin_shufflevector(lo, hi, 0, 1, 2, 3, 4, 5, 6, 7);
}

namespace pg8 {
#define PG8_LAS __attribute__((address_space(3)))
constexpr int BM = 256, BK = 64, HALF = 128, HTB = HALF * BK * 2, STAGE_BYTES = 8 * HTB, NXCD = 8, WGM = 4;
__host__ __device__ __forceinline__ int lds_byte(int r, int c) { const int st = (r >> 4) * 2 + (c >> 5), rr = r & 15, cc = c & 31, ob = rr * 64 + cc * 2; return st * 1024 + (ob ^ (((ob >> 9) & 1) << 5)); }
__host__ __device__ __forceinline__ void stage_rc(int b, int& R, int& C) { const int st = b / 1024, sb = b % 1024, swz = sb ^ (((sb >> 9) & 1) << 5); R = (st >> 1) * 16 + swz / 64; C = (st & 1) * 32 + (swz % 64) / 2; }
__host__ __device__ __forceinline__ int perm32(int rho) { const int n = rho >> 4, i = rho & 15; return 8 * (i >> 2) + 4 * n + (i & 3); }
struct Unit { int pm, pn; };
struct Gemm { const bf16* A; const bf16* Bt; int M, N, K; };
struct StaticOrder {
    int nM, nN, nwg, G, c, wgm;
    __host__ __device__ void init(int M, int N, int G_, int c_, int wgm_ = WGM) { nM = M / BM; nN = N / BM; nwg = nM * nN; G = G_; c = c_; wgm = wgm_; }
    __host__ __device__ bool next(int i, Unit& u) const {
        const long L = (long)i * G + c; if (L >= nwg) return false;
        int wgid = (int)L; { const int q = nwg / NXCD, r = nwg % NXCD, xcd = wgid % NXCD, off = wgid / NXCD; wgid = (xcd < r ? xcd * (q + 1) : r * (q + 1) + (xcd - r) * q) + off; }
        const int nig = wgm * nN, gid = wgid / nig, fm = gid * wgm, gsz = (nM - fm) < wgm ? (nM - fm) : wgm;
        u.pm = fm + ((wgid % nig) % gsz); u.pn = (wgid % nig) / gsz; return true;
    }
    __device__ __forceinline__ void a_ready(const Unit&) const {}
    __device__ __forceinline__ void done(const Unit&) const {}
};
template <class Epi, class Sched, bool ALIGN_EPI = false, bool SP2 = false>
__device__ __forceinline__ void gemm_phase(PG8_LAS unsigned char* lds, const Gemm g, const Sched& S, const Epi& E) {
    const int tid = otid(), wid = __builtin_amdgcn_readfirstlane(tid >> 6), lane = tid & 63, wr = wid >> 2, wc = wid & 3, fr = lane & 15, fq = lane >> 4;
    const int K = g.K, nt = K / BK;
    unsigned voffA[2], voffB[2];
#pragma unroll
    for (int i = 0; i < 2; ++i) { int R, C; stage_rc(tid * 16 + i * 8192, R, C); const int Rb = Epi::PERM ? ((R & ~31) + perm32(R & 31)) : R;
        voffA[i] = (unsigned)(R * K + C) * 2u; voffB[i] = (unsigned)(Rb * K + C) * 2u; }
    const size_t kstep = (size_t)(BK * 2);
    const size_t hstep = (size_t)HALF * K * 2;
    const size_t tstep = 2 * hstep;
    const unsigned ldsw = (unsigned)wid * 1024u;
    const int aoff = lds_byte(wr * 64 + fr, fq * 8), boff = lds_byte(wc * 32 + fr, fq * 8);
#define PG8_SA(b, h) (((b) * 2 + (h)) * HTB)
#define PG8_SB(b, h) ((4 + (b) * 2 + (h)) * HTB)
#define PG8_STAGE(bufoff, gbase, voff) do { _Pragma("unroll") for (int _i = 0; _i < 2; ++_i) \
        __builtin_amdgcn_global_load_lds((const unsigned*)((const char*)(gbase) + (voff)[_i]), (PG8_LAS unsigned*)(lds + (bufoff) + ldsw + _i * 8192), 16, 0, 0); } while (0)
#define PG8_LDA(dst, b, h) do { _Pragma("unroll") for (int m = 0; m < 4; ++m) _Pragma("unroll") for (int k = 0; k < 2; ++k) dst[m][k] = *(const PG8_LAS bf16x8*)(lds + PG8_SA(b, h) + aoff + m * 2048 + k * 1024); } while (0)
#define PG8_LDB(dst, b, h) do { _Pragma("unroll") for (int n = 0; n < 2; ++n) _Pragma("unroll") for (int k = 0; k < 2; ++k) dst[n][k] = *(const PG8_LAS bf16x8*)(lds + PG8_SB(b, h) + boff + n * 2048 + k * 1024); } while (0)
#define PG8_MMA(ai, bj, At, Bt) do { __builtin_amdgcn_s_setprio(1); _Pragma("unroll") for (int m = 0; m < 4; ++m) _Pragma("unroll") for (int n = 0; n < 2; ++n) _Pragma("unroll") for (int k = 0; k < 2; ++k) \
        acc[ai][bj][m][n] = __builtin_amdgcn_mfma_f32_16x16x32_bf16(Bt[n][k], At[m][k], acc[ai][bj][m][n], 0, 0, 0); __builtin_amdgcn_s_setprio(0); } while (0)
#define PG8_WAIT_V(n) asm volatile("s_waitcnt vmcnt(" #n ")" ::: "memory")
#define PG8_WAIT_L(n) asm volatile("s_waitcnt lgkmcnt(" #n ")" ::: "memory")
#define PG8_BAR __builtin_amdgcn_s_barrier()
#define PG8_SCHED __builtin_amdgcn_sched_barrier(0)
    Unit cur, nxt; int ui = 0;
    if (!S.next(0, cur)) return;
    f32x4 acc[2][2][4][2];
#pragma unroll
    for (int a = 0; a < 2; ++a)
#pragma unroll
        for (int b = 0; b < 2; ++b)
#pragma unroll
            for (int m = 0; m < 4; ++m)
#pragma unroll
                for (int n = 0; n < 2; ++n) acc[a][b][m][n] = (f32x4){0.f, 0.f, 0.f, 0.f};
    bf16x8 At[4][2], B0[2][2], B1[2][2];
    const char* cA = (const char*)g.A + (size_t)cur.pm * tstep; const char* cB = (const char*)g.Bt + (size_t)cur.pn * tstep;
    S.a_ready(cur);
    if constexpr (SP2) {
        PG8_STAGE(PG8_SB(0, 0), cB, voffB); PG8_STAGE(PG8_SB(0, 1), cB + hstep, voffB); PG8_STAGE(PG8_SA(0, 0), cA, voffA); PG8_STAGE(PG8_SA(0, 1), cA + hstep, voffA);
        if (wr == 1) PG8_BAR;
        PG8_WAIT_V(2); PG8_BAR;
        PG8_STAGE(PG8_SB(1, 0), cB + kstep, voffB); PG8_STAGE(PG8_SA(1, 0), cA + kstep, voffA); PG8_STAGE(PG8_SB(1, 1), cB + hstep + kstep, voffB);
        PG8_WAIT_V(6); PG8_BAR;
    } else {
        PG8_STAGE(PG8_SB(0, 0), cB, voffB); PG8_STAGE(PG8_SA(0, 0), cA, voffA); PG8_STAGE(PG8_SB(0, 1), cB + hstep, voffB); PG8_STAGE(PG8_SA(0, 1), cA + hstep, voffA);
        if (wr == 1) PG8_BAR;
        PG8_WAIT_V(4); PG8_BAR;
        PG8_STAGE(PG8_SB(1, 0), cB + kstep, voffB); PG8_STAGE(PG8_SA(1, 0), cA + kstep, voffA); PG8_STAGE(PG8_SB(1, 1), cB + hstep + kstep, voffB);
        PG8_WAIT_V(6); PG8_BAR;
    }
    for (;;) {
        const bool has_next = S.next(ui + 1, nxt);
        const char* nA = has_next ? (const char*)g.A + (size_t)nxt.pm * tstep : cA; const char* nB = has_next ? (const char*)g.Bt + (size_t)nxt.pn * tstep : cB;
        for (int t = 0; t < nt; t += 2) {
            const bool last = (t == nt - 2);
            const char* a1 = cA + (size_t)(t + 1) * kstep;
            const char* a2 = last ? nA : cA + (size_t)(t + 2) * kstep; const char* b2 = last ? nB : cB + (size_t)(t + 2) * kstep;
            const char* a3 = a2 + kstep; const char* b3 = b2 + kstep;
            if (last && has_next) S.a_ready(nxt);
            if constexpr (SP2) {
            PG8_LDB(B0, 0, 0); PG8_LDB(B1, 0, 1); PG8_SCHED; PG8_LDA(At, 0, 0); PG8_STAGE(PG8_SA(1, 1), a1 + hstep, voffA);
            PG8_WAIT_V(8); PG8_WAIT_L(0); PG8_BAR; PG8_MMA(0, 0, At, B0); PG8_MMA(0, 1, At, B1); PG8_BAR; PG8_SCHED;
            PG8_LDA(At, 0, 1); PG8_STAGE(PG8_SB(0, 0), b2, voffB); PG8_STAGE(PG8_SB(0, 1), b2 + hstep, voffB); PG8_STAGE(PG8_SA(0, 0), a2, voffA);
            PG8_WAIT_V(8); PG8_WAIT_L(0); PG8_BAR; PG8_MMA(1, 0, At, B0); PG8_MMA(1, 1, At, B1); PG8_BAR; PG8_SCHED;
            PG8_LDB(B0, 1, 0); PG8_LDB(B1, 1, 1); PG8_SCHED; PG8_LDA(At, 1, 0); PG8_STAGE(PG8_SA(0, 1), a2 + hstep, voffA);
            PG8_WAIT_V(8); PG8_WAIT_L(0); PG8_BAR; PG8_MMA(0, 0, At, B0); PG8_MMA(0, 1, At, B1); PG8_BAR; PG8_SCHED;
            PG8_LDA(At, 1, 1); PG8_STAGE(PG8_SB(1, 0), b3, voffB); PG8_STAGE(PG8_SB(1, 1), b3 + hstep, voffB); PG8_STAGE(PG8_SA(1, 0), a3, voffA);
            PG8_WAIT_V(8); PG8_WAIT_L(0); PG8_BAR; PG8_MMA(1, 0, At, B0); PG8_MMA(1, 1, At, B1); PG8_BAR; PG8_SCHED;
            } else {
            PG8_LDB(B0, 0, 0); PG8_SCHED; PG8_LDA(At, 0, 0); PG8_STAGE(PG8_SA(1, 1), a1 + hstep, voffA);
            PG8_WAIT_L(8); PG8_BAR; PG8_WAIT_L(0); PG8_MMA(0, 0, At, B0); PG8_BAR; PG8_SCHED;
            PG8_LDB(B1, 0, 1); PG8_STAGE(PG8_SB(0, 0), b2, voffB);
            PG8_BAR; PG8_WAIT_L(0); PG8_MMA(0, 1, At, B1); PG8_BAR;
            PG8_LDA(At, 0, 1); PG8_STAGE(PG8_SA(0, 0), a2, voffA);
            PG8_BAR; PG8_WAIT_L(0); PG8_MMA(1, 0, At, B0); PG8_BAR; PG8_SCHED;
            PG8_STAGE(PG8_SB(0, 1), b2 + hstep, voffB);
            PG8_WAIT_V(6); PG8_BAR; PG8_MMA(1, 1, At, B1); PG8_BAR;
            PG8_LDB(B0, 1, 0); PG8_SCHED; PG8_LDA(At, 1, 0); PG8_STAGE(PG8_SA(0, 1), a2 + hstep, voffA);
            PG8_WAIT_L(8); PG8_BAR; PG8_WAIT_L(0); PG8_MMA(0, 0, At, B0); PG8_BAR; PG8_SCHED;
            PG8_LDB(B1, 1, 1); PG8_STAGE(PG8_SB(1, 0), b3, voffB);
            PG8_BAR; PG8_WAIT_L(0); PG8_MMA(0, 1, At, B1); PG8_BAR;
            PG8_LDA(At, 1, 1); PG8_STAGE(PG8_SA(1, 0), a3, voffA);
            PG8_BAR; PG8_WAIT_L(0); PG8_MMA(1, 0, At, B0); PG8_BAR; PG8_SCHED;
            PG8_STAGE(PG8_SB(1, 1), b3 + hstep, voffB);
            PG8_WAIT_V(6); PG8_BAR; PG8_MMA(1, 1, At, B1); PG8_BAR;
            }
        }
        if constexpr (ALIGN_EPI) { if (wr == 0) PG8_BAR; }
        if constexpr (!Epi::AFTER_DRAIN) { E(acc, cur, wr, wc, fr, fq); S.done(cur); }
        if (!has_next) break;
#pragma unroll
        for (int a = 0; a < 2; ++a)
#pragma unroll
            for (int b = 0; b < 2; ++b)
#pragma unroll
                for (int m = 0; m < 4; ++m)
#pragma unroll
                    for (int n = 0; n < 2; ++n) acc[a][b][m][n] = (f32x4){0.f, 0.f, 0.f, 0.f};
        cur = nxt; cA = nA; cB = nB; ++ui;
        if constexpr (ALIGN_EPI) { if (wr == 1) PG8_BAR; }
    }
    PG8_WAIT_V(0);
    if constexpr (!ALIGN_EPI) { if (wr == 0) PG8_BAR; }
    PG8_BAR;
#undef PG8_SA
#undef PG8_SB
#undef PG8_STAGE
#undef PG8_LDA
#undef PG8_LDB
#undef PG8_MMA
#undef PG8_WAIT_V
#undef PG8_WAIT_L
#undef PG8_BAR
#undef PG8_SCHED
}
}
using pg8::Unit;

DI float row_rstd16(const float* ssq, int row, int fq) {
    const f32x4 a = *(const f32x4*)(ssq + (size_t)row * 16 + fq * 4);
    const float s = quad_sum((a.x + a.y) + (a.z + a.w));
    return rsqrtf(s * (1.f / 1024.f) + EPS);
}
struct EpiInAB {
    static constexpr bool PERM = true, AFTER_DRAIN = false;
    bf16* zb; const float* ssq; float* o_cmp; float* o_sel; float* o_win;
    DI void operator()(const f32x4 (&acc)[2][2][4][2], const Unit& u, int wr, int wc, int fr, int fq) const {
#pragma unroll
        for (int ai = 0; ai < 2; ++ai)
#pragma unroll
            for (int m = 0; m < 4; ++m) {
                const int row = u.pm * 256 + ai * 128 + wr * 64 + m * 16 + fr; const float rs = row_rstd16(ssq, row, fq);
#pragma unroll
                for (int bj = 0; bj < 2; ++bj) {
                    const int cl = bj * 128 + wc * 32 + fq * 8, col = u.pn * 256 + cl;
                    const f32x4 v0 = acc[ai][bj][m][0] * rs, v1 = acc[ai][bj][m][1] * rs;
                    u32x4 w; w.x = pk2(v0[0], v0[1]); w.y = pk2(v0[2], v0[3]); w.z = pk2(v1[0], v1[1]); w.w = pk2(v1[2], v1[3]);
                    *(u32x4*)(zb + (size_t)row * ABP + col) = w;
                    if (u.pn == 10) { float* o = o_cmp + (size_t)row * 256 + cl; *(f32x4*)o = v0; *(f32x4*)(o + 4) = v1; }
                    else if (u.pn == 11) { float* o = o_sel + (size_t)row * 256 + cl; *(f32x4*)o = v0; *(f32x4*)(o + 4) = v1; }
                    else if (u.pn == 12) { const int t = row & 4095, b = row >> 12; if (t >= SEQ - 512) { float* o = o_win + ((size_t)b * 512 + (t - (SEQ - 512))) * 256 + cl; *(f32x4*)o = v0; *(f32x4*)(o + 4) = v1; } }
                }
            }
    }
};
struct EpiResid {
    static constexpr bool PERM = true, AFTER_DRAIN = false;
    const bf16* res; bf16* hb; float* ssq;
    DI void operator()(const f32x4 (&acc)[2][2][4][2], const Unit& u, int wr, int wc, int fr, int fq) const {
#pragma unroll
        for (int ai = 0; ai < 2; ++ai)
#pragma unroll
            for (int m = 0; m < 4; ++m) {
                const int row = u.pm * 256 + ai * 128 + wr * 64 + m * 16 + fr; float ss = 0.f;
#pragma unroll
                for (int bj = 0; bj < 2; ++bj) {
                    const int col = u.pn * 256 + bj * 128 + wc * 32 + fq * 8; const size_t o = (size_t)row * D + col;
                    const u32x4 r8 = *(const u32x4*)(res + o);
                    const f32x4 v0 = acc[ai][bj][m][0] + (f32x4){bflo(r8.x), bfhi(r8.x), bflo(r8.y), bfhi(r8.y)}, v1 = acc[ai][bj][m][1] + (f32x4){bflo(r8.z), bfhi(r8.z), bflo(r8.w), bfhi(r8.w)};
                    u32x4 w; w.x = pk2(v0[0], v0[1]); w.y = pk2(v0[2], v0[3]); w.z = pk2(v1[0], v1[1]); w.w = pk2(v1[2], v1[3]);
                    *(u32x4*)(hb + o) = w;
                    ss += (v0[0] * v0[0] + v0[1] * v0[1]) + (v0[2] * v0[2] + v0[3] * v0[3]) + (v1[0] * v1[0] + v1[1] * v1[1]) + (v1[2] * v1[2] + v1[3] * v1[3]);
                }
                ss = quad_sum(ss);
                if (fq == 0) ssq[(size_t)row * 16 + u.pn * 4 + wc] = ss;
            }
    }
};
struct EpiFFN1 {
    static constexpr bool PERM = true, AFTER_DRAIN = false;
    bf16* hff; const float* ssq;
    DI void operator()(const f32x4 (&acc)[2][2][4][2], const Unit& u, int wr, int wc, int fr, int fq) const {
#pragma unroll
        for (int ai = 0; ai < 2; ++ai)
#pragma unroll
            for (int m = 0; m < 4; ++m) {
                const int row = u.pm * 256 + ai * 128 + wr * 64 + m * 16 + fr; const float rs = row_rstd16(ssq, row, fq);
#pragma unroll
                for (int bj = 0; bj < 2; ++bj) {
                    const int col = u.pn * 256 + bj * 128 + wc * 32 + fq * 8;
                    f32x4 v0 = acc[ai][bj][m][0] * rs, v1 = acc[ai][bj][m][1] * rs;
#pragma unroll
                    for (int i = 0; i < 4; ++i) { const float a = fmaxf(v0[i], 0.f), b = fmaxf(v1[i], 0.f); v0[i] = a * a; v1[i] = b * b; }
                    u32x4 w; w.x = pk2(v0[0], v0[1]); w.y = pk2(v0[2], v0[3]); w.z = pk2(v1[0], v1[1]); w.w = pk2(v1[2], v1[3]);
                    *(u32x4*)(hff + (size_t)row * FF + col) = w;
                }
            }
    }
};
struct EpiInC {
    static constexpr bool PERM = true, AFTER_DRAIN = false;
    bf16* ub; bf16* vb; const float* ssq; float* vstat;
    DI void operator()(const f32x4 (&acc)[2][2][4][2], const Unit& u, int wr, int wc, int fr, int fq) const {
        const bool isv = u.pn >= 4; bf16* dst = isv ? vb : ub; const int pn = isv ? u.pn - 4 : u.pn;
#pragma unroll
        for (int ai = 0; ai < 2; ++ai)
#pragma unroll
            for (int m = 0; m < 4; ++m) {
                const int row = u.pm * 256 + ai * 128 + wr * 64 + m * 16 + fr; const float rs = row_rstd16(ssq, row, fq); float s1 = 0.f, s2 = 0.f;
#pragma unroll
                for (int bj = 0; bj < 2; ++bj) {
                    const int col = pn * 256 + bj * 128 + wc * 32 + fq * 8;
                    f32x4 v0 = acc[ai][bj][m][0] * rs, v1 = acc[ai][bj][m][1] * rs;
#pragma unroll
                    for (int i = 0; i < 4; ++i) { v0[i] = gelu_tanh(v0[i]); v1[i] = gelu_tanh(v1[i]); s1 += v0[i] + v1[i]; s2 += v0[i] * v0[i] + v1[i] * v1[i]; }
                    u32x4 w; w.x = pk2(v0[0], v0[1]); w.y = pk2(v0[2], v0[3]); w.z = pk2(v1[0], v1[1]); w.w = pk2(v1[2], v1[3]);
                    *(u32x4*)(dst + (size_t)row * D + col) = w;
                }
                if (isv) { s1 = quad_sum(s1); s2 = quad_sum(s2);
                    if (fq == 0) *(f32x2*)(vstat + ((size_t)row * 16 + pn * 4 + wc) * 2) = (f32x2){s1, s2}; }
            }
    }
};

DI unsigned* ctl_words();
DI void publish_count(int idx) {
    asm volatile("s_waitcnt vmcnt(0)" ::: "memory");
    __syncthreads();
    if (threadIdx.x == 0) { __builtin_amdgcn_fence(__ATOMIC_RELEASE, "agent"); asm volatile("s_waitcnt vmcnt(0)" ::: "memory");
        __hip_atomic_fetch_add(ctl_words() + 4096 + 64 * idx, 1u, __ATOMIC_RELAXED, __HIP_MEMORY_SCOPE_AGENT); }
}
DI void wait_count(int idx, unsigned n) {
    if (threadIdx.x == 0) { unsigned* c = ctl_words() + 4096 + 64 * idx; unsigned sp = 0;
        while (__hip_atomic_load(c, __ATOMIC_RELAXED, __HIP_MEMORY_SCOPE_AGENT) < n) { __builtin_amdgcn_s_sleep(2); if (++sp > (1u << 22)) break; }
        __builtin_amdgcn_fence(__ATOMIC_ACQUIRE, "agent"); asm volatile("s_waitcnt vmcnt(0)" ::: "memory"); }
    __syncthreads();
}
DI float dot8sq(bf16x8 x) { const u32x4 u = __builtin_bit_cast(u32x4, x); float s = 0.f;
#pragma unroll
    for (int i = 0; i < 4; ++i) { const float a = bflo(u[i]), b = bfhi(u[i]); s += a * a + b * b; }
    return s; }
template <bool NORM, int KS, class Epi>
DI void skinny_gemm(unsigned char* lds, const bf16* A, int lda, const bf16* Wt, int N, int bid, int G, const Epi& E) {
    constexpr int K = KS * 32 * 8;
    float* red = (float*)lds; float* sred = red + 8 * 2 * 64 * 4;
    const int tid = otid(), wave = tid >> 6, lane = tid & 63, r16 = lane & 15, quad = lane >> 4, ksl = KS * 32;
    for (int task = bid; task < (N >> 4); task += G) {
        const int n0 = task * 16;
        f32x4 acc0 = {0.f, 0.f, 0.f, 0.f}, acc1 = {0.f, 0.f, 0.f, 0.f}; float ss0 = 0.f, ss1 = 0.f;
        const bf16* wrow = Wt + (size_t)(n0 + r16) * K + wave * ksl + quad * 8;
        const bf16* a0 = A + (size_t)r16 * lda + wave * ksl + quad * 8; const bf16* a1 = a0 + (size_t)16 * lda;
#pragma unroll
        for (int k0 = 0; k0 < KS; k0 += 8) {
            constexpr int NB = (KS < 8) ? KS : 8;
            bf16x8 bq[NB], x0[NB], x1[NB];
#pragma unroll
            for (int u = 0; u < NB; ++u) { bq[u] = *(const bf16x8*)(wrow + (k0 + u) * 32); x0[u] = *(const bf16x8*)(a0 + (k0 + u) * 32); x1[u] = *(const bf16x8*)(a1 + (k0 + u) * 32); }
#pragma unroll
            for (int u = 0; u < NB; ++u) { if (NORM) { ss0 += dot8sq(x0[u]); ss1 += dot8sq(x1[u]); } acc0 = MFMA16(x0[u], bq[u], acc0); acc1 = MFMA16(x1[u], bq[u], acc1); }
        }
        if (NORM) { ss0 = quad_sum(ss0); ss1 = quad_sum(ss1); if (quad == 0) { sred[wave * 32 + r16] = ss0; sred[wave * 32 + 16 + r16] = ss1; } }
        *(f32x4*)(red + ((wave * 2 + 0) * 64 + lane) * 4) = acc0; *(f32x4*)(red + ((wave * 2 + 1) * 64 + lane) * 4) = acc1;
        __syncthreads();
        if (tid < 128) {
            const int rt = tid >> 6, l = tid & 63; f32x4 s = {0.f, 0.f, 0.f, 0.f};
#pragma unroll
            for (int w = 0; w < 8; ++w) s += *(const f32x4*)(red + ((w * 2 + rt) * 64 + l) * 4);
#pragma unroll
            for (int i = 0; i < 4; ++i) { const int row = rt * 16 + (l >> 4) * 4 + i, col = n0 + (l & 15); float sc = 1.f;
                if (NORM) { float q = 0.f;
#pragma unroll
                    for (int w = 0; w < 8; ++w) q += sred[w * 32 + row];
                    sc = rsqrtf(q / (float)K + EPS); }
                E(row, col, s[i] * sc); }
        }
        __syncthreads();
    }
}
struct SEpiInAB { float* zs; float* o_cmp; float* o_sel;
    DI void operator()(int row, int col, float v) const { zs[row * ABP + col] = v; if (col >= C_CMP && col < C_SEL) o_cmp[row * 256 + col - C_CMP] = v; else if (col >= C_SEL && col < C_WIN) o_sel[row * 256 + col - C_SEL] = v; } };
struct SEpiResid { float* hs; bf16* hsb; DI void operator()(int row, int col, float v) const { const float r = hs[row * D + col] + v; hs[row * D + col] = r; hsb[row * D + col] = f2bf(r); } };
struct SEpiFFN1 { bf16* h; DI void operator()(int row, int col, float v) const { const float a = fmaxf(v, 0.f); h[row * FF + col] = f2bf(a * a); } };
struct SEpiInC { float* uv; DI void operator()(int row, int col, float v) const { uv[row * 2048 + col] = gelu_tanh(v); } };

#define XB_TMO      128
#define XB_XCNT(j)  (256  + 64 * (j))
#define XB_XSUB(j)  (1280 + 64 * (j))
#define XB_XGEN(j)  (2304 + 64 * (j))
#define XB_TOP      3328
#define XB_TOPGEN   3392
#define XCD_BAR_WORDS 3456
#define XB_SPIN_CAP (1u << 18)
__device__ __forceinline__ unsigned xb_ld(unsigned* p)              { return __hip_atomic_load(p, __ATOMIC_RELAXED, __HIP_MEMORY_SCOPE_AGENT); }
__device__ __forceinline__ unsigned xb_add(unsigned* p, unsigned v) { return __hip_atomic_fetch_add(p, v, __ATOMIC_RELAXED, __HIP_MEMORY_SCOPE_AGENT); }
__device__ __forceinline__ unsigned xb_xcc_id() { return (unsigned)__builtin_amdgcn_s_getreg((3 << 11) | 20) & 0xFu; }
#define XB_SPIN(cond, bar) do { unsigned _sp = 0; while (cond) { __builtin_amdgcn_s_sleep(1); \
    if ((++_sp & 255u) == 0u) { if (xb_ld(&(bar)[XB_TMO])) break; if (_sp > XB_SPIN_CAP) { atomicAdd(&(bar)[XB_TMO], 1u); break; } } } } while (0)
struct XcdBarrier { unsigned* bar; unsigned x; volatile LAS unsigned* st; };
__device__ __forceinline__ XcdBarrier xcd_barrier_post(unsigned* bar, volatile LAS unsigned* st) {
    XcdBarrier b; b.bar = bar; b.x = xb_xcc_id(); b.st = st;
    if (threadIdx.x == 0) (void)xb_add(&bar[XB_XCNT(b.x)], 1u);
    return b;
}
__device__ __forceinline__ void xcd_barrier_complete(unsigned* bar, unsigned x, unsigned& nloc, unsigned& nx) {
    const unsigned G = gridDim.x * gridDim.y * gridDim.z;
    unsigned sum, cnt, mine, sp = 0u;
    for (;;) {
        sum = 0u; cnt = 0u; mine = 0u;
#pragma unroll
        for (unsigned j = 0; j < 16; ++j) { const unsigned c = xb_ld(&bar[XB_XCNT(j)]); sum += c; cnt += (c > 0u) ? 1u : 0u; mine = (j == x) ? c : mine; }
        if (sum == G) break;
        __builtin_amdgcn_s_sleep(1);
        if ((++sp & 255u) == 0u) { if (xb_ld(&bar[XB_TMO])) break; if (sp > XB_SPIN_CAP) { atomicAdd(&bar[XB_TMO], 1u); break; } }
    }
    nloc = mine > 0u ? mine : 1u; nx = cnt > 0u ? cnt : 1u;
}
__device__ __forceinline__ void xcd_barrier(const XcdBarrier& b) {
    asm volatile("s_waitcnt vmcnt(0)" ::: "memory");
    __syncthreads();
    if (threadIdx.x == 0) {
        unsigned* bar = b.bar;
        __builtin_amdgcn_s_waitcnt(0);
        unsigned nloc = b.st[0], nx = b.st[1];
        if (nloc == 0u) { xcd_barrier_complete(bar, b.x, nloc, nx); b.st[0] = nloc; b.st[1] = nx; }
        const unsigned old = xb_add(&bar[XB_XSUB(b.x)], 1u);
        const unsigned gen = old / nloc;
        if (old + 1u == (gen + 1u) * nloc) {
            __builtin_amdgcn_fence(__ATOMIC_RELEASE, "agent");
            asm volatile("s_waitcnt vmcnt(0)" ::: "memory");
            const unsigned og = xb_add(&bar[XB_TOP], 1u);
            const unsigned tg = og / nx;
            if (og + 1u == (tg + 1u) * nx) xb_add(&bar[XB_TOPGEN], 1u);
            else XB_SPIN(xb_ld(&bar[XB_TOPGEN]) == tg, bar);
            __builtin_amdgcn_fence(__ATOMIC_ACQUIRE, "agent");
            xb_add(&bar[XB_XGEN(b.x)], 1u);
            asm volatile("s_waitcnt vmcnt(0)" ::: "memory");
        } else {
            XB_SPIN(xb_ld(&bar[XB_XGEN(b.x)]) == gen, bar);
            __builtin_amdgcn_fence(__ATOMIC_ACQUIRE, "agent");
            asm volatile("s_waitcnt vmcnt(0)" ::: "memory");
        }
    }
    __syncthreads();
}

DI void transpose_item(const float* W, int K, int N, bf16* WT, const float* gain, float* scr, int item, int nblk, int lane) {
    const int kb = item / nblk, nb = item % nblk, k0 = 64 * kb, n0 = 64 * nb;
    const int kr = lane >> 4, nc = (lane & 15) * 4; const bool ok = (n0 + nc) < N;
    f32x4 v[16];
#pragma unroll
    for (int i = 0; i < 16; ++i) v[i] = ok ? *(const f32x4*)(W + (size_t)(k0 + 4 * i + kr) * N + n0 + nc) : (f32x4){0.f, 0.f, 0.f, 0.f};
#pragma unroll
    for (int i = 0; i < 16; ++i) { const int kk = 4 * i + kr; f32x4 x = v[i]; if (gain) x = x * gain[k0 + kk]; *(f32x4*)(scr + kk * 68 + nc) = x; }
    asm volatile("s_waitcnt lgkmcnt(0)" ::: "memory");
    const int c = lane & 7;
#pragma unroll
    for (int j = 0; j < 8; ++j) { const int nn = (lane >> 3) + 8 * j; const float* s = scr + (8 * c) * 68 + nn;
        u32x4 o; o.x = pk2(s[0 * 68], s[1 * 68]); o.y = pk2(s[2 * 68], s[3 * 68]); o.z = pk2(s[4 * 68], s[5 * 68]); o.w = pk2(s[6 * 68], s[7 * 68]);
        *(u32x4*)(WT + (size_t)(n0 + nn) * K + k0 + 8 * c) = o; }
    asm volatile("s_waitcnt lgkmcnt(0)" ::: "memory");
}

struct Args { const void* in[25]; float* out; unsigned char* ws; int ph_lo, ph_hi; };
struct Ptrs {
    const float *x_prompt, *x_sample, *cache_cmp, *cache_sel, *state_win, *state_hgrn; const int* page_table;
    const float *norm_mix, *norm_ffn, *norm_final, *w_in_ab, *w_out_ab, *hgrn_lb, *hgrn_norm, *cmp_pe, *cmp_w1, *cmp_w2, *w_in_c, *ln_c_g, *ln_c_b, *w_s, *b_s, *w_out_c, *w_ffn1, *w_ffn2;
    float* out; unsigned char* ws;
};
typedef const __attribute__((address_space(4))) Args* KArgs;
DI Ptrs get_ptrs() {
    KArgs a = (KArgs)__builtin_amdgcn_kernarg_segment_ptr(); asm volatile("" : "+s"(a));
    Ptrs P;
    P.x_prompt = (const float*)a->in[0]; P.x_sample = (const float*)a->in[1]; P.cache_cmp = (const float*)a->in[2]; P.cache_sel = (const float*)a->in[3];
    P.state_win = (const float*)a->in[4]; P.state_hgrn = (const float*)a->in[5]; P.page_table = (const int*)a->in[6];
    P.norm_mix = (const float*)a->in[7]; P.norm_ffn = (const float*)a->in[8]; P.norm_final = (const float*)a->in[9]; P.w_in_ab = (const float*)a->in[10]; P.w_out_ab = (const float*)a->in[11];
    P.hgrn_lb = (const float*)a->in[12]; P.hgrn_norm = (const float*)a->in[13]; P.cmp_pe = (const float*)a->in[14]; P.cmp_w1 = (const float*)a->in[15]; P.cmp_w2 = (const float*)a->in[16];
    P.w_in_c = (const float*)a->in[17]; P.ln_c_g = (const float*)a->in[18]; P.ln_c_b = (const float*)a->in[19]; P.w_s = (const float*)a->in[20]; P.b_s = (const float*)a->in[21];
    P.w_out_c = (const float*)a->in[22]; P.w_ffn1 = (const float*)a->in[23]; P.w_ffn2 = (const float*)a->in[24]; P.out = a->out; P.ws = a->ws;
    return P;
}

DI unsigned* ctl_words() { return (unsigned*)(get_ptrs().ws + WS_CTL); }
DI void prologue(unsigned char* lds, int bid, int G) {
    const Ptrs P = get_ptrs();
    const int tid = otid(), wave = tid >> 6, lane = tid & 63;
    float* scr = (float*)lds + wave * (64 * 68);
    const int gw = bid * 8 + wave, NGW = G * 8;
    unsigned char* ws = P.ws;
    for (int t = bid; t < 128; t += G) {
        const int q = t >> 5, part = t & 31;
        float* part_l = (float*)lds + 8 * 64 * 68;
        const float* pe = P.cmp_pe + (size_t)q * 2048 + part * 64 + wave * 8; const float* w1 = P.cmp_w1 + ((size_t)q * 2048 + part * 64 + wave * 8) * 128;
        float a0 = 0.f, a1 = 0.f;
#pragma unroll
        for (int f = 0; f < 8; ++f) { const float p = pe[f]; a0 += p * w1[(size_t)f * 128 + lane]; a1 += p * w1[(size_t)f * 128 + 64 + lane]; }
        part_l[wave * 128 + lane] = a0; part_l[wave * 128 + 64 + lane] = a1;
        __syncthreads();
        if (tid < 128) { float s = 0.f; for (int w = 0; w < 8; ++w) s += part_l[w * 128 + tid]; ((float*)(ws + WS_SMALL + 8192))[(size_t)t * 128 + tid] = s; }
        publish_count(980 + q);
    }
    constexpr int I_INAB = 16 * 56, I_OUTAB = 16 * 16, I_INC = 16 * 32, I_OUTC = 16 * 16, I_F1 = 16 * 64, I_F2 = 64 * 16, I_C1 = 32 * 2, I_C2 = 2 * 1;
    constexpr int NITEMS = 2 * (I_INAB + I_OUTAB + I_INC + I_OUTC) + 4 * (I_F1 + I_F2) + 4 * I_C1;
    for (int it = gw; it < NITEMS; it += NGW) {
        int r = it;
        if (r < 4 * I_F1) { const int l = r / I_F1; transpose_item(P.w_ffn1 + (size_t)l * D * FF, D, FF, (bf16*)(ws + WS_WF1) + (size_t)l * FF * D, P.norm_ffn + l * D, scr, r % I_F1, 64, lane); continue; } r -= 4 * I_F1;
        if (r < 4 * I_F2) { const int l = r / I_F2; transpose_item(P.w_ffn2 + (size_t)l * FF * D, FF, D, (bf16*)(ws + WS_WF2) + (size_t)l * D * FF, nullptr, scr, r % I_F2, 16, lane); continue; } r -= 4 * I_F2;
        if (r < 2 * I_INAB) { const int j = r / I_INAB; transpose_item(P.w_in_ab + (size_t)j * D * ABC, D, ABC, (bf16*)(ws + WS_WINAB) + (size_t)j * ABP * D, P.norm_mix + (2 * j) * D, scr, r % I_INAB, 56, lane); continue; } r -= 2 * I_INAB;
        if (r < 2 * I_OUTAB) { const int j = r / I_OUTAB; transpose_item(P.w_out_ab + (size_t)j * D * D, D, D, (bf16*)(ws + WS_WOUTAB) + (size_t)j * D * D, nullptr, scr, r % I_OUTAB, 16, lane); continue; } r -= 2 * I_OUTAB;
        if (r < 2 * I_INC) { const int j = r / I_INC; transpose_item(P.w_in_c + (size_t)j * D * 2048, D, 2048, (bf16*)(ws + WS_WINC) + (size_t)j * 2048 * D, P.norm_mix + (2 * j + 1) * D, scr, r % I_INC, 32, lane); continue; } r -= 2 * I_INC;
        if (r < 2 * I_OUTC) { const int j = r / I_OUTC; transpose_item(P.w_out_c + (size_t)j * D * D, D, D, (bf16*)(ws + WS_WOUTC) + (size_t)j * D * D, nullptr, scr, r % I_OUTC, 16, lane); continue; } r -= 2 * I_OUTC;
        { const int q = r / I_C1; transpose_item(P.cmp_w1 + (size_t)q * 2048 * 128, 2048, 128, (bf16*)(ws + WS_WC1) + (size_t)q * 128 * 2048, nullptr, scr, r % I_C1, 2, lane); }
    }
    for (int r = (G - 1 - bid) * 8 + wave; r < 4 * I_C2; r += NGW) { const int q = r / I_C2; transpose_item(P.cmp_w2 + (size_t)q * 128 * 64, 128, 64, (bf16*)(ws + WS_WC2) + (size_t)q * 64 * 128, nullptr, scr, r % I_C2, 1, lane); }
    {
        bf16* hb = (bf16*)(ws + WS_HB); float* ssq = (float*)(ws + WS_SSQ);
        for (int m = gw; m < MP; m += NGW) {
            const f32x4* xr = (const f32x4*)(P.x_prompt + (size_t)m * D) + lane; float s = 0.f; u64* o8 = (u64*)(hb + (size_t)m * D) + lane;
#pragma unroll
            for (int j = 0; j < 4; ++j) { const f32x4 v = xr[64 * j]; s += (v.x * v.x + v.y * v.y) + (v.z * v.z + v.w * v.w); o8[64 * j] = (u64)pk2(v.x, v.y) | ((u64)pk2(v.z, v.w) << 32); }
            s = wave_sum(s);
            if (lane < 16) ssq[(size_t)m * 16 + lane] = (lane == 0) ? s : 0.f;
        }
    }
    { float* hs = (float*)(ws + WS_SMP + SMP_HS); bf16* hsb = (bf16*)(ws + WS_SMP + SMP_HSB); for (int i = bid * 512 + tid; i < DB * D; i += G * 512) { const float v = P.x_sample[i]; hs[i] = v; hsb[i] = f2bf(v); } }
    { float* lbs = (float*)(ws + WS_SMALL);
      for (int i = bid * 512 + tid; i < 512; i += G * 512) { const float a = P.hgrn_lb[i], b = P.hgrn_lb[512 + i], mx = fmaxf(a, b), ea = __expf(a - mx), eb = __expf(b - mx); lbs[i] = 0.f; lbs[512 + i] = eb / (ea + eb); } }
    { bf16* tr = (bf16*)(ws + WS_TRIL);
      for (int i = bid * 512 + tid; i < 2 * 8 * 128 * 128; i += G * 512) { const int s = i & 127, t = (i >> 7) & 127; tr[i] = (s <= t) ? f2bf(P.w_s[i]) : (bf16)0; } }
    {
        float* cb = (float*)(ws + WS_SMALL + 4096);
        for (int q = G - 2 - bid; q >= 0 && q < 4; q += G) {
            wait_count(980 + q, 32u);
            if (tid < 128) { const float* cbp = (const float*)(ws + WS_SMALL + 8192) + (size_t)q * 32 * 128 + tid; float s = 0.f;
#pragma unroll 8
                for (int p = 0; p < 32; ++p) s += __builtin_nontemporal_load(cbp + p * 128);
                cb[q * 128 + tid] = s; }
        }
    }
}

#ifndef CU_VAR
#define CU_VAR 0
#endif
template <bool SAMPLE>
DI void compress_unit(unsigned char* lds, int j, int b, int ub, int ncmp, int L, int kv_lo, int kv_hi) {
    const Ptrs P = get_ptrs();
    const int tid = otid(), wave = tid >> 6, lane = tid & 63, r16 = lane & 15, quad = lane >> 4;
    unsigned char* rowsL = lds; bf16* hid = (bf16*)(lds + 135168);
    int* pg = (int*)(lds + 135168 + 17408);
    const bf16* w1t = (const bf16*)(P.ws + WS_WC1) + (size_t)j * 2 * 128 * 2048; const bf16* w2t = (const bf16*)(P.ws + WS_WC2) + (size_t)j * 2 * 64 * 128;
    const float* cb = (const float*)(P.ws + WS_SMALL + 4096) + j * 256;
    const int n0 = ub * 32, row0 = n0 * 16;
    if (SAMPLE) { if (tid < 5) { const int pi = (row0 >> 7) + tid; pg[tid] = (pi < NPAGES) ? P.page_table[b * NPAGES + pi] : 0; } __syncthreads(); }
    for (int kv = kv_lo; kv < kv_hi; ++kv) {
        for (int rp_ = 0; rp_ < ((CU_VAR == 1 && SAMPLE) ? 2 : 1); ++rp_) {
            asm volatile("" ::: "memory");
            f32x4 fa[17], fc[17]; u32x4 w[17];
#pragma unroll
            for (int u = 0; u < 17; ++u) { const int idx = u * 512 + tid, row = idx >> 4, ch = idx & 15, sr = row0 + row; const bool ok = (u < 16 || tid < 256) && (sr < L);
                if (SAMPLE) { const float* src = P.cache_cmp + (((size_t)j * NPOOL + (ok ? pg[row >> 7] : 0)) * 128 + (sr & 127)) * 256 + kv * 128 + ch * 8;
                    fa[u] = ok ? *(const f32x4*)src : (f32x4){0.f, 0.f, 0.f, 0.f}; fc[u] = ok ? *(const f32x4*)(src + 4) : (f32x4){0.f, 0.f, 0.f, 0.f};
                } else w[u] = ok ? *(const u32x4*)((const bf16*)(P.ws + WS_ZB) + ((size_t)b * SEQ + sr) * ABP + C_CMP + kv * 128 + ch * 8) : (u32x4){0u, 0u, 0u, 0u}; }
#pragma unroll
            for (int u = 0; u < 17; ++u) { const int idx = u * 512 + tid, row = idx >> 4, ch = idx & 15;
                if (SAMPLE) { w[u].x = pk2(fa[u].x, fa[u].y); w[u].y = pk2(fa[u].z, fa[u].w); w[u].z = pk2(fc[u].x, fc[u].y); w[u].w = pk2(fc[u].z, fc[u].w); }
                if (u < 16 || tid < 256) *(u32x4*)(rowsL + row * 256 + ((ch ^ ((row >> 4) & 15)) << 4)) = w[u]; }
        }
        __syncthreads();
        f32x4 acc[2][2];
        for (int rp_ = 0; rp_ < ((CU_VAR == 2 && SAMPLE) ? 2 : 1); ++rp_) {
        asm volatile("" ::: "memory");
#pragma unroll
        for (int g = 0; g < 2; ++g) { acc[g][0] = (f32x4){0.f, 0.f, 0.f, 0.f}; acc[g][1] = (f32x4){0.f, 0.f, 0.f, 0.f}; }
        const bf16* wp = w1t + ((size_t)kv * 128 + wave * 16 + r16) * 2048 + quad * 8;
        bf16x8 bq[3][8];
#pragma unroll
        for (int pb_ = 0; pb_ < 2; ++pb_)
#pragma unroll
            for (int u = 0; u < 8; ++u) bq[pb_][u] = *(const bf16x8*)(wp + (pb_ * 8 + u) * 32);
        bf16x8 af[2][4];
#define CU_LDA(KS, DST) { const int r_ = (KS) >> 1, c0_ = ((KS) & 1) * 4 + quad, sw_ = (r16 + (r_ >> 4)) & 15; \
            _Pragma("unroll") for (int bt = 0; bt < 2; ++bt) _Pragma("unroll") for (int g = 0; g < 2; ++g) \
                DST[bt * 2 + g] = *(const bf16x8*)(rowsL + (256 * bt + 16 * r16 + r_) * 256 + (((g * 8 + c0_) ^ sw_) << 4)); }
        CU_LDA(0, af[0]);
#pragma unroll
        for (int bt8 = 0; bt8 < 8; ++bt8) {
            if (bt8 + 2 < 8) {
#pragma unroll
                for (int u = 0; u < 8; ++u) bq[(bt8 + 2) % 3][u] = *(const bf16x8*)(wp + ((bt8 + 2) * 8 + u) * 32); }
#pragma unroll
            for (int u = 0; u < 8; ++u) { const int ks = bt8 * 8 + u;
                if (ks + 1 < 64) CU_LDA(ks + 1, af[(ks + 1) & 1]);
                __builtin_amdgcn_sched_barrier(0);
#pragma unroll
                for (int bt = 0; bt < 2; ++bt)
#pragma unroll
                    for (int g = 0; g < 2; ++g) acc[g][bt] = MFMA16(af[ks & 1][bt * 2 + g], bq[bt8 % 3][u], acc[g][bt]);
                __builtin_amdgcn_sched_barrier(0);
            }
        }
#undef CU_LDA
        asm volatile("" : "+v"(acc[0][0]), "+v"(acc[0][1]), "+v"(acc[1][0]), "+v"(acc[1][1]));
        }
#pragma unroll
        for (int g = 0; g < 2; ++g)
#pragma unroll
            for (int bt = 0; bt < 2; ++bt)
#pragma unroll
                for (int i = 0; i < 4; ++i) { const int h = wave * 16 + r16; hid[(g * 32 + bt * 16 + quad * 4 + i) * 136 + h] = f2bf(gelu_tanh(acc[g][bt][i] + cb[kv * 128 + h])); }
        __syncthreads();
        { const int rt = wave >> 1, g2 = rt >> 1; f32x4 a2[2] = {{0.f, 0.f, 0.f, 0.f}, {0.f, 0.f, 0.f, 0.f}};
#pragma unroll
          for (int ks = 0; ks < 4; ++ks) { const bf16x8 a = *(const bf16x8*)(hid + (rt * 16 + r16) * 136 + ks * 32 + quad * 8);
#pragma unroll
              for (int x = 0; x < 2; ++x) { const int ct = (wave & 1) * 2 + x; const bf16x8 bfr = *(const bf16x8*)(w2t + ((size_t)kv * 64 + ct * 16 + r16) * 128 + ks * 32 + quad * 8); a2[x] = MFMA16(a, bfr, a2[x]); } }
#pragma unroll
          for (int x = 0; x < 2; ++x)
#pragma unroll
              for (int i = 0; i < 4; ++i) { const int n = n0 + (rt & 1) * 16 + quad * 4 + i, d = ((wave & 1) * 2 + x) * 16 + r16;
                  if (n < ncmp) { if (SAMPLE) ((float*)(P.ws + WS_KCS))[(((size_t)b * 512 + n) * 4 + kv * 2 + g2) * 64 + d] = a2[x][i];
                                  else ((bf16*)(P.ws + WS_KCP))[(((size_t)b * 256 + n) * 4 + kv * 2 + g2) * 64 + d] = f2bf(a2[x][i]); } }
        }
        __syncthreads();
    }
}

DI void hgrn_p1_unit(unsigned char* lds, int j, int b, int c, int h) {
    const Ptrs P = get_ptrs();
    const int tid = otid(), wave = tid >> 6, lane = tid & 63, r16 = lane & 15, quad = lane >> 4;
    float* bl = (float*)lds; float* kk = bl + 8192; bf16* Vr = (bf16*)(lds + 65536); bf16* KD = Vr + 64 * 144; float* tot = (float*)(lds + 65536 + 2 * 64 * 144 * 2);
    const bf16* zb = (const bf16*)(P.ws + WS_ZB) + ((size_t)b * SEQ + c * 64) * ABP; const float* lb = (const float*)(P.ws + WS_SMALL) + j * 512 + h * 128;
    const int unit = (b * 4 + h) * 64 + c;
    u32x4 f8[2], v8[2];
#pragma unroll
    for (int u = 0; u < 2; ++u) { const int idx = tid + 512 * u, t = idx >> 4, ch = idx & 15; f8[u] = *(const u32x4*)(zb + (size_t)t * ABP + C_F + h * 128 + ch * 8); v8[u] = *(const u32x4*)(zb + (size_t)t * ABP + C_I + h * 128 + ch * 8); }
#pragma unroll
    for (int u = 0; u < 2; ++u) { const int idx = tid + 512 * u, t = idx >> 4, ch = idx & 15;
#pragma unroll
        for (int i = 0; i < 4; ++i) { const unsigned fw = f8[u][i]; const int d = ch * 8 + 2 * i;
            { const float lbv = lb[d], fg = lbv + (1.f - lbv) * sigmoidf_(bflo(fw)); bl[t * 128 + d] = __logf(fg); kk[t * 128 + d] = 1.f - fg; }
            { const float lbv = lb[d + 1], fg = lbv + (1.f - lbv) * sigmoidf_(bfhi(fw)); bl[t * 128 + d + 1] = __logf(fg); kk[t * 128 + d + 1] = 1.f - fg; } }
        *(u32x4*)(Vr + t * 144 + ch * 8) = v8[u]; }
    __syncthreads();
    { const int seg = tid >> 7, d = tid & 127; float run = 0.f;
#pragma unroll
      for (int i = 0; i < 16; ++i) { run += bl[(seg * 16 + i) * 128 + d]; bl[(seg * 16 + i) * 128 + d] = run; }
      tot[seg * 128 + d] = run; }
    __syncthreads();
    for (int idx = tid; idx < 4096; idx += 512) { const int t = idx >> 6, d = (idx & 63) * 2, seg = t >> 4; float e0 = 0.f, e1 = 0.f;
        e0 = tot[seg * 128 + d] - bl[t * 128 + d]; e1 = tot[seg * 128 + d + 1] - bl[t * 128 + d + 1];
        for (int s = seg + 1; s < 4; ++s) { e0 += tot[s * 128 + d]; e1 += tot[s * 128 + d + 1]; }
        *(unsigned*)(KD + t * 144 + d) = pk2(kk[t * 128 + d] * __expf(e0), kk[t * 128 + d + 1] * __expf(e1)); }
    if (tid < 128) ((float*)(P.ws + WS_DL))[(size_t)unit * 128 + tid] = __expf((tot[tid] + tot[128 + tid]) + (tot[256 + tid] + tot[384 + tid]));
    __syncthreads();
    f32x4 acc[8];
#pragma unroll
    for (int nt = 0; nt < 8; ++nt) acc[nt] = (f32x4){0.f, 0.f, 0.f, 0.f};
#pragma unroll
    for (int ks = 0; ks < 2; ++ks) { const bf16x8 a = tr_frag(Vr, 144, ks * 32, wave * 16, r16, quad);
#pragma unroll
        for (int nt = 0; nt < 8; ++nt) { const bf16x8 bb = tr_frag(KD, 144, ks * 32, nt * 16, r16, quad); acc[nt] = MFMA16(a, bb, acc[nt]); } }
    float* LT = (float*)(P.ws + WS_LT) + (size_t)unit * 16384;
#pragma unroll
    for (int nt = 0; nt < 8; ++nt)
#pragma unroll
        for (int i = 0; i < 4; ++i) LT[(wave * 16 + quad * 4 + i) * 128 + nt * 16 + r16] = acc[nt][i];
    __syncthreads();
}
DI void hgrn_scan_item(int j, int item) {
    const Ptrs P = get_ptrs();
    float* LT = (float*)(P.ws + WS_LT); const float* DL = (const float*)(P.ws + WS_DL);
    { const int gi = item * 512 + otid();
        const int bh = gi >> 12, q4 = gi & 4095, e = q4 >> 5, d4 = (q4 & 31) * 4;
        float* p = LT + (size_t)bh * 64 * 16384 + q4 * 4; const float* dp = DL + (size_t)bh * 64 * 128 + d4;
        f32x4 S = {0.f, 0.f, 0.f, 0.f};
        for (int c0 = 0; c0 < 64; c0 += 16) {
            f32x4 Lv[16], dv[16];
#pragma unroll
            for (int u = 0; u < 16; ++u) { Lv[u] = *(const f32x4*)(p + (size_t)(c0 + u) * 16384); dv[u] = *(const f32x4*)(dp + (c0 + u) * 128); }
#pragma unroll
            for (int u = 0; u < 16; ++u) { *(f32x4*)(p + (size_t)(c0 + u) * 16384) = S; S = dv[u] * S + Lv[u]; }
        }
        float* o = P.out + O_HG_P + ((size_t)j * 16 + bh) * 16384;
#pragma unroll
        for (int i = 0; i < 4; ++i) o[(d4 + i) * 128 + e] = S[i];
    }
    asm volatile("s_waitcnt vmcnt(0)" ::: "memory");
    __syncthreads();
    if (threadIdx.x == 0) { __builtin_amdgcn_fence(__ATOMIC_RELEASE, "agent"); asm volatile("s_waitcnt vmcnt(0)" ::: "memory");
        __hip_atomic_fetch_add((unsigned*)(P.ws + WS_CTL) + 4096 + 64 * (120 + j), 1u, __ATOMIC_RELAXED, __HIP_MEMORY_SCOPE_AGENT); }
}
DI void scan_wait(int j) {
    const Ptrs P = get_ptrs();
    if (threadIdx.x == 0) { unsigned* c = (unsigned*)(P.ws + WS_CTL) + 4096 + 64 * (120 + j); unsigned sp = 0;
        while (__hip_atomic_load(c, __ATOMIC_RELAXED, __HIP_MEMORY_SCOPE_AGENT) < 128u) { __builtin_amdgcn_s_sleep(2); if (++sp > (1u << 22)) break; }
        __builtin_amdgcn_fence(__ATOMIC_ACQUIRE, "agent"); asm volatile("s_waitcnt vmcnt(0)" ::: "memory"); }
    __syncthreads();
}
DI void hgrn_p3_unit(unsigned char* lds, int j, int b, int c, int h) {
    const Ptrs P = get_ptrs();
    const int tid = otid(), wave = tid >> 6, lane = tid & 63, r16 = lane & 15, quad = lane >> 4;
    float* bl = (float*)lds; unsigned char* Sb = lds;
    bf16* Qt = (bf16*)(lds + 32768); bf16* Qh = Qt + 64 * 136; bf16* Kt = Qh + 64 * 136; bf16* Vr = Kt + 160 * 136; bf16* att = Vr + 64 * 144; float* tot = (float*)(att + 64 * 72);
    float* obuf = (float*)Kt;
    const bf16* zb = (const bf16*)(P.ws + WS_ZB) + ((size_t)b * SEQ + c * 64) * ABP; const float* lb = (const float*)(P.ws + WS_SMALL) + j * 512 + h * 128;
    const int unit = (b * 4 + h) * 64 + c;
    u32x4 f8[2], v8[2], q8[2];
#pragma unroll
    for (int u = 0; u < 2; ++u) { const int idx = tid + 512 * u, t = idx >> 4, ch = idx & 15; const bf16* zr = zb + (size_t)t * ABP + h * 128 + ch * 8;
        f8[u] = *(const u32x4*)(zr + C_F); v8[u] = *(const u32x4*)(zr + C_I); q8[u] = *(const u32x4*)(zr + C_Q); }
#pragma unroll
    for (int u = 0; u < 2; ++u) { const int idx = tid + 512 * u, t = idx >> 4, ch = idx & 15;
#pragma unroll
        for (int i = 0; i < 4; ++i) { const unsigned fw = f8[u][i]; const int d = ch * 8 + 2 * i;
            { const float lbv = lb[d]; bl[t * 128 + d] = __logf(lbv + (1.f - lbv) * sigmoidf_(bflo(fw))); }
            { const float lbv = lb[d + 1]; bl[t * 128 + d + 1] = __logf(lbv + (1.f - lbv) * sigmoidf_(bfhi(fw))); } }
        *(u32x4*)(Vr + t * 144 + ch * 8) = v8[u]; }
    __syncthreads();
    { const int seg = tid >> 7, d = tid & 127; float run = 0.f;
#pragma unroll
      for (int i = 0; i < 16; ++i) { run += bl[(seg * 16 + i) * 128 + d]; bl[(seg * 16 + i) * 128 + d] = run; }
      tot[seg * 128 + d] = run; }
    __syncthreads();
#pragma unroll
    for (int u = 0; u < 2; ++u) { const int idx = tid + 512 * u, t = idx >> 4, ch = idx & 15, I = t >> 4;
        u32x4 wqt, wqh; float kv_[8], ex[8], pre[8];
#pragma unroll
        for (int i = 0; i < 8; ++i) { const int d = ch * 8 + i; float p = 0.f; for (int s = 0; s < I; ++s) p += tot[s * 128 + d]; pre[i] = p; }
#pragma unroll
        for (int i = 0; i < 4; ++i) {
            const int d = ch * 8 + 2 * i; const float q0 = siluf_(bflo(q8[u][i])), q1 = siluf_(bfhi(q8[u][i]));
            const float b0 = bl[t * 128 + d], b1 = bl[t * 128 + d + 1], e0 = __expf(b0), e1 = __expf(b1);
            wqt[i] = pk2(q0 * e0, q1 * e1); wqh[i] = pk2(q0 * e0 * __expf(pre[2 * i]), q1 * e1 * __expf(pre[2 * i + 1]));
            const float l0 = lb[d], l1 = lb[d + 1];
            kv_[2 * i] = 1.f - (l0 + (1.f - l0) * sigmoidf_(bflo(f8[u][i]))); kv_[2 * i + 1] = 1.f - (l1 + (1.f - l1) * sigmoidf_(bfhi(f8[u][i]))); ex[2 * i] = -b0; ex[2 * i + 1] = -b1;
        }
        *(u32x4*)(Qt + t * 136 + ch * 8) = wqt; *(u32x4*)(Qh + t * 136 + ch * 8) = wqh;
        for (int I2 = I; I2 < 4; ++I2) {
            u32x4 wk;
#pragma unroll
            for (int i = 0; i < 4; ++i) wk[i] = pk2(kv_[2 * i] * __expf(ex[2 * i]), kv_[2 * i + 1] * __expf(ex[2 * i + 1]));
            *(u32x4*)(Kt + (8 * I2 * (I2 + 1) + t) * 136 + ch * 8) = wk;
#pragma unroll
            for (int i = 0; i < 8; ++i) ex[i] += tot[I2 * 128 + ch * 8 + i];
        }
    }
    __syncthreads();
    { const float* St = (const float*)(P.ws + WS_LT) + (size_t)unit * 16384; f32x4 sa[4], sc4[4];
#pragma unroll
      for (int u = 0; u < 4; ++u) { const int idx = tid + 512 * u, e = idx >> 4, ch = idx & 15; sa[u] = *(const f32x4*)(St + e * 128 + ch * 8); sc4[u] = *(const f32x4*)(St + e * 128 + ch * 8 + 4); }
#pragma unroll
      for (int u = 0; u < 4; ++u) { const int idx = tid + 512 * u, e = idx >> 4, ch = idx & 15;
          u32x4 w; w.x = pk2(sa[u].x, sa[u].y); w.y = pk2(sa[u].z, sa[u].w); w.z = pk2(sc4[u].x, sc4[u].y); w.w = pk2(sc4[u].z, sc4[u].w); *(u32x4*)(Sb + e * 256 + ((ch ^ (e & 15)) << 4)) = w; } }
    { const int I = wave >> 1;
#pragma unroll
      for (int jj = 0; jj < 2; ++jj) { const int J = 2 * (wave & 1) + jj; f32x4 a4 = {0.f, 0.f, 0.f, 0.f};
          if (J <= I) {
#pragma unroll
              for (int ks = 0; ks < 4; ++ks) { const bf16x8 a = *(const bf16x8*)(Qt + (16 * I + r16) * 136 + ks * 32 + quad * 8);
                  const bf16x8 bb = *(const bf16x8*)(Kt + (8 * I * (I + 1) + 16 * J + r16) * 136 + ks * 32 + quad * 8); a4 = MFMA16(a, bb, a4); } }
#pragma unroll
          for (int i = 0; i < 4; ++i) { const int t = 16 * I + quad * 4 + i, s = 16 * J + r16; att[t * 72 + s] = (s <= t) ? f2bf(a4[i]) : (bf16)0; } } }
    __syncthreads();
    { const int I = wave >> 1; f32x4 acc[4];
#pragma unroll
      for (int x = 0; x < 4; ++x) acc[x] = (f32x4){0.f, 0.f, 0.f, 0.f};
#pragma unroll
      for (int ks = 0; ks < 4; ++ks) { const bf16x8 a = *(const bf16x8*)(Qh + (16 * I + r16) * 136 + ks * 32 + quad * 8);
#pragma unroll
          for (int x = 0; x < 4; ++x) { const int e = ((wave & 1) * 4 + x) * 16 + r16; const bf16x8 bb = *(const bf16x8*)(Sb + e * 256 + (((ks * 4 + quad) ^ (e & 15)) << 4)); acc[x] = MFMA16(a, bb, acc[x]); } }
      const int nks = (I >= 2) ? 2 : 1;
      for (int ks = 0; ks < nks; ++ks) { const bf16x8 a = *(const bf16x8*)(att + (16 * I + r16) * 72 + ks * 32 + quad * 8);
#pragma unroll
          for (int x = 0; x < 4; ++x) { const bf16x8 bb = tr_frag(Vr, 144, ks * 32, ((wave & 1) * 4 + x) * 16, r16, quad); acc[x] = MFMA16(a, bb, acc[x]); } }
#pragma unroll
      for (int x = 0; x < 4; ++x)
#pragma unroll
          for (int i = 0; i < 4; ++i) obuf[(16 * I + quad * 4 + i) * 132 + ((wave & 1) * 4 + x) * 16 + r16] = acc[x][i];
    }
    __syncthreads();
    { const float* hn = P.hgrn_norm + j * 128; bf16* oc = (bf16*)(P.ws + WS_OC) + ((size_t)b * SEQ + c * 64) * D + h * 128;
      const float h0 = hn[2 * lane], h1 = hn[2 * lane + 1]; unsigned gw[8];
#pragma unroll
      for (int i = 0; i < 8; ++i) gw[i] = *(const unsigned*)(zb + (size_t)(wave * 8 + i) * ABP + C_G + h * 128 + 2 * lane);
#pragma unroll
      for (int i = 0; i < 8; ++i) { const int t = wave * 8 + i; const f32x2 v = *(const f32x2*)(obuf + t * 132 + 2 * lane); const float ss = wave_sum(v.x * v.x + v.y * v.y), rs = rsqrtf(ss * (1.f / 128.f) + EPS);
          *(unsigned*)(oc + (size_t)t * D + 2 * lane) = pk2(v.x * rs * h0 * siluf_(bflo(gw[i])), v.y * rs * h1 * siluf_(bfhi(gw[i]))); } }
    __syncthreads();
}

DI float ex2(float x) { return __builtin_amdgcn_exp2f(x); }
DI void attn_fetch(u32x4& k8, u32x4& v8, const bf16* kbase, const bf16* vbase, size_t stride, int nvalid, int tid) {
    const int key = tid >> 3, ch = tid & 7; k8 = (u32x4){0u, 0u, 0u, 0u}; v8 = k8;
    if (key < nvalid) { k8 = *(const u32x4*)(kbase + (size_t)key * stride + ch * 8); v8 = *(const u32x4*)(vbase + (size_t)key * stride + ch * 8); }
}
DI void attn_put(bf16* Ks, const u32x4& k8, const u32x4& v8, int tid) {
    const int key = tid >> 3, ch = tid & 7; *(u32x4*)(Ks + key * 72 + ch * 8) = k8; *(u32x4*)(Ks + 64 * 72 + key * 72 + ch * 8) = v8;
}
DI void attn_qk(f32x4 (&s)[4][2], const bf16* Ks, const bf16x8 (&qf)[2][2], int r16, int quad, bool en0, bool en1) {
    if (en0 && en1) {
        bf16x8 kf[4][2];
#pragma unroll
        for (int kt = 0; kt < 4; ++kt)
#pragma unroll
            for (int ks = 0; ks < 2; ++ks) kf[kt][ks] = *(const bf16x8*)(Ks + (kt * 16 + r16) * 72 + ks * 32 + quad * 8);
#pragma unroll
        for (int kt = 0; kt < 4; ++kt) {
            s[kt][0] = MFMA16(kf[kt][0], qf[0][0], ((f32x4){0.f, 0.f, 0.f, 0.f})); s[kt][1] = MFMA16(kf[kt][0], qf[1][0], ((f32x4){0.f, 0.f, 0.f, 0.f}));
            s[kt][0] = MFMA16(kf[kt][1], qf[0][1], s[kt][0]); s[kt][1] = MFMA16(kf[kt][1], qf[1][1], s[kt][1]);
        }
    } else {
#pragma unroll
        for (int qt = 0; qt < 2; ++qt) {
            if (qt ? en1 : en0) {
#pragma unroll
                for (int kt = 0; kt < 4; ++kt) {
                    s[kt][qt] = (f32x4){0.f, 0.f, 0.f, 0.f};
#pragma unroll
                    for (int ks = 0; ks < 2; ++ks) { const bf16x8 a = *(const bf16x8*)(Ks + (kt * 16 + r16) * 72 + ks * 32 + quad * 8); s[kt][qt] = MFMA16(a, qf[qt][ks], s[kt][qt]); }
                }
            }
        }
    }
}
DI void attn_pv(f32x4 (&o)[4][2], const bf16* Vs, const bf16x8 (&pb)[2][2], int r16, int quad, bool en0, bool en1) {
    const bf16* vb = Vs + (quad * 4 + (r16 >> 2)) * 72 + (r16 & 3) * 4;
    if (en0 && en1) {
        s16x4 vf[4][2][2];
#pragma unroll
        for (int dt = 0; dt < 4; ++dt)
#pragma unroll
            for (int kk = 0; kk < 2; ++kk) { vf[dt][kk][0] = vtr(vb + (2 * kk) * 16 * 72 + dt * 16); vf[dt][kk][1] = vtr(vb + (2 * kk + 1) * 16 * 72 + dt * 16); }
#pragma unroll
        for (int dt = 0; dt < 4; ++dt)
#pragma unroll
            for (int kk = 0; kk < 2; ++kk) {
                const bf16x8 a = __builtin_shufflevector(vf[dt][kk][0], vf[dt][kk][1], 0, 1, 2, 3, 4, 5, 6, 7);
                o[dt][0] = MFMA16(a, pb[kk][0], o[dt][0]); o[dt][1] = MFMA16(a, pb[kk][1], o[dt][1]);
            }
    } else {
#pragma unroll
        for (int qt = 0; qt < 2; ++qt) {
            if (qt ? en1 : en0) {
#pragma unroll
                for (int dt = 0; dt < 4; ++dt)
#pragma unroll
                    for (int kk = 0; kk < 2; ++kk) {
                        const s16x4 lo = vtr(vb + (2 * kk) * 16 * 72 + dt * 16), hi = vtr(vb + (2 * kk + 1) * 16 * 72 + dt * 16);
                        const bf16x8 a = __builtin_shufflevector(lo, hi, 0, 1, 2, 3, 4, 5, 6, 7);
                        o[dt][qt] = MFMA16(a, pb[kk][qt], o[dt][qt]);
                    }
            }
        }
    }
}
template <int MODE>
DI void attn_branch(bf16* KV, const unsigned char* tl, int n, const bf16* zb, const bf16* kc, int g, int qi, int tid, int wave, int r16, int quad,
                    const bf16x8 (&qf)[2][2], const int (&tpos)[2], f32x4 (&o)[4][2], float (&m)[2], float (&l)[2], const u64 (&mk)[2], const u64 (&wq)[2], float* impA, float* impB) {
    const int q0 = qi * 64, rh = (r16 >> 2) & 3;
    u32x4 k8, v8;
#define AB_FETCH(i_) do { const int jb_ = tl[i_]; if (MODE <= 1) attn_fetch(k8, v8, kc + (size_t)jb_ * 64 * 256, kc + (size_t)jb_ * 64 * 256 + 128, 256, 255 - jb_ * 64, tid); \
        else { const int co_ = (MODE == 2) ? C_WIN : C_SEL; attn_fetch(k8, v8, zb + (size_t)jb_ * 64 * ABP + co_ + g * 64, zb + (size_t)jb_ * 64 * ABP + co_ + 128 + g * 64, ABP, 64, tid); } } while (0)
    if (n <= 0) return;
    AB_FETCH(0); attn_put(KV, k8, v8, tid);
    if (n > 1) AB_FETCH(1);
    __syncthreads();
    for (int i = 0; i < n; ++i) {
        bf16* Ks = KV + (i & 1) * (128 * 72);
        if (i + 1 < n) attn_put(KV + ((i + 1) & 1) * (128 * 72), k8, v8, tid);
        if (i + 2 < n) AB_FETCH(i + 2);
        const int jb = tl[i];
        bool en0 = true, en1 = true;
        if (MODE == 3) { en0 = (wq[0] >> jb) & 1ull; en1 = (wq[1] >> jb) & 1ull; }
        if (en0 || en1) {
            f32x4 s[4][2];
            attn_qk(s, Ks, qf, r16, quad, en0, en1);
            bool partial;
            if (MODE <= 1) partial = !(16 * (jb * 64 + 63) + 31 <= q0);
            else if (MODE == 2) partial = (jb == qi) || (jb + 8 == qi);
            else partial = (jb == qi);
            bf16x8 pb[2][2];
#pragma unroll
            for (int qt = 0; qt < 2; ++qt) {
                if (!(qt ? en1 : en0)) continue;
                if (partial) {
#pragma unroll
                    for (int kt = 0; kt < 4; ++kt)
#pragma unroll
                        for (int i2 = 0; i2 < 4; ++i2) { const int kp = jb * 64 + kt * 16 + quad * 4 + i2; bool ok;
                            if (MODE <= 1) ok = (16 * kp + 31 <= tpos[qt]); else if (MODE == 2) { const int dd = tpos[qt] - kp; ok = (dd >= 0 && dd < 512); } else ok = (kp <= tpos[qt]);
                            s[kt][qt][i2] = ok ? s[kt][qt][i2] : -INFINITY; }
                }
                if (MODE == 1) {
                    const float mu = m[qt], il = (l[qt] > 0.f) ? 1.f / l[qt] : 0.f; const int tokl = 8 * wave + 4 * qt + (r16 & 3);
#pragma unroll
                    for (int kt = 0; kt < 4; ++kt) {
#pragma unroll
                        for (int i2 = 0; i2 < 4; ++i2) s[kt][qt][i2] = ex2(s[kt][qt][i2] - mu) * il;
                        float v = (s[kt][qt][0] + s[kt][qt][1]) + (s[kt][qt][2] + s[kt][qt][3]), v3 = s[kt][qt][3];
                        v += __shfl_xor(v, 4); v += __shfl_xor(v, 8); v3 += __shfl_xor(v3, 4); v3 += __shfl_xor(v3, 8);
                        if (rh == 0) { const int c = jb * 16 + kt * 4 + quad; impA[tokl * 65 + c] = v; if (c + 1 < 64) impB[tokl * 65 + c + 1] = v3; }
                    }
                } else {
                    const bool lsel = (MODE == 3) ? ((mk[qt] >> jb) & 1ull) : true;
                    float mx = fmax3(s[0][qt][0], s[0][qt][1], s[0][qt][2]);
                    mx = fmax3(mx, s[0][qt][3], s[1][qt][0]); mx = fmax3(mx, s[1][qt][1], s[1][qt][2]); mx = fmax3(mx, s[1][qt][3], s[2][qt][0]); mx = fmax3(mx, s[2][qt][1], s[2][qt][2]);
                    mx = fmax3(mx, s[2][qt][3], s[3][qt][0]); mx = fmax3(mx, s[3][qt][1], s[3][qt][2]); mx = fmax2(mx, s[3][qt][3]);
                    if (MODE == 3) mx = lsel ? mx : -INFINITY;
                    mx = quad_max(mx);
                    const bool slow = (m[qt] != 0.f) || (mx > 8.f) || (l[qt] == 0.f && mx < -8.f && mx > -INFINITY);
                    f32x2 r2 = {0.f, 0.f};
                    if (__any(slow)) {
                        const bool fresh = (l[qt] == 0.f);
                        const float mn = (mx == -INFINITY) ? m[qt] : (fresh ? mx : fmax2(m[qt], mx)), alpha = fresh ? 1.f : ex2(m[qt] - mn);
#pragma unroll
                        for (int kt = 0; kt < 4; ++kt) {
#pragma unroll
                            for (int i2 = 0; i2 < 4; ++i2) s[kt][qt][i2] = ex2(s[kt][qt][i2] - mn);
                            r2 += (f32x2){s[kt][qt][0], s[kt][qt][1]}; r2 += (f32x2){s[kt][qt][2], s[kt][qt][3]}; }
                        float rs = r2.x + r2.y; if (MODE == 3) rs = lsel ? rs : 0.f;
                        l[qt] = l[qt] * alpha + quad_sum(rs); m[qt] = mn;
                        if (MODE != 0) {
#pragma unroll
                            for (int dt = 0; dt < 4; ++dt) o[dt][qt] = o[dt][qt] * alpha; }
                    } else {
#pragma unroll
                        for (int kt = 0; kt < 4; ++kt) {
#pragma unroll
                            for (int i2 = 0; i2 < 4; ++i2) s[kt][qt][i2] = ex2(s[kt][qt][i2]);
                            r2 += (f32x2){s[kt][qt][0], s[kt][qt][1]}; r2 += (f32x2){s[kt][qt][2], s[kt][qt][3]}; }
                        float rs = r2.x + r2.y; if (MODE == 3) rs = lsel ? rs : 0.f;
                        l[qt] += quad_sum(rs);
                    }
                }
                if (MODE != 0) {
#pragma unroll
                    for (int kk = 0; kk < 2; ++kk) { pb[kk][qt] = pack8(s[2 * kk][qt], s[2 * kk + 1][qt]);
                        if (MODE == 3) { const bool lsel = (mk[qt] >> jb) & 1ull; const bf16x8 z = {0, 0, 0, 0, 0, 0, 0, 0}; pb[kk][qt] = lsel ? pb[kk][qt] : z; } }
                }
            }
            if (MODE != 0) attn_pv(o, Ks + 64 * 72, pb, r16, quad, en0, en1);
        }
        __syncthreads();
    }
#undef AB_FETCH
}
DI void attn_unit(unsigned char* lds, int b, int g, int qi) {
    const Ptrs P = get_ptrs();
    const int tid = otid(), wave = tid >> 6, lane = tid & 63, r16 = lane & 15, quad = lane >> 4;
    bf16* Qs = (bf16*)lds; bf16* KV = (bf16*)(lds + 36864);
    float* impA = (float*)(lds + 73728); float* impB = impA + 64 * 65; u64* msk = (u64*)(lds + 107008);
    unsigned char* tl = lds + 107584;
    f32x4* obLo = (f32x4*)lds + tid; f32x4* obHi = (f32x4*)(lds + 73728) + tid;
    const bf16* zb = (const bf16*)(P.ws + WS_ZB) + (size_t)b * SEQ * ABP; const int q0 = qi * 64;
    const bf16* kc = (const bf16*)(P.ws + WS_KCP) + (size_t)b * 256 * 256 + g * 64;
    const int ntc = ((q0 + 32) >> 4) / 64 + 1;
    for (int idx = tid; idx < 2048; idx += 512) { const int tok = idx >> 5, r = (idx >> 3) & 3, ch = idx & 7; const float qs = 0.18033688011112042f;
        const u32x4 q8 = *(const u32x4*)(zb + (size_t)(q0 + tok) * ABP + C_QB + (g * 4 + r) * 64 + ch * 8); u32x4 w;
#pragma unroll
        for (int i = 0; i < 4; ++i) w[i] = pk2(bflo(q8[i]) * qs, bfhi(q8[i]) * qs);
        *(u32x4*)(Qs + (tok * 4 + r) * 72 + ch * 8) = w; }
    for (int idx = tid; idx < 2 * 64 * 65; idx += 512) impA[idx] = 0.f;
    if (tid < 4) tl[tid] = (unsigned char)tid;
    __syncthreads();
    bf16x8 qf[2][2]; int tpos[2]; float gate[2][3];
    const int rh = (r16 >> 2) & 3;
#pragma unroll
    for (int qt = 0; qt < 2; ++qt) { const int tokl = 8 * wave + 4 * qt + (r16 & 3); tpos[qt] = q0 + tokl;
#pragma unroll
        for (int ks = 0; ks < 2; ++ks) qf[qt][ks] = *(const bf16x8*)(Qs + (tokl * 4 + rh) * 72 + ks * 32 + quad * 8);
#pragma unroll
        for (int br = 0; br < 3; ++br) gate[qt][br] = sigmoidf_(bf2f(zb[(size_t)tpos[qt] * ABP + C_GATE + (g * 4 + rh) * 3 + br])); }
    f32x4 o[4][2]; float m[2], l[2]; u64 mk[2] = {0ull, 0ull}, wq[2] = {0ull, 0ull};
    m[0] = m[1] = 0.f; l[0] = l[1] = 0.f;
#pragma unroll
    for (int dt = 0; dt < 4; ++dt) { o[dt][0] = (f32x4){0.f, 0.f, 0.f, 0.f}; o[dt][1] = (f32x4){0.f, 0.f, 0.f, 0.f}; }
    attn_branch<0>(KV, tl, ntc, zb, kc, g, qi, tid, wave, r16, quad, qf, tpos, o, m, l, mk, wq, impA, impB);
    attn_branch<1>(KV, tl, ntc, zb, kc, g, qi, tid, wave, r16, quad, qf, tpos, o, m, l, mk, wq, impA, impB);
    {
        const int tok = tid >> 3, sub = tid & 7, cur = qi; u64 mkk;
        if (cur < 16) mkk = (1ull << (cur + 1)) - 1ull;
        else {
            float v[8]; unsigned taken = 0u;
#pragma unroll
            for (int i = 0; i < 8; ++i) { const int jb = sub + 8 * i; v[i] = (jb >= 1 && jb <= cur - 2) ? impA[tok * 65 + jb] + impB[tok * 65 + jb] : -INFINITY; }
            for (int it = 0; it < 13; ++it) {
                float bv = -INFINITY; int bi = 64;
#pragma unroll
                for (int i = 0; i < 8; ++i) { const bool c = !((taken >> i) & 1u) && v[i] > bv; bv = c ? v[i] : bv; bi = c ? sub + 8 * i : bi; }
#pragma unroll
                for (int o_ = 1; o_ < 8; o_ <<= 1) { const float ov = __shfl_xor(bv, o_); const int oi = __shfl_xor(bi, o_); const bool c = ov > bv || (ov == bv && oi < bi); bv = c ? ov : bv; bi = c ? oi : bi; }
                if ((bi & 7) == sub && bi < 64) taken |= 1u << (bi >> 3);
            }
            unsigned lo = 0u, hi = 0u;
#pragma unroll
            for (int i = 0; i < 8; ++i) if ((taken >> i) & 1u) { const int jb = sub + 8 * i; if (jb < 32) lo |= 1u << jb; else hi |= 1u << (jb - 32); }
#pragma unroll
            for (int o_ = 1; o_ < 8; o_ <<= 1) { lo |= __shfl_xor(lo, o_); hi |= __shfl_xor(hi, o_); }
            mkk = (((u64)hi << 32) | lo) | 1ull | (1ull << cur) | (1ull << (cur - 1));
        }
        if (sub == 0) msk[tok] = mkk;
        unsigned ul = (unsigned)mkk, uh = (unsigned)(mkk >> 32);
#pragma unroll
        for (int o_ = 8; o_ < 64; o_ <<= 1) { ul |= __shfl_xor(ul, o_); uh |= __shfl_xor(uh, o_); }
        if (lane == 0) msk[64 + wave] = ((u64)uh << 32) | ul;
    }
    __syncthreads();
#pragma unroll
    for (int qt = 0; qt < 2; ++qt) { obLo[(0 * 2 + qt) * 512] = o[0][qt] * gate[qt][0]; obLo[(1 * 2 + qt) * 512] = o[1][qt] * gate[qt][0]; }
    u64 uni = 0;
    {
#pragma unroll
      for (int t = 0; t < 8; ++t) uni |= msk[64 + t];
      uni &= (qi == 63) ? ~0ull : ((1ull << (qi + 1)) - 1ull);
#pragma unroll
      for (int qt = 0; qt < 2; ++qt) { mk[qt] = msk[8 * wave + 4 * qt + (r16 & 3)]; u64 w_ = 0; for (int t = 0; t < 4; ++t) w_ |= msk[8 * wave + 4 * qt + t];
          wq[qt] = ((u64)__builtin_amdgcn_readfirstlane((unsigned)(w_ >> 32)) << 32) | (unsigned)__builtin_amdgcn_readfirstlane((unsigned)w_); } }
    __syncthreads();
#pragma unroll
    for (int qt = 0; qt < 2; ++qt) { obHi[(0 * 2 + qt) * 512] = o[2][qt] * gate[qt][0]; obHi[(1 * 2 + qt) * 512] = o[3][qt] * gate[qt][0]; }
    const int jw0 = (qi > 8 ? qi - 8 : 0), nw = qi - jw0 + 1;
    if (tid < nw) tl[tid] = (unsigned char)(jw0 + tid);
    __syncthreads();
    m[0] = m[1] = 0.f; l[0] = l[1] = 0.f;
#pragma unroll
    for (int dt = 0; dt < 4; ++dt) { o[dt][0] = (f32x4){0.f, 0.f, 0.f, 0.f}; o[dt][1] = (f32x4){0.f, 0.f, 0.f, 0.f}; }
    attn_branch<2>(KV, tl, nw, zb, kc, g, qi, tid, wave, r16, quad, qf, tpos, o, m, l, mk, wq, impA, impB);
#pragma unroll
    for (int qt = 0; qt < 2; ++qt) { const float sc = gate[qt][2] / fmaxf(l[qt], 1e-30f);
        obLo[(0 * 2 + qt) * 512] += o[0][qt] * sc; obLo[(1 * 2 + qt) * 512] += o[1][qt] * sc; obHi[(0 * 2 + qt) * 512] += o[2][qt] * sc; obHi[(1 * 2 + qt) * 512] += o[3][qt] * sc; }
    if (tid < 64) ((u64*)(P.ws + WS_MSK))[(size_t)(b * 2 + g) * SEQ + q0 + tid] = msk[tid];
    { bf16* oc = (bf16*)(P.ws + WS_OC) + (size_t)b * SEQ * D;
#pragma unroll
      for (int qt = 0; qt < 2; ++qt)
#pragma unroll
          for (int dt = 0; dt < 4; ++dt) { const f32x4 acc = (dt < 2) ? obLo[(dt * 2 + qt) * 512] : obHi[((dt - 2) * 2 + qt) * 512];
              u32x2 w; w.x = pk2(acc[0], acc[1]); w.y = pk2(acc[2], acc[3]);
              *(u32x2*)(oc + (size_t)tpos[qt] * D + 512 + (g * 4 + rh) * 64 + dt * 16 + quad * 4) = w; } }
    __syncthreads();
}

namespace selb {
typedef unsigned short bf16;
using bf16x8=__attribute__((ext_vector_type(8)))short;
using s16x4=__attribute__((ext_vector_type(4)))short;
using f32x16=__attribute__((ext_vector_type(16)))float;
using u32x4=__attribute__((ext_vector_type(4)))unsigned;
constexpr int D=64,PQ=3584,PO=1024;
constexpr int NW=8,QBLK=32,QB=QBLK*NW,KVBLK=64;
__device__ __forceinline__ int crow(int r,int hi){return (r&3)+8*(r>>2)+4*hi;}
#define SBAR() __builtin_amdgcn_sched_barrier(0)
__device__ __forceinline__ void cmask(f32x16&p0,f32x16&p1,int jb,int qrel,int hi){
  const float NEG=-INFINITY; int kb=64*jb+4*hi;
  #pragma unroll
  for(int r=0;r<16;++r){int kv=kb+(r&3)+8*(r>>2); if(kv>qrel)p0[r]=NEG; if(kv+32>qrel)p1[r]=NEG;}
}

constexpr int NSLOT=3, SLOTB=8192;
constexpr int LDS_K=0, LDS_V=NSLOT*SLOTB, LDS_WS=2*NSLOT*SLOTB, LDS_OST=LDS_WS+NW*64*4, LDS_BYTES=LDS_OST+NW*4096;
constexpr float C2=0.125f*1.4426950408889634f;
__device__ __forceinline__ void glds16(const void*gsrc,unsigned lds_dst){unsigned keep;
  asm volatile("s_mov_b32 %0, m0\n\ts_mov_b32 m0, %2\n\ts_nop 0\n\tglobal_load_lds_dwordx4 %1, off\n\ts_mov_b32 m0, %0":"=&s"(keep):"v"(gsrc),"s"(lds_dst):"memory");}
__device__ __forceinline__ float max3f(float a,float b,float c){float r;asm("v_max3_f32 %0, %1, %2, %3":"=v"(r):"v"(a),"v"(b),"v"(c));return r;}
__device__ __forceinline__ float max2f(float a,float b){float r;asm("v_max_f32_e32 %0, %1, %2":"=v"(r):"v"(a),"v"(b));return r;}
__device__ __forceinline__ float fadd_s(float a,float b){float r;asm("v_add_f32_e32 %0, %1, %2":"=v"(r):"v"(a),"v"(b));return r;}
__device__ __forceinline__ float fsub_s(float a,float b){float r;asm("v_sub_f32_e32 %0, %1, %2":"=v"(r):"v"(a),"v"(b));return r;}
typedef float f32x2_t __attribute__((ext_vector_type(2))); typedef __bf16 bf16x2_t __attribute__((ext_vector_type(2)));
__device__ __forceinline__ unsigned cvtpk_s(float lo,float hi){f32x2_t v={lo,hi};bf16x2_t b=__builtin_convertvector(v,bf16x2_t);return __builtin_bit_cast(unsigned,b);}
#define WAIT_BAR(N) asm volatile("s_waitcnt vmcnt(" #N ") lgkmcnt(0)\n\ts_barrier":::"memory")

__device__ __forceinline__ void qkt(f32x16&p0,f32x16&p1,const char*Kslot,const bf16x8*qr,const f32x16&negm,int r32,int hi){
  const char*kb=Kslot+hi*1024+r32*16;
  #pragma unroll
  for(int d0=0;d0<4;++d0){
    const bf16x8 b0=*reinterpret_cast<const bf16x8*>(kb+d0*2048);
    const bf16x8 b1=*reinterpret_cast<const bf16x8*>(kb+d0*2048+512);
    if(d0==0){p0=__builtin_amdgcn_mfma_f32_32x32x16_bf16(b0,qr[0],negm,0,0,0);p1=__builtin_amdgcn_mfma_f32_32x32x16_bf16(b1,qr[0],negm,0,0,0);}
    else{p0=__builtin_amdgcn_mfma_f32_32x32x16_bf16(b0,qr[d0],p0,0,0,0);p1=__builtin_amdgcn_mfma_f32_32x32x16_bf16(b1,qr[d0],p1,0,0,0);}}
}
typedef __attribute__((address_space(3))) const char* lds_cptr;
typedef short v4i16_t __attribute__((ext_vector_type(4)));
__device__ __forceinline__ void kload8(bf16x8*kf,lds_cptr kp){
  kf[0]=*(const __attribute__((address_space(3))) bf16x8*)(kp);      kf[1]=*(const __attribute__((address_space(3))) bf16x8*)(kp+512);
  kf[2]=*(const __attribute__((address_space(3))) bf16x8*)(kp+2048); kf[3]=*(const __attribute__((address_space(3))) bf16x8*)(kp+2560);
  kf[4]=*(const __attribute__((address_space(3))) bf16x8*)(kp+4096); kf[5]=*(const __attribute__((address_space(3))) bf16x8*)(kp+4608);
  kf[6]=*(const __attribute__((address_space(3))) bf16x8*)(kp+6144); kf[7]=*(const __attribute__((address_space(3))) bf16x8*)(kp+6656);
}
__device__ __forceinline__ void kload2(bf16x8*kf,lds_cptr kp,int j){ kf[2*j]=*(const __attribute__((address_space(3))) bf16x8*)(kp+j*2048); kf[2*j+1]=*(const __attribute__((address_space(3))) bf16x8*)(kp+j*2048+512); }
__device__ __forceinline__ s16x4 vtr(lds_cptr p){ return __builtin_bit_cast(s16x4,__builtin_amdgcn_ds_read_tr16_b64_v4i16((__attribute__((address_space(3))) v4i16_t*)p)); }
__device__ __forceinline__ float rowmax(const f32x16&p0,const f32x16&p1){
  float a=max3f(p0[0],p0[1],p1[0]),b=max3f(p0[2],p0[3],p1[1]);a=max3f(a,p1[2],p1[3]);
  #pragma unroll
  for(int r=4;r<16;r+=4){a=max3f(a,p0[r],p0[r+1]);b=max3f(b,p0[r+2],p0[r+3]);a=max3f(a,p1[r],p1[r+1]);b=max3f(b,p1[r+2],p1[r+3]);}
  const float m=max2f(a,b);
  auto rr=__builtin_amdgcn_permlane32_swap(__float_as_uint(m),__float_as_uint(m),false,false);
  return max2f(__uint_as_float(rr[0]),__uint_as_float(rr[1]));
}
__device__ __forceinline__ void pv(f32x16*o,int vb,bf16x8 pa0,bf16x8 pa1,bf16x8 pa2,bf16x8 pa3){
  #pragma unroll
  for(int d0=0;d0<2;++d0){s16x4 lo[4],hi[4];
    #pragma unroll
    for(int ks=0;ks<4;++ks){
      asm volatile("ds_read_b64_tr_b16 %0,%1 offset:%c2":"=&v"(lo[ks]):"v"(vb),"i"(d0*4096+ks*1024):"memory");
      asm volatile("ds_read_b64_tr_b16 %0,%1 offset:%c2":"=&v"(hi[ks]):"v"(vb),"i"(d0*4096+ks*1024+512):"memory");}
    asm volatile("s_waitcnt lgkmcnt(0)":::"memory");SBAR();
    #define PK(k) (bf16x8){lo[k][0],lo[k][1],lo[k][2],lo[k][3],hi[k][0],hi[k][1],hi[k][2],hi[k][3]}
    o[d0]=__builtin_amdgcn_mfma_f32_32x32x16_bf16(pa0,PK(0),o[d0],0,0,0);
    o[d0]=__builtin_amdgcn_mfma_f32_32x32x16_bf16(pa1,PK(1),o[d0],0,0,0);
    o[d0]=__builtin_amdgcn_mfma_f32_32x32x16_bf16(pa2,PK(2),o[d0],0,0,0);
    o[d0]=__builtin_amdgcn_mfma_f32_32x32x16_bf16(pa3,PK(3),o[d0],0,0,0);
    #undef PK
  }
}

template<int THRL> __device__ __forceinline__ void sel_unit(int qb,const bf16*Qh,const bf16*__restrict__ Kh,const bf16*__restrict__ Vh,bf16*Oh,const unsigned long long*mrow,const bf16*gz,char*shm){
  const int tid=otid(),lane=tid&63,r32=lane&31,hi=lane>>5; const int wid=__builtin_amdgcn_readfirstlane(tid>>6);
  const int q0=qb*QB;
  const bf16*Qw=Qh+(long)(q0+wid*QBLK)*PQ;
  const unsigned lds0=(unsigned)(uintptr_t)shm;
  float*wsf=(float*)(shm+LDS_WS)+wid*64;
  const bf16*ksrc=Kh+(long)lane*PQ+wid*8;
  const bf16*vsrc=Vh+(long)(16*(wid&3)+(lane>>2))*PQ+(wid>>2)*32+(lane&3)*8;
  const unsigned kdst=lds0+LDS_K+wid*1024, vdst=lds0+LDS_V+wid*1024;
  #define DMA_K(t,slot) glds16(ksrc+(long)(t)*KVBLK*PQ,(unsigned)__builtin_amdgcn_readfirstlane(kdst+(slot)))
  #define DMA_V(t,slot) glds16(vsrc+(long)(t)*KVBLK*PQ,(unsigned)__builtin_amdgcn_readfirstlane(vdst+(slot)))
  const int vb0=(int)(lds0+LDS_V)+((lane>>4)&1)*32+(lane&3)*8+(4*hi+((lane&15)>>2))*64;
  const char*Kbase=shm+LDS_K; bf16x8 kf[8];
  const lds_cptr shm3=(lds_cptr)shm; const lds_cptr kp0=shm3+LDS_K+hi*1024+r32*16; const lds_cptr vp0=shm3+LDS_V+((lane>>4)&1)*32+(lane&3)*8+(4*hi+((lane&15)>>2))*64;
  const int NT=(q0+QB)/KVBLK;
  DMA_K(0,0);DMA_V(0,0);DMA_K(1,SLOTB);
  bf16x8 qr[4];
  #pragma unroll
  for(int d0=0;d0<4;++d0){ const u32x4 q8=*reinterpret_cast<const u32x4*>(&Qw[(long)r32*PQ+d0*16+hi*8]); u32x4 w;
    _Pragma("unroll") for(int i=0;i<4;++i) w[i]=cvtpk_s(__uint_as_float(q8[i]<<16)*C2,__uint_as_float(q8[i]&0xffff0000u)*C2);
    qr[d0]=__builtin_bit_cast(bf16x8,w); }
  const unsigned long long mkl=mrow[q0+wid*QBLK+r32];
  float mhat=0.f,l_reg=0.f;f32x16 o[2];o[0]=f32x16{};o[1]=f32x16{};f32x16 csel=f32x16{};
  const int qrel=wid*QBLK+r32;
  #define CMASK(P0,P1,t) do{int jb_=(t)-(NT-4); if(jb_>=0)cmask(P0,P1,jb_,qrel,hi);}while(0)
  bool resc=false;
  #define START(P0,P1) do{ const float rm=rowmax(P0,P1); resc=false; \
    { const float dl=rm; mhat=fadd_s(mhat,dl); \
      _Pragma("unroll") for(int r=0;r<16;++r){P0[r]=fsub_s(P0[r],dl);P1[r]=fsub_s(P1[r],dl);} \
      } \
    _Pragma("unroll") for(int r=0;r<16;++r)P0[r]=__builtin_amdgcn_exp2f(P0[r]); }while(0)
  #define RESC() do{ if(resc){ asm volatile("s_waitcnt lgkmcnt(0)":::"memory"); \
      _Pragma("unroll") for(int d_=0;d_<2;++d_) _Pragma("unroll") for(int r=0;r<16;++r)o[d_][r]*=wsf[crow(r,hi)]; } }while(0)
  f32x16 pA0,pA1,pB0,pB1;
  int sl_prev=0,sl_cur=0,sl_next=SLOTB;
  #define ROT() do{sl_prev=sl_cur;sl_cur=sl_next;sl_next=(sl_next==(NSLOT-1)*SLOTB)?0:sl_next+SLOTB;}while(0)
  DMA_K(2,2*SLOTB);
  WAIT_BAR(3);
  qkt(pA0,pA1,Kbase,qr,csel,r32,hi);asm volatile("s_nop 15\n\ts_nop 7":"+v"(pA0),"+v"(pA1));CMASK(pA0,pA1,0);
  START(pA0,pA1);
  _Pragma("unroll") for(int r=0;r<16;++r)pA1[r]=__builtin_amdgcn_exp2f(pA1[r]);
  WAIT_BAR(0);
  DMA_K(3,0);DMA_V(1,SLOTB);
  ROT();
  kload8(kf,kp0+sl_cur);
  WAIT_BAR(2);
  s16x4 vlo[8],vhi[8]; u32x4 pw0,pw1,pw2,pw3;
  #define PKW(P,B) cvtpk_s(P[B],P[B+1])
  #define PAF(k) __builtin_bit_cast(bf16x8,pw##k)
  #define VFR(i) (bf16x8){vlo[i][0],vlo[i][1],vlo[i][2],vlo[i][3],vhi[i][0],vhi[i][1],vhi[i][2],vhi[i][3]}
  #define PIN(x) asm volatile("":"+v"(x))
  #define MX3(a,b,c) __builtin_fmaxf(__builtin_fmaxf((a),(b)),(c))
  #define GAPA(MF,A0,A1,A2,A3,W0,W1,PW) do{ MF; sacc+=A0; sacc+=A1; sacc+=A2; sacc+=A3; PIN(sacc); W0; W1; PIN(PW); SBAR(); }while(0)
  #define EX(v) __builtin_amdgcn_exp2f(v)
  #define GAPB(MF,X,B) do{ MF; X[B]=EX(X[B]); X[B+1]=EX(X[B+1]); X[B+2]=EX(X[B+2]); X[B+3]=EX(X[B+3]); PIN(X); SBAR(); }while(0)
  #define VRD(i) do{ vlo[i]=vtr(vp_+(((i)>>2)*4096+((i)&3)*1024)); vhi[i]=vtr(vp_+(((i)>>2)*4096+((i)&3)*1024+512)); }while(0)
  #define KRD(G,j) do{ if(G){ kload2(kf,kp0+sl_next,j); SBAR(); } }while(0)
  #define STEP(C0,C1,P0,P1,t,GK,GV,GL) do{ SBAR(); \
    { const float cs_=((mkl>>(t))&1ull)?-mhat:-INFINITY; _Pragma("unroll") for(int r=0;r<16;++r)csel[r]=cs_; asm volatile("":"+v"(csel)); } SBAR(); \
    const lds_cptr vp_=vp0+sl_prev; \
    VRD(0); SBAR(); float sacc=(P0[0]+P0[1]); \
    GAPA(C0=__builtin_amdgcn_mfma_f32_32x32x16_bf16(kf[0],qr[0],csel,0,0,0), P0[2],P0[3],P0[4],P0[5],     pw0[0]=PKW(P0,0), pw0[1]=PKW(P0,2), pw0); \
    VRD(4); SBAR(); GAPA(C1=__builtin_amdgcn_mfma_f32_32x32x16_bf16(kf[1],qr[0],csel,0,0,0), P0[6],P0[7],P0[8],P0[9],     pw0[2]=PKW(P0,4), pw0[3]=PKW(P0,6), pw0); \
    VRD(1); SBAR(); GAPA(C0=__builtin_amdgcn_mfma_f32_32x32x16_bf16(kf[2],qr[1],C0,0,0,0),   P0[10],P0[11],P0[12],P0[13], pw1[0]=PKW(P0,8), pw1[1]=PKW(P0,10), pw1); \
    VRD(5); SBAR(); GAPA(C1=__builtin_amdgcn_mfma_f32_32x32x16_bf16(kf[3],qr[1],C1,0,0,0),   P0[14],P0[15],P1[0],P1[1],   pw1[2]=PKW(P0,12),pw1[3]=PKW(P0,14), pw1); \
    VRD(2); SBAR(); GAPA(C0=__builtin_amdgcn_mfma_f32_32x32x16_bf16(kf[4],qr[2],C0,0,0,0),   P1[2],P1[3],P1[4],P1[5],     pw2[0]=PKW(P1,0), pw2[1]=PKW(P1,2), pw2); \
    VRD(6); SBAR(); GAPA(C1=__builtin_amdgcn_mfma_f32_32x32x16_bf16(kf[5],qr[2],C1,0,0,0),   P1[6],P1[7],P1[8],P1[9],     pw2[2]=PKW(P1,4), pw2[3]=PKW(P1,6), pw2); \
    VRD(3); SBAR(); GAPA(C0=__builtin_amdgcn_mfma_f32_32x32x16_bf16(kf[6],qr[3],C0,0,0,0),   P1[10],P1[11],P1[12],P1[13], pw3[0]=PKW(P1,8), pw3[1]=PKW(P1,10), pw3); \
    VRD(7); SBAR(); GAPA(C1=__builtin_amdgcn_mfma_f32_32x32x16_bf16(kf[7],qr[3],C1,0,0,0),   P1[14],P1[15],0.f,0.f,       pw3[2]=PKW(P1,12),pw3[3]=PKW(P1,14), pw3); \
    l_reg+=sacc; \
    if(GK){DMA_K((t)+3,sl_cur);} if(GV){DMA_V((t)+1,sl_next);} \
    CMASK(C0,C1,t); \
    { float a=MX3(C0[0],C0[1],C1[0]),b=MX3(C0[2],C0[3],C1[1]); a=MX3(a,C1[2],C1[3]); \
      _Pragma("unroll") for(int r=4;r<16;r+=4){a=MX3(a,C0[r],C0[r+1]);b=MX3(b,C0[r+2],C0[r+3]);a=MX3(a,C1[r],C1[r+1]);b=MX3(b,C1[r+2],C1[r+3]);} \
      float rm=__builtin_fmaxf(a,b); { auto rr=__builtin_amdgcn_permlane32_swap(__float_as_uint(rm),__float_as_uint(rm),false,false); rm=__builtin_fmaxf(__uint_as_float(rr[0]),__uint_as_float(rr[1])); } \
      resc=false; \
      if(__builtin_expect(__any(rm>(float)THRL),0)){ const float dl=__builtin_fmaxf(rm,0.f); mhat+=dl; \
        _Pragma("unroll") for(int r=0;r<16;++r){C0[r]-=dl;C1[r]-=dl;} \
        const float f=__builtin_amdgcn_exp2f(-dl); l_reg*=f; if(hi==0)wsf[r32]=f; resc=true; } } \
    SBAR(); \
    GAPB(o[0]=__builtin_amdgcn_mfma_f32_32x32x16_bf16(PAF(0),VFR(0),o[0],0,0,0), C0,0); \
    GAPB(o[1]=__builtin_amdgcn_mfma_f32_32x32x16_bf16(PAF(0),VFR(4),o[1],0,0,0), C0,4); \
    KRD(GL,0); GAPB(o[0]=__builtin_amdgcn_mfma_f32_32x32x16_bf16(PAF(1),VFR(1),o[0],0,0,0), C0,8); \
    KRD(GL,1); GAPB(o[1]=__builtin_amdgcn_mfma_f32_32x32x16_bf16(PAF(1),VFR(5),o[1],0,0,0), C0,12); \
    KRD(GL,2); GAPB(o[0]=__builtin_amdgcn_mfma_f32_32x32x16_bf16(PAF(2),VFR(2),o[0],0,0,0), C1,0); \
    KRD(GL,3); GAPB(o[1]=__builtin_amdgcn_mfma_f32_32x32x16_bf16(PAF(2),VFR(6),o[1],0,0,0), C1,4); \
    GAPB(o[0]=__builtin_amdgcn_mfma_f32_32x32x16_bf16(PAF(3),VFR(3),o[0],0,0,0), C1,8); \
    GAPB(o[1]=__builtin_amdgcn_mfma_f32_32x32x16_bf16(PAF(3),VFR(7),o[1],0,0,0), C1,12); \
    }while(0)
  int t=1;
  #undef CMASK
  #define CMASK(P0,P1,t) do{}while(0)
  for(;t+5<NT;t+=2){
    STEP(pB0,pB1,pA0,pA1,t,true,true,true);     WAIT_BAR(2); RESC(); ROT();
    STEP(pA0,pA1,pB0,pB1,t+1,true,true,true);   WAIT_BAR(2); RESC(); ROT();
  }
  #undef CMASK
  #define CMASK(P0,P1,t) do{int jb_=(t)-(NT-4); if(jb_>=0)cmask(P0,P1,jb_,qrel,hi);}while(0)
  #define ENDW(tt) do{ if((tt)+3<NT){WAIT_BAR(2);} else if((tt)+2<NT){WAIT_BAR(1);} else {WAIT_BAR(0);} }while(0)
  for(;t+1<NT;t+=2){
    STEP(pB0,pB1,pA0,pA1,t,(t+3<NT),(t+1<NT),(t+1<NT));       ENDW(t);   RESC(); ROT();
    STEP(pA0,pA1,pB0,pB1,t+1,(t+4<NT),(t+2<NT),(t+2<NT));     ENDW(t+1); RESC(); ROT();
  }
  STEP(pB0,pB1,pA0,pA1,NT-1,false,false,false); RESC();
  { float sacc=pB0[0]+pB0[1]; _Pragma("unroll") for(int r=2;r<16;++r)sacc+=pB0[r]; _Pragma("unroll") for(int r=0;r<16;++r)sacc+=pB1[r]; l_reg+=sacc;
    pw0=(u32x4){PKW(pB0,0),PKW(pB0,2),PKW(pB0,4),PKW(pB0,6)};pw1=(u32x4){PKW(pB0,8),PKW(pB0,10),PKW(pB0,12),PKW(pB0,14)};pw2=(u32x4){PKW(pB1,0),PKW(pB1,2),PKW(pB1,4),PKW(pB1,6)};pw3=(u32x4){PKW(pB1,8),PKW(pB1,10),PKW(pB1,12),PKW(pB1,14)};
    SBAR(); pv(o,vb0+sl_cur,PAF(0),PAF(1),PAF(2),PAF(3)); }
  #undef PKW
  #undef PAF
  #undef VFR
  #undef PIN
  #undef MX3
  #undef GAPA
  #undef GAPB
  #undef EX
  #undef VRD
  #undef KRD
  #undef STEP
  #undef ENDW
  {auto rr=__builtin_amdgcn_permlane32_swap(__float_as_uint(l_reg),__float_as_uint(l_reg),false,false);l_reg=__uint_as_float(rr[0])+__uint_as_float(rr[1]);}
  { const float gl=__uint_as_float((unsigned)gz[(long)(q0+wid*QBLK+r32)*PQ]<<16); const float gate=__builtin_amdgcn_rcpf(1.f+__expf(-gl));
    if(hi==0)wsf[32+r32]=gate*__builtin_amdgcn_rcpf(fmaxf(l_reg,1e-30f)); }
  asm volatile("s_waitcnt lgkmcnt(0)":::"memory");
  float rli[16];
  #pragma unroll
  for(int r=0;r<16;++r)rli[r]=wsf[32+crow(r,hi)];
  bf16*Ow=Oh+(long)(q0+wid*QBLK)*PO;
  { bf16*stg=(bf16*)(shm+LDS_OST)+wid*2048;
    #pragma unroll
    for(int r=0;r<16;++r){const int orow=crow(r,hi);
      #pragma unroll
      for(int d0=0;d0<2;++d0)stg[orow*64+d0*32+r32]=(bf16)(cvtpk_s(o[d0][r]*rli[r],0.f)&0xffffu);}
    asm volatile("s_waitcnt lgkmcnt(0)":::"memory");
    #pragma unroll
    for(int i=0;i<4;++i){const int row=i*8+(lane>>3),ch=lane&7; const u32x4 v=*(const u32x4*)(stg+row*64+ch*8); bf16*dst=Ow+(long)row*PO+ch*8; const u32x4 p=*(const u32x4*)dst; u32x4 w;
      _Pragma("unroll") for(int e=0;e<4;++e) w[e]=cvtpk_s(__uint_as_float(v[e]<<16)+__uint_as_float(p[e]<<16),__uint_as_float(v[e]&0xffff0000u)+__uint_as_float(p[e]&0xffff0000u));
      *(u32x4*)dst=w;} }
  asm volatile("s_waitcnt lgkmcnt(0)\n\ts_barrier":::"memory");
  #undef DMA_K
  #undef DMA_V
  #undef CMASK
  #undef START
  #undef RESC
  #undef ROT
}
constexpr int SEL_LDS_BYTES=LDS_BYTES;
#undef SBAR
#undef WAIT_BAR
}

DI void sel_attn_unit(unsigned char* lds, int b, int hq, int qb) {
    const Ptrs P = get_ptrs();
    const int g = hq >> 2;
    const bf16* zb = (const bf16*)(P.ws + WS_ZB) + (size_t)b * SEQ * ABP;
    selb::sel_unit<8>(qb, zb + C_QB + hq * 64, zb + C_SEL + g * 64, zb + C_SEL + 128 + g * 64, (bf16*)(P.ws + WS_OC) + (size_t)b * SEQ * D + 512 + hq * 64,
                      (const u64*)(P.ws + WS_MSK) + (size_t)(b * 2 + g) * SEQ, zb + C_GATE + hq * 3 + 1, (char*)lds);
}

DI void mix_unit(unsigned char* lds, int jc, int chunk, int gq) {
    const Ptrs P = get_ptrs();
    const int tid = otid(), wave = tid >> 6, lane = tid & 63, r16 = lane & 15, quad = lane >> 4;
    bf16* Vr = (bf16*)lds; float* mu = (float*)(lds + 128 * 144 * 2); float* rsd = mu + 128;
    const size_t tok0 = (size_t)chunk * 128;
    const bf16* ub = (const bf16*)(P.ws + WS_ZB); const bf16* vb = ub + (size_t)MP * D; const float* vstat = (const float*)(P.ws + WS_VSTAT);
    u32x4 v8[4];
#pragma unroll
    for (int u = 0; u < 4; ++u) { const int idx = tid + 512 * u, s = idx >> 4, ch = idx & 15; v8[u] = *(const u32x4*)(vb + (tok0 + s) * D + gq * 128 + ch * 8); }
    const int t = wave * 16 + r16; u32x2 u4[8];
#pragma unroll
    for (int mt = 0; mt < 8; ++mt) u4[mt] = *(const u32x2*)(ub + (tok0 + t) * D + gq * 128 + mt * 16 + quad * 4);
    if (tid < 128) { const f32x4* p = (const f32x4*)(vstat + (tok0 + tid) * 32); float s1 = 0.f, s2 = 0.f;
#pragma unroll
        for (int i = 0; i < 8; ++i) { const f32x4 v = p[i]; s1 += v.x + v.z; s2 += v.y + v.w; }
        const float mean = s1 * (1.f / 1024.f), var = fmaxf(s2 * (1.f / 1024.f) - mean * mean, 0.f); mu[tid] = mean; rsd[tid] = rsqrtf(var + EPS); }
    __syncthreads();
    { const float* lg = P.ln_c_g + jc * D + gq * 128; const float* lbb = P.ln_c_b + jc * D + gq * 128;
#pragma unroll
      for (int u = 0; u < 4; ++u) { const int idx = tid + 512 * u, s = idx >> 4, ch = idx & 15; const float mm = mu[s], rr = rsd[s]; u32x4 w;
#pragma unroll
          for (int i = 0; i < 4; ++i) { const int c = ch * 8 + 2 * i; w[i] = pk2((bflo(v8[u][i]) - mm) * rr * lg[c] + lbb[c], (bfhi(v8[u][i]) - mm) * rr * lg[c + 1] + lbb[c + 1]); }
          *(u32x4*)(Vr + s * 144 + ch * 8) = w; } }
    __syncthreads();
    f32x4 acc[8];
#pragma unroll
    for (int mt = 0; mt < 8; ++mt) acc[mt] = (f32x4){0.f, 0.f, 0.f, 0.f};
    const bf16* wt = (const bf16*)(P.ws + WS_TRIL) + ((size_t)(jc * 8 + gq) * 128 + t) * 128 + quad * 8;
    const int nks = (wave >> 1) + 1;
    for (int ks = 0; ks < nks; ++ks) { const bf16x8 bb = *(const bf16x8*)(wt + ks * 32);
#pragma unroll
        for (int mt = 0; mt < 8; ++mt) { const bf16x8 a = tr_frag(Vr, 144, ks * 32, mt * 16, r16, quad); acc[mt] = MFMA16(a, bb, acc[mt]); } }
    { const float bs = P.b_s[(jc * 8 + gq) * 128 + t]; bf16* um = (bf16*)(P.ws + WS_OC);
#pragma unroll
      for (int mt = 0; mt < 8; ++mt) { const int c = gq * 128 + mt * 16 + quad * 4;
          u32x2 w; w.x = pk2(bflo(u4[mt].x) * (acc[mt][0] + bs), bfhi(u4[mt].x) * (acc[mt][1] + bs)); w.y = pk2(bflo(u4[mt].y) * (acc[mt][2] + bs), bfhi(u4[mt].y) * (acc[mt][3] + bs));
          *(u32x2*)(um + (tok0 + t) * D + c) = w; } }
    __syncthreads();
}

DI void hgrn_s_unit(unsigned char* lds, int j, int b, int h) {
    const Ptrs P = get_ptrs();
    const int tid = otid(); float* qq = (float*)lds; float* fg = qq + 128; float* kx = fg + 128; float* vv = kx + 128; float* part = vv + 128; float* sq = part + 16 * 128;
    const float* z = (const float*)(P.ws + WS_SMP + SMP_ZS) + (size_t)b * ABP; const float* lb = (const float*)(P.ws + WS_SMALL) + j * 512 + h * 128;
    if (tid < 128) { const float f = z[C_F + h * 128 + tid], lbv = lb[tid], fgv = lbv + (1.f - lbv) * sigmoidf_(f);
        qq[tid] = siluf_(z[C_Q + h * 128 + tid]); fg[tid] = fgv; kx[tid] = 1.f - fgv; vv[tid] = z[C_I + h * 128 + tid]; }
    __syncthreads();
    const int e4 = (tid & 31) * 4, dr = tid >> 5; const size_t sbase = (((size_t)j * DB + b) * 4 + h) * 16384;
    const float* S0 = P.state_hgrn + sbase; float* S1 = P.out + O_HG_S + sbase;
    f32x4 acc = {0.f, 0.f, 0.f, 0.f}; const f32x4 v4 = *(const f32x4*)(vv + e4);
#pragma unroll
    for (int it = 0; it < 8; ++it) { const int d = it * 16 + dr; const f32x4 s0 = *(const f32x4*)(S0 + d * 128 + e4); const f32x4 sn = s0 * fg[d] + v4 * kx[d]; *(f32x4*)(S1 + d * 128 + e4) = sn; acc += sn * qq[d]; }
    *(f32x4*)(part + dr * 128 + e4) = acc;
    __syncthreads();
    float o = 0.f;
    if (tid < 128) { for (int r = 0; r < 16; ++r) o += part[r * 128 + tid]; sq[tid] = o * o; }
    __syncthreads();
    if (tid < 128) { float ss = 0.f; for (int i = 0; i < 128; ++i) ss += sq[i]; const float rs = rsqrtf(ss * (1.f / 128.f) + EPS);
        ((bf16*)(P.ws + WS_SMP + SMP_OCS))[(size_t)b * D + h * 128 + tid] = f2bf(o * rs * P.hgrn_norm[j * 128 + tid] * siluf_(z[C_G + h * 128 + tid])); }
    __syncthreads();
}
DI void sattn_core(const float* const* kp, int nkeys, const float* qL, float* sc, float* red, float* oacc) {
    const int tid = otid(), wave = tid >> 6, lane = tid & 63;
    for (int key = tid; key < nkeys; key += 512) { const float* k = kp[key]; float d0 = -INFINITY, d1 = -INFINITY, d2 = -INFINITY, d3 = -INFINITY;
        if (k) { d0 = d1 = d2 = d3 = 0.f;
#pragma unroll
            for (int i = 0; i < 16; ++i) { const f32x4 kv = *(const f32x4*)(k + 4 * i); const f32x4 a = *(const f32x4*)(qL + 4 * i), b = *(const f32x4*)(qL + 64 + 4 * i), c = *(const f32x4*)(qL + 128 + 4 * i), d = *(const f32x4*)(qL + 192 + 4 * i);
                d0 += (kv.x * a.x + kv.y * a.y) + (kv.z * a.z + kv.w * a.w); d1 += (kv.x * b.x + kv.y * b.y) + (kv.z * b.z + kv.w * b.w);
                d2 += (kv.x * c.x + kv.y * c.y) + (kv.z * c.z + kv.w * c.w); d3 += (kv.x * d.x + kv.y * d.y) + (kv.z * d.z + kv.w * d.w); }
            d0 *= 0.125f; d1 *= 0.125f; d2 *= 0.125f; d3 *= 0.125f; }
        sc[key] = d0; sc[1040 + key] = d1; sc[2080 + key] = d2; sc[3120 + key] = d3; }
    __syncthreads();
    if (wave < 4) { float* row = sc + wave * 1040; float mx = -INFINITY; for (int k = lane; k < nkeys; k += 64) mx = fmaxf(mx, row[k]); mx = wave_max(mx); const float mu = (mx == -INFINITY) ? 0.f : mx;
        float sm = 0.f; for (int k = lane; k < nkeys; k += 64) { const float e = __expf(row[k] - mu); row[k] = e; sm += e; } sm = wave_sum(sm); const float il = 1.f / fmaxf(sm, 1e-30f);
        for (int k = lane; k < nkeys; k += 64) row[k] *= il; }
    __syncthreads();
    {
      const int ks = tid >> 4, d4 = (tid & 15) * 4; f32x4 a0 = {0.f, 0.f, 0.f, 0.f}, a1 = a0, a2 = a0, a3 = a0; const float* safe = kp[0];
      for (int k0 = ks; k0 < nkeys; k0 += 256) {
          f32x4 v[8]; float p0[8], p1[8], p2[8], p3[8];
#pragma unroll
          for (int u = 0; u < 8; ++u) { const int k = k0 + 32 * u; const bool ok = k < nkeys; const float* kv = ok ? kp[k] : nullptr; const bool ld = kv != nullptr; kv = ld ? kv : safe;
              v[u] = *(const f32x4*)(kv + 128 + d4); const int kk = ok ? k : 0;
              p0[u] = ld ? sc[kk] : 0.f; p1[u] = ld ? sc[1040 + kk] : 0.f; p2[u] = ld ? sc[2080 + kk] : 0.f; p3[u] = ld ? sc[3120 + kk] : 0.f; }
#pragma unroll
          for (int u = 0; u < 8; ++u) { a0 += v[u] * p0[u]; a1 += v[u] * p1[u]; a2 += v[u] * p2[u]; a3 += v[u] * p3[u]; }
      }
      *(f32x4*)(red + (ks * 4 + 0) * 64 + d4) = a0; *(f32x4*)(red + (ks * 4 + 1) * 64 + d4) = a1; *(f32x4*)(red + (ks * 4 + 2) * 64 + d4) = a2; *(f32x4*)(red + (ks * 4 + 3) * 64 + d4) = a3; }
    __syncthreads();
    if (tid < 256) { float a = 0.f;
#pragma unroll 8
        for (int ks = 0; ks < 32; ++ks) a += red[ks * 256 + tid];
        oacc[tid] = a; }
    __syncthreads();
}
DI void sattn_unit(unsigned char* lds, int j, int b, int g) {
    const Ptrs P = get_ptrs();
    const int tid = otid(), lane = tid & 63;
    const float** kp = (const float**)lds;
    float* sc = (float*)(lds + 8320);
    float* qL = sc + 4 * 1040; float* red = qL + 256; float* oacc = red + 8192; float* om = oacc + 256; float* imp = om + 256; int* flag = (int*)(imp + 132); int* list = flag + 132;
    const float* z = (const float*)(P.ws + WS_SMP + SMP_ZS) + (size_t)b * ABP;
    if (tid < 256) { qL[tid] = z[C_QB + g * 256 + tid]; om[tid] = 0.f; }
    const float* wbuf = P.state_win + (((size_t)j * DB + b) * 512) * 256 + g * 64;
    for (int k = tid; k < 512; k += 512) kp[k] = (k < 511) ? wbuf + (size_t)(k + 1) * 256 : z + C_WIN + g * 64;
    __syncthreads();
    sattn_core(kp, 512, qL, sc, red, oacc);
    if (tid < 256) { const int r = tid >> 6; om[tid] += sigmoidf_(z[C_GATE + (g * 4 + r) * 3 + 2]) * oacc[tid]; }
    __syncthreads();
    const float* kcs = (const float*)(P.ws + WS_KCS) + (size_t)b * 512 * 256 + g * 64;
    for (int k = tid; k < 511; k += 512) kp[k] = kcs + (size_t)k * 256;
    __syncthreads();
    sattn_core(kp, 511, qL, sc, red, oacc);
    if (tid < 256) { const int r = tid >> 6; om[tid] += sigmoidf_(z[C_GATE + (g * 4 + r) * 3 + 0]) * oacc[tid]; }
    if (tid < 129) { float a = 0.f; const int nlo = (4 * tid - 1 < 0) ? 0 : 4 * tid - 1, nhi = (4 * tid + 3 > 510) ? 510 : 4 * tid + 3;
        for (int r = 0; r < 4; ++r) for (int n = nlo; n <= nhi; ++n) a += sc[r * 1040 + n];
        imp[tid] = a; flag[tid] = (tid == 0 || tid == 127 || tid == 128) ? 1 : 0; }
    __syncthreads();
    if (tid < 64) {
        const int j1 = lane + 1, j2 = lane + 65; float v1 = imp[j1], v2 = (j2 <= 126) ? imp[j2] : -INFINITY; bool t1 = false, t2 = (j2 > 126);
        for (int it = 0; it < 13; ++it) {
            float bv; int bi;
            const float c1 = t1 ? -INFINITY : v1, c2 = t2 ? -INFINITY : v2;
            if (c2 > c1) { bv = c2; bi = j2; } else { bv = c1; bi = j1; }
#pragma unroll
            for (int o_ = 1; o_ < 64; o_ <<= 1) { const float ov = __shfl_xor(bv, o_); const int oi = __shfl_xor(bi, o_); if (ov > bv || (ov == bv && oi < bi)) { bv = ov; bi = oi; } }
            if (bi == j1) { t1 = true; flag[j1] = 1; } else if (bi == j2) { t2 = true; flag[j2] = 1; }
        }
    }
    __syncthreads();
    if (tid == 0) { int n = 0; for (int jb = 0; jb < 129 && n < 16; ++jb) if (flag[jb]) list[n++] = jb; for (; n < 16; ++n) list[n] = -1; }
    __syncthreads();
    for (int k = tid; k < 1024; k += 512) { const int jb = list[k >> 6], i = k & 63; const float* p = nullptr;
        if (jb >= 0) { if (jb < 128) { const int pos = jb * 64 + i, page = P.page_table[b * NPAGES + (pos >> 7)]; p = P.cache_sel + (((size_t)j * NPOOL + page) * 128 + (pos & 127)) * 256 + g * 64; }
                       else if (i == 0) p = z + C_SEL + g * 64; }
        kp[k] = p; }
    __syncthreads();
    sattn_core(kp, 1024, qL, sc, red, oacc);
    if (tid < 256) { const int r = tid >> 6, d = tid & 63; const float v = om[tid] + sigmoidf_(z[C_GATE + (g * 4 + r) * 3 + 1]) * oacc[tid];
        ((bf16*)(P.ws + WS_SMP + SMP_OCS))[(size_t)b * D + 512 + (g * 4 + r) * 64 + d] = f2bf(v); }
    __syncthreads();
}
DI void gmlp_s_unit(unsigned char* lds, int jc, int b) {
    const Ptrs P = get_ptrs();
    const int tid = otid(), wave = tid >> 6, lane = tid & 63; float* red = (float*)lds;
    const float* uv = (const float*)(P.ws + WS_SMP + SMP_UVS) + (size_t)b * 2048;
    const float v0 = uv[1024 + tid], v1 = uv[1024 + 512 + tid];
    float s = wave_sum(v0 + v1); if (lane == 0) red[wave] = s; __syncthreads();
    float mean = 0.f; for (int w = 0; w < 8; ++w) mean += red[w]; mean *= (1.f / 1024.f); __syncthreads();
    const float d0 = v0 - mean, d1 = v1 - mean; s = wave_sum(d0 * d0 + d1 * d1); if (lane == 0) red[wave] = s; __syncthreads();
    float var = 0.f; for (int w = 0; w < 8; ++w) var += red[w]; const float rs = rsqrtf(var * (1.f / 1024.f) + EPS);
#pragma unroll
    for (int k = 0; k < 2; ++k) { const int c = tid + 512 * k, gq = c >> 7; const float vl = (k ? d1 : d0) * rs * P.ln_c_g[jc * D + c] + P.ln_c_b[jc * D + c];
        P.out[O_CV_S + ((size_t)jc * DB + b) * D + c] = vl;
        ((bf16*)(P.ws + WS_SMP + SMP_OCS))[(size_t)b * D + c] = f2bf(uv[c] * (P.w_s[(size_t)(jc * 8 + gq) * 16384] * vl + P.b_s[(jc * 8 + gq) * 128])); }
    __syncthreads();
}
DI void final_norm(int bid, int G) {
    const Ptrs P = get_ptrs();
    const int tid = otid(), wave = tid >> 6, lane = tid & 63; const int gw = bid * 8 + wave, NGW = G * 8;
    const float* hs = (const float*)(P.ws + WS_SMP + SMP_HS);
    f32x4 g4[4];
#pragma unroll
    for (int k = 0; k < 4; ++k) g4[k] = ((const f32x4*)P.norm_final)[lane + 64 * k];
    for (int m = gw; m < MP + DB; m += NGW) {
        f32x4 v[4]; float s = 0.f;
        if (m < MP) { const u32x2* xr = (const u32x2*)((const bf16*)(P.ws + WS_HB) + (size_t)m * D) + lane;
#pragma unroll
            for (int k = 0; k < 4; ++k) { const u32x2 w = xr[64 * k]; v[k] = (f32x4){bflo(w.x), bfhi(w.x), bflo(w.y), bfhi(w.y)}; }
        } else { const f32x4* xr = (const f32x4*)(hs + (size_t)(m - MP) * D) + lane;
#pragma unroll
            for (int k = 0; k < 4; ++k) v[k] = xr[64 * k]; }
        f32x4* o = (f32x4*)((m < MP) ? P.out + O_YP + (size_t)m * D : P.out + O_YS + (size_t)(m - MP) * D) + lane;
#pragma unroll
        for (int k = 0; k < 4; ++k) s += (v[k].x * v[k].x + v[k].y * v[k].y) + (v[k].z * v[k].z + v[k].w * v[k].w);
        const float rs = rsqrtf(wave_sum(s) * (1.f / 1024.f) + EPS);
#pragma unroll
        for (int k = 0; k < 4; ++k) o[64 * k] = v[k] * rs * g4[k];
    }
}
constexpr int N_PHASES = 30;
__global__ void __launch_bounds__(512, 2) mega_fwd(Args args) {
    extern __shared__ __attribute__((aligned(16))) unsigned char lds[];
    const int tid = otid(), bid = blockIdx.x, G = gridDim.x;
    const int lo = args.ph_lo, hi = args.ph_hi;
    volatile LAS unsigned* MISC = (volatile LAS unsigned*)((LAS unsigned char*)lds + MISC_OFF);
    if (tid < 16) MISC[tid] = 0u;
    __syncthreads();
    XcdBarrier bar; bar.bar = (unsigned*)(args.ws + WS_CTL); bar.x = 0; bar.st = nullptr;
    const bool multi = (hi - lo) > 1;
    if (multi) bar = xcd_barrier_post((unsigned*)(args.ws + WS_CTL), MISC + 8);
#ifndef PHM
#define PHM 0x7ff
#endif
#define SITE(s) ((PHM >> (s)) & 1)
#ifndef PROBE_DUP
#define PROBE_DUP 0
#endif
#define NREP(s) (1 + ((PROBE_DUP >> (s)) & 1))
#ifndef FILL_A
#define FILL_A 1
#endif
#ifndef WGM_A
#define WGM_A 4
#endif
#ifndef WGM_C
#define WGM_C 4
#endif
#ifndef WGM_E
#define WGM_E 4
#endif
#ifndef WGM_F
#define WGM_F 4
#endif
#ifndef WGM_G
#define WGM_G 8
#endif
#ifndef PROBE_SK
#define PROBE_SK 0
#endif
#ifndef PROBE_SUB
#define PROBE_SUB 0
#endif
#define IN(k) (lo <= (k) && (k) < hi)
#ifndef PROBE_DBLBAR
#define PROBE_DBLBAR 0
#endif
#define SEAM(k) do { if (multi && (k) + 1 < hi) { xcd_barrier(bar); if (PROBE_DBLBAR) xcd_barrier(bar); } else __syncthreads(); } while (0)
#define LOCALS const Ptrs P = get_ptrs(); unsigned char* ws = P.ws; (void)ws; \
    float* hp = (float*)(ws + WS_HP); bf16* hb = (bf16*)(ws + WS_HB); float* ssq = (float*)(ws + WS_SSQ); bf16* zb = (bf16*)(ws + WS_ZB); bf16* hff = (bf16*)(ws + WS_HFF); bf16* oc = (bf16*)(ws + WS_OC); \
    float* hs = (float*)(ws + WS_SMP + SMP_HS); float* zs = (float*)(ws + WS_SMP + SMP_ZS); bf16* ocs = (bf16*)(ws + WS_SMP + SMP_OCS); bf16* hffs = (bf16*)(ws + WS_SMP + SMP_HFFS); float* uvs = (float*)(ws + WS_SMP + SMP_UVS); bf16* hsb = (bf16*)(ws + WS_SMP + SMP_HSB); (void)hsb; \
    (void)hp; (void)hb; (void)ssq; (void)zb; (void)hff; (void)oc; (void)hs; (void)zs; (void)ocs; (void)hffs; (void)uvs;
    PG8_LAS unsigned char* ring = (PG8_LAS unsigned char*)lds;

    if (SITE(0) && IN(0)) { for (int rep = 0; rep < NREP(0); ++rep) prologue(lds, bid, G); SEAM(0); }

    for (int L = 0; L < 4; ++L) {
        const int pb = 1 + 7 * L, j = L >> 1;
        if ((L & 1) == 0) {
            if (SITE(1) && IN(pb + 0)) {
                LOCALS
                for (int rep = 0; rep < NREP(1); ++rep) {
                { pg8::Gemm g{hb, (const bf16*)(ws + WS_WINAB) + (size_t)j * ABP * D, MP, ABP, D}; pg8::StaticOrder S; S.init(MP, ABP, G, bid, WGM_A);
                  EpiInAB E{zb, ssq, P.out + O_CMP_P + (size_t)j * MP * 256, P.out + O_SEL_P + (size_t)j * MP * 256, P.out + O_WIN_P + (size_t)j * BATCH * 512 * 256};
                  pg8::gemm_phase<EpiInAB, pg8::StaticOrder, true, true>(ring, g, S, E); }
                { SEpiInAB E{zs, P.out + O_CMP_S + (size_t)j * DB * 256, P.out + O_SEL_S + (size_t)j * DB * 256};
                  skinny_gemm<true, 4, SEpiInAB>(lds, hsb, D, (const bf16*)(ws + WS_WINAB) + (size_t)j * ABP * D, ABP, bid, G, E);
                   }
                if (rep == 0 && FILL_A) { const int rem = 896 % G;
                    if (rem != 0 && bid >= rem && bid - rem < 1024) { const int hi_ = bid - rem; compress_unit<true>(lds, j, hi_ >> 5, (hi_ >> 1) & 15, 511, PAST, hi_ & 1, (hi_ & 1) + 1); } }
                }
                SEAM(pb + 0);
            }
            if (SITE(2) && IN(pb + 1)) {
                for (int rep = 0; rep < NREP(2); ++rep) {
                const int rem_ = 896 % G, npre = (FILL_A && rem_ != 0) ? ((G - rem_ < 1024) ? G - rem_ : 1024) : 0, NH = 1024 - npre;
                unsigned* qctr = (unsigned*)(get_ptrs().ws + WS_CTL) + 4096 + 64 * (4 + j * 2 + rep);
                volatile LAS unsigned* qslot = MISC + 4;
                unsigned nxt = 0u;
                if (tid == 0) nxt = __hip_atomic_fetch_add(qctr, 1u, __ATOMIC_RELAXED, __HIP_MEMORY_SCOPE_AGENT);
                for (;;) {
                    if (tid == 0) qslot[0] = nxt;
                    __syncthreads();
                    int it = (int)qslot[0];
                    __syncthreads();
                    if (it >= NH + 736) break;
                    if (tid == 0) nxt = __hip_atomic_fetch_add(qctr, 1u, __ATOMIC_RELAXED, __HIP_MEMORY_SCOPE_AGENT);
                    if (it < NH) { const int hi_ = it + npre; compress_unit<true>(lds, j, hi_ >> 5, (hi_ >> 1) & 15, 511, PAST, hi_ & 1, (hi_ & 1) + 1); continue; }
                    it += 512 - NH;
                    if (it < 544) { const int u = it - 512; compress_unit<false>(lds, j, u >> 3, u & 7, 255, SEQ, 0, 2); }
                    else if (it < 672) { const int u = it - 544; hgrn_s_unit(lds, j, u >> 2, u & 3); }
                    else if (it < 736) {
                        LOCALS
                        const f32x4* src = (const f32x4*)(P.state_win + (size_t)j * DB * 512 * 256); f32x4* dst = (f32x4*)(P.out + O_WIN_S + (size_t)j * DB * 512 * 256);
                        const int i0 = (it - 672) * 16384 + otid();
#pragma unroll 4
                        for (int q = 0; q < 32; ++q) { const int i = i0 + q * 512, c4 = i & 63, s = (i >> 6) & 511, b = i >> 15;
                            dst[i] = (s < 511) ? src[i + 64] : *(const f32x4*)(zs + (size_t)b * ABP + C_WIN + c4 * 4); } }
                    else { const int u = (it - 736) * 2; hgrn_p1_unit(lds, j, u >> 8, u & 63, (u >> 6) & 3); hgrn_p1_unit(lds, j, (u + 1) >> 8, (u + 1) & 63, ((u + 1) >> 6) & 3); }
                }
                }
                SEAM(pb + 1);
            }
            if (SITE(3) && IN(pb + 2)) {
                for (int rep = 0; rep < NREP(3); ++rep) {
                const int myq = (int)(xb_xcc_id() & 7u); bool scan_ok = false;
                volatile LAS unsigned* qslot = MISC + 4;
                for (int off = 0; off < 8; ++off) {
                    const int q = (myq + off) & 7;
                    unsigned* qctr = (unsigned*)(get_ptrs().ws + WS_CTL) + 4096 + 64 * (16 + (j * 2 + rep) * 8 + q);
                    unsigned nxt = 0u;
                    if (tid == 0) nxt = __hip_atomic_fetch_add(qctr, 1u, __ATOMIC_RELAXED, __HIP_MEMORY_SCOPE_AGENT);
                    for (;;) {
                        if (tid == 0) qslot[0] = nxt;
                        __syncthreads();
                        const int it = (int)qslot[0];
                        __syncthreads();
                        if (it >= 216) break;
                        if (tid == 0) nxt = __hip_atomic_fetch_add(qctr, 1u, __ATOMIC_RELAXED, __HIP_MEMORY_SCOPE_AGENT);
                        if (it < 16) { if (rep == 0) hgrn_scan_item(j, q * 16 + it); }
                        else if (it < 24) { if (rep == 0 || PROBE_SUB != 2) { const int u = q * 8 + (it - 16); sattn_unit(lds, j, u >> 1, u & 1); } }
                        else if (it < 88) { if (rep == 0 || PROBE_SUB != 1) { const int qi = 63 - (it - 24); attn_unit(lds, q >> 1, q & 1, qi); if (rep == 0) publish_count(700 + (j * 8 + q) * 16 + (qi >> 2)); } }
                        else if (it < 152) { if (rep != 0) continue; const int i_ = it - 88, qb = 15 - (i_ >> 2);
                            wait_count(700 + (j * 8 + q) * 16 + qb, 4u);
                            sel_attn_unit(lds, q >> 1, (q & 1) * 4 + (i_ & 3), qb); }
                        else {
                            if (rep != 0) continue;
                            if (!scan_ok) { scan_wait(j); scan_ok = true; }
                            const int u = q * 128 + (it - 152) * 2; hgrn_p3_unit(lds, j, u >> 8, u & 63, (u >> 6) & 3); hgrn_p3_unit(lds, j, (u + 1) >> 8, (u + 1) & 63, ((u + 1) >> 6) & 3); }
                    }
                }
                }
                SEAM(pb + 2);
            }
        } else {
            if (SITE(5) && IN(pb + 0)) {
                LOCALS
                for (int rep = 0; rep < NREP(5); ++rep) {
                { pg8::Gemm g{hb, (const bf16*)(ws + WS_WINC) + (size_t)j * 2048 * D, MP, 2048, D}; pg8::StaticOrder S; S.init(MP, 2048, G, bid, WGM_C);
                  EpiInC E{zb, zb + (size_t)MP * D, ssq, (float*)(ws + WS_VSTAT)};
                  pg8::gemm_phase<EpiInC, pg8::StaticOrder, true, true>(ring, g, S, E); }
                { SEpiInC E{uvs}; skinny_gemm<true, 4, SEpiInC>(lds, hsb, D, (const bf16*)(ws + WS_WINC) + (size_t)j * 2048 * D, 2048, bid, G, E); }
                }
                SEAM(pb + 0);
            }
            if (SITE(6) && IN(pb + 1)) {
                for (int rep = 0; rep < NREP(6); ++rep) {
                unsigned* qctr = (unsigned*)(get_ptrs().ws + WS_CTL) + 4096 + 64 * (72 + j * 2 + rep);
                volatile LAS unsigned* qslot = MISC + 4; unsigned nxt = 0u;
                if (tid == 0) nxt = __hip_atomic_fetch_add(qctr, 1u, __ATOMIC_RELAXED, __HIP_MEMORY_SCOPE_AGENT);
                for (;;) {
                    if (tid == 0) qslot[0] = nxt;
                    __syncthreads();
                    const int it = (int)qslot[0];
                    __syncthreads();
                    if (it >= 512 + DB) break;
                    if (tid == 0) nxt = __hip_atomic_fetch_add(qctr, 1u, __ATOMIC_RELAXED, __HIP_MEMORY_SCOPE_AGENT);
                    if (it < DB) gmlp_s_unit(lds, j, it);
                    else { const int u = (it - DB) * 2; mix_unit(lds, j, u >> 3, u & 7); mix_unit(lds, j, (u + 1) >> 3, (u + 1) & 7); }
                }
                }
                SEAM(pb + 1);
            }
        }
        if (SITE(7) && IN(pb + 4)) {
            LOCALS
            const bf16* wo = (L & 1) ? (const bf16*)(ws + WS_WOUTC) + (size_t)j * D * D : (const bf16*)(ws + WS_WOUTAB) + (size_t)j * D * D;
            { pg8::Gemm g{oc, wo, MP, D, D}; pg8::StaticOrder S; S.init(MP, D, G, bid, WGM_E);
              if (NREP(7) == 2) { EpiResid E2{hb, (bf16*)(ws + WS_DUMMY + 64 * MiB), (float*)(ws + WS_DUMMY + 96 * MiB)}; pg8::gemm_phase<EpiResid, pg8::StaticOrder, true, true>(ring, g, S, E2);
                  SEpiResid E3{(float*)(ws + WS_DUMMY + 98 * MiB), (bf16*)(ws + WS_DUMMY + 99 * MiB)}; skinny_gemm<false, 4, SEpiResid>(lds, ocs, D, wo, D, bid, G, E3); }
              EpiResid E{hb, hb, ssq};
              pg8::gemm_phase<EpiResid, pg8::StaticOrder, true, true>(ring, g, S, E); }
            { SEpiResid E{hs, hsb}; skinny_gemm<false, 4, SEpiResid>(lds, ocs, D, wo, D, bid, G, E); }
            SEAM(pb + 4);
        }
        if (SITE(8) && IN(pb + 5)) {
            LOCALS
            const bf16* w1 = (const bf16*)(ws + WS_WF1) + (size_t)L * FF * D;
            for (int rep = 0; rep < NREP(8); ++rep) {
            { pg8::Gemm g{hb, w1, MP, FF, D}; pg8::StaticOrder S; S.init(MP, FF, G, bid, WGM_F); EpiFFN1 E{hff, ssq};
              pg8::gemm_phase<EpiFFN1, pg8::StaticOrder, true, true>(ring, g, S, E); }
            { SEpiFFN1 E{hffs}; skinny_gemm<true, 4, SEpiFFN1>(lds, hsb, D, w1, FF, bid, G, E); }
            }
            SEAM(pb + 5);
        }
        if (SITE(9) && IN(pb + 6)) {
            LOCALS
            const bf16* w2 = (const bf16*)(ws + WS_WF2) + (size_t)L * D * FF;
            { pg8::Gemm g{hff, w2, MP, D, FF}; pg8::StaticOrder S; S.init(MP, D, G, bid, WGM_G);
              if (NREP(9) == 2) { EpiResid E2{hb, (bf16*)(ws + WS_DUMMY + 64 * MiB), (float*)(ws + WS_DUMMY + 96 * MiB)}; pg8::gemm_phase<EpiResid, pg8::StaticOrder, true, true>(ring, g, S, E2);
                  SEpiResid E3{(float*)(ws + WS_DUMMY + 98 * MiB), (bf16*)(ws + WS_DUMMY + 99 * MiB)}; skinny_gemm<false, 16, SEpiResid>(lds, hffs, FF, w2, D, bid, G, E3); }
              EpiResid E{hb, hb, ssq};
              pg8::gemm_phase<EpiResid, pg8::StaticOrder, true, true>(ring, g, S, E); }
            { SEpiResid E{hs, hsb}; skinny_gemm<false, 16, SEpiResid>(lds, hffs, FF, w2, D, bid, G, E); }
            SEAM(pb + 6);
        }
    }
    if (SITE(10) && IN(29)) for (int rep = 0; rep < NREP(10); ++rep) final_norm(bid, G);
#undef IN
#undef SEAM
#undef LOCALS
}

extern "C" void kernel_launch(void* const* d_in, const int* in_sizes, int n_in, void* d_out, int out_size, void* d_ws, size_t ws_size, hipStream_t stream) {
    static int grid = 0;
    if (grid == 0) {
        if (n_in != 25 || (size_t)out_size != O_END || ws_size < WS_END + 100 * MiB) { fprintf(stderr, "kernel_launch: unexpected shapes (n_in %d out %d ws %zu)\n", n_in, out_size, ws_size); grid = -1; return; }
        int dev = 0, cus = 0, per_cu = 0;
        if (hipGetDevice(&dev) != hipSuccess || hipDeviceGetAttribute(&cus, hipDeviceAttributeMultiprocessorCount, dev) != hipSuccess) { grid = -1; return; }
        if (hipFuncSetAttribute((const void*)mega_fwd, hipFuncAttributeMaxDynamicSharedMemorySize, LDS_BYTES) != hipSuccess) { fprintf(stderr, "kernel_launch: hipFuncSetAttribute failed\n"); grid = -1; return; }
        if (hipOccupancyMaxActiveBlocksPerMultiprocessor(&per_cu, (const void*)mega_fwd, 512, LDS_BYTES) != hipSuccess || per_cu < 1) fprintf(stderr, "kernel_launch: occupancy query says %d\n", per_cu);
        (void)hipGetLastError();
        grid = cus;
    }
    if (grid < 0) return;
    (void)hipMemsetAsync((char*)d_ws + WS_CTL, 0, CTL_ZERO_BYTES, stream);
    Args a{};
    for (int i = 0; i < 25; ++i) a.in[i] = d_in[i];
    a.out = (float*)d_out; a.ws = (unsigned char*)d_ws;
#if MK_ONE_LAUNCH
#ifndef PROBE_PRE
#define PROBE_PRE 0
#endif
    if (PROBE_PRE > 0) {
        a.ph_lo = 0; a.ph_hi = PROBE_PRE; hipLaunchKernelGGL(mega_fwd, dim3(grid), dim3(512), LDS_BYTES, stream, a);
        (void)hipMemsetAsync((char*)d_ws + WS_CTL, 0, CTL_ZERO_BYTES, stream); }
    a.ph_lo = 0; a.ph_hi = N_PHASES;
    hipLaunchKernelGGL(mega_fwd, dim3(grid), dim3(512), LDS_BYTES, stream, a);
#else
    for (int ph = 0; ph < N_PHASES; ++ph) {
        if (ph >= 1 && ph <= 28) { const int L = (ph - 1) / 7, loc = (ph - 1) % 7; if ((L & 1) && (loc == 2 || loc == 3)) continue; }
        a.ph_lo = ph; a.ph_hi = ph + 1;
        hipLaunchKernelGGL(mega_fwd, dim3(grid), dim3(512), LDS_BYTES, stream, a);
    }
#endif
}
```

```cpp
#include <hip/hip_runtime.h>
#include <cstdio>
#include <cstdint>

#ifndef MK_ONE_LAUNCH
#define MK_ONE_LAUNCH 1
#endif

#define DI __device__ __forceinline__
#define LAS __attribute__((address_space(3)))
#define GAS __attribute__((address_space(1)))
typedef unsigned short bf16;
typedef short bf16x8 __attribute__((ext_vector_type(8)));
typedef short s16x4 __attribute__((ext_vector_type(4)));
typedef float f32x4 __attribute__((ext_vector_type(4)));
typedef float f32x2 __attribute__((ext_vector_type(2)));
typedef unsigned u32x4 __attribute__((ext_vector_type(4)));
typedef unsigned u32x2 __attribute__((ext_vector_type(2)));
typedef unsigned long long u64;

constexpr int D = 1024, BATCH = 4, SEQ = 4096, MP = BATCH * SEQ, DB = 32, PAST = 8192, NPAGES = 64, NPOOL = 2560;
constexpr int ABC = 3352, ABP = 3584, FF = 4096;
constexpr float EPS = 1e-6f;
constexpr int C_Q = 0, C_F = 512, C_I = 1024, C_G = 1536, C_QB = 2048, C_CMP = 2560, C_SEL = 2816, C_WIN = 3072, C_GATE = 3328;

constexpr size_t O_YP = 0, O_YS = 16777216, O_CMP_P = O_YS + 32768, O_CMP_S = O_CMP_P + 8388608, O_SEL_P = O_CMP_S + 16384, O_SEL_S = O_SEL_P + 8388608,
                 O_WIN_P = O_SEL_S + 16384, O_WIN_S = O_WIN_P + 1048576, O_HG_P = O_WIN_S + 8388608, O_HG_S = O_HG_P + 524288, O_CV_S = O_HG_S + 4194304, O_END = O_CV_S + 65536;

constexpr size_t MiB = 1u << 20;
constexpr size_t WS_CTL = 0, CTL_ZERO_BYTES = 1 * MiB;
constexpr size_t WS_WINAB = 2 * MiB, WS_WOUTAB = 16 * MiB, WS_WINC = 20 * MiB, WS_WOUTC = 28 * MiB, WS_WF1 = 32 * MiB, WS_WF2 = 64 * MiB, WS_WC1 = 96 * MiB, WS_WC2 = 98 * MiB,
                 WS_TRIL = 99 * MiB, WS_SMALL = 100 * MiB, WS_HP = 104 * MiB, WS_HB = 168 * MiB, WS_SSQ = 200 * MiB, WS_VSTAT = 201 * MiB, WS_ZB = 204 * MiB, WS_HFF = 316 * MiB,
                 WS_OC = 444 * MiB, WS_LT = 476 * MiB, WS_DL = 540 * MiB, WS_KCP = 541 * MiB, WS_KCS = 542 * MiB, WS_SMP = 558 * MiB, WS_END = 560 * MiB, WS_DUMMY = 560 * MiB;
constexpr size_t WS_MSK = WS_SMALL + 1 * MiB;
constexpr size_t SMP_HS = 0, SMP_ZS = 128 * 1024, SMP_OCS = 576 * 1024, SMP_HFFS = 704 * 1024, SMP_UVS = 1216 * 1024, SMP_HSB = 1472 * 1024;

constexpr int LDS_BYTES = 163840;
constexpr int MISC_OFF = LDS_BYTES - 64;

DI unsigned pk2(float lo, float hi) { typedef __bf16 bf2 __attribute__((ext_vector_type(2))); f32x2 v = {lo, hi}; bf2 b = __builtin_convertvector(v, bf2); return __builtin_bit_cast(unsigned, b); }
DI bf16 f2bf(float x) { return (bf16)(pk2(x, 0.f) & 0xffffu); }
DI float bf2f(bf16 h) { return __uint_as_float((unsigned)h << 16); }
DI float bflo(unsigned u) { return __uint_as_float(u << 16); }
DI float bfhi(unsigned u) { return __uint_as_float(u & 0xffff0000u); }
DI float sigmoidf_(float x) { return __builtin_amdgcn_rcpf(1.f + __expf(-x)); }
DI float siluf_(float x) { return x * __builtin_amdgcn_rcpf(1.f + __expf(-x)); }
DI float gelu_tanh(float x) { const float u = 0.7978845608028654f * (x + 0.044715f * x * x * x); return x * __builtin_amdgcn_rcpf(1.f + __expf(-2.f * u)); }
DI float wave_sum(float v) {
#pragma unroll
    for (int o = 1; o < 64; o <<= 1) v += __shfl_xor(v, o);
    return v;
}
DI float wave_max(float v) {
#pragma unroll
    for (int o = 1; o < 64; o <<= 1) v = fmaxf(v, __shfl_xor(v, o));
    return v;
}
DI float fmax2(float a, float b) { float r; asm("v_max_f32 %0, %1, %2" : "=v"(r) : "v"(a), "v"(b)); return r; }
DI float fmax3(float a, float b, float c) { float r; asm("v_max3_f32 %0, %1, %2, %3" : "=v"(r) : "v"(a), "v"(b), "v"(c)); return r; }
DI float quad_max(float v) {
    auto a = __builtin_amdgcn_permlane16_swap(__float_as_uint(v), __float_as_uint(v), false, false); v = fmax2(__uint_as_float(a[0]), __uint_as_float(a[1]));
    auto b = __builtin_amdgcn_permlane32_swap(__float_as_uint(v), __float_as_uint(v), false, false); return fmax2(__uint_as_float(b[0]), __uint_as_float(b[1]));
}
DI float quad_sum(float v) {
    auto a = __builtin_amdgcn_permlane16_swap(__float_as_uint(v), __float_as_uint(v), false, false); v = __uint_as_float(a[0]) + __uint_as_float(a[1]);
    auto b = __builtin_amdgcn_permlane32_swap(__float_as_uint(v), __float_as_uint(v), false, false); return __uint_as_float(b[0]) + __uint_as_float(b[1]);
}
DI bf16x8 pack8(f32x4 a, f32x4 b) { u32x4 p; p.x = pk2(a.x, a.y); p.y = pk2(a.z, a.w); p.z = pk2(b.x, b.y); p.w = pk2(b.z, b.w); return __builtin_bit_cast(bf16x8, p); }
DI int otid() { int t = threadIdx.x; asm volatile("" : "+v"(t)); return t; }
#define MFMA16(a, b, c) __builtin_amdgcn_mfma_f32_16x16x32_bf16((a), (b), (c), 0, 0, 0)
DI s16x4 vtr(const bf16* p) { return __builtin_bit_cast(s16x4, __builtin_amdgcn_ds_read_tr16_b64_v4i16((LAS s16x4*)(LAS char*)p)); }
DI bf16x8 tr_frag(const bf16* img, int stride, int k0, int c0, int r16, int quad) {
    const bf16* p = img + (k0 + quad * 8 + (r16 >> 2)) * stride + c0 + (r16 & 3) * 4;
    const s16x4 lo = vtr(p), hi = vtr(p + 4 * stride);
    return __builtin_shufflevector(lo, hi, 0, 1, 2, 3, 4, 5, 6, 7);
}

namespace pg8 {
#define PG8_LAS __attribute__((address_space(3)))
constexpr int BM = 256, BK = 64, HALF = 128, HTB = HALF * BK * 2, STAGE_BYTES = 8 * HTB, NXCD = 8, WGM = 4;
__host__ __device__ __forceinline__ int lds_byte(int r, int c) { const int st = (r >> 4) * 2 + (c >> 5), rr = r & 15, cc = c & 31, ob = rr * 64 + cc * 2; return st * 1024 + (ob ^ (((ob >> 9) & 1) << 5)); }
__host__ __device__ __forceinline__ void stage_rc(int b, int& R, int& C) { const int st = b / 1024, sb = b % 1024, swz = sb ^ (((sb >> 9) & 1) << 5); R = (st >> 1) * 16 + swz / 64; C = (st & 1) * 32 + (swz % 64) / 2; }
__host__ __device__ __forceinline__ int perm32(int rho) { const int n = rho >> 4, i = rho & 15; return 8 * (i >> 2) + 4 * n + (i & 3); }
struct Unit { int pm, pn; };
struct Gemm { const bf16* A; const bf16* Bt; int M, N, K; };
struct StaticOrder {
    int nM, nN, nwg, G, c, wgm;
    __host__ __device__ void init(int M, int N, int G_, int c_, int wgm_ = WGM) { nM = M / BM; nN = N / BM; nwg = nM * nN; G = G_; c = c_; wgm = wgm_; }
    __host__ __device__ bool next(int i, Unit& u) const {
        const long L = (long)i * G + c; if (L >= nwg) return false;
        int wgid = (int)L; { const int q = nwg / NXCD, r = nwg % NXCD, xcd = wgid % NXCD, off = wgid / NXCD; wgid = (xcd < r ? xcd * (q + 1) : r * (q + 1) + (xcd - r) * q) + off; }
        const int nig = wgm * nN, gid = wgid / nig, fm = gid * wgm, gsz = (nM - fm) < wgm ? (nM - fm) : wgm;
        u.pm = fm + ((wgid % nig) % gsz); u.pn = (wgid % nig) / gsz; return true;
    }
    __device__ __forceinline__ void a_ready(const Unit&) const {}
    __device__ __forceinline__ void done(const Unit&) const {}
};
template <class Epi, class Sched, bool ALIGN_EPI = false, bool SP2 = false, bool TA = false, bool TB = false>
__device__ __forceinline__ void gemm_phase(PG8_LAS unsigned char* lds, const Gemm g, const Sched& S, const Epi& E) {
    const int tid = otid(), wid = __builtin_amdgcn_readfirstlane(tid >> 6), lane = tid & 63, wr = wid >> 2, wc = wid & 3, fr = lane & 15, fq = lane >> 4;
    const int K = g.K, nt = K / BK;
    unsigned voffA[2], voffB[2];
#pragma unroll
    for (int i = 0; i < 2; ++i) { int R, C; stage_rc(tid * 16 + i * 8192, R, C); const int Rb = Epi::PERM ? ((R & ~31) + perm32(R & 31)) : R;
        const int b_ = tid * 16 + i * 8192, st_ = b_ >> 10, sb_ = b_ & 1023, swz_ = sb_ ^ (((sb_ >> 9) & 1) << 5); const unsigned tl_ = (unsigned)(((st_ >> 1) * (K >> 5) + (st_ & 1)) * 1024 + swz_);
        voffA[i] = TA ? tl_ : (unsigned)(R * K + C) * 2u; voffB[i] = TB ? tl_ : (unsigned)(Rb * K + C) * 2u; }
    const size_t kstepA = TA ? (size_t)2048 : (size_t)(BK * 2), kstepB = TB ? (size_t)2048 : (size_t)(BK * 2);
    const size_t hstep = (size_t)HALF * K * 2;
    const size_t tstep = 2 * hstep;
    const unsigned ldsw = (unsigned)wid * 1024u;
    const int aoff = lds_byte(wr * 64 + fr, fq * 8), boff = lds_byte(wc * 32 + fr, fq * 8);
#define PG8_SA(b, h) (((b) * 2 + (h)) * HTB)
#define PG8_SB(b, h) ((4 + (b) * 2 + (h)) * HTB)
#define PG8_STAGE(bufoff, gbase, voff) do { _Pragma("unroll") for (int _i = 0; _i < 2; ++_i) \
        __builtin_amdgcn_global_load_lds((const unsigned*)((const char*)(gbase) + (voff)[_i]), (PG8_LAS unsigned*)(lds + (bufoff) + ldsw + _i * 8192), 16, 0, 0); } while (0)
#define PG8_LDA(dst, b, h) do { _Pragma("unroll") for (int m = 0; m < 4; ++m) _Pragma("unroll") for (int k = 0; k < 2; ++k) dst[m][k] = *(const PG8_LAS bf16x8*)(lds + PG8_SA(b, h) + aoff + m * 2048 + k * 1024); } while (0)
#define PG8_LDB(dst, b, h) do { _Pragma("unroll") for (int n = 0; n < 2; ++n) _Pragma("unroll") for (int k = 0; k < 2; ++k) dst[n][k] = *(const PG8_LAS bf16x8*)(lds + PG8_SB(b, h) + boff + n * 2048 + k * 1024); } while (0)
#define PG8_MMA(ai, bj, At, Bt) do { __builtin_amdgcn_s_setprio(1); _Pragma("unroll") for (int m = 0; m < 4; ++m) _Pragma("unroll") for (int n = 0; n < 2; ++n) _Pragma("unroll") for (int k = 0; k < 2; ++k) \
        acc[ai][bj][m][n] = __builtin_amdgcn_mfma_f32_16x16x32_bf16(Bt[n][k], At[m][k], acc[ai][bj][m][n], 0, 0, 0); __builtin_amdgcn_s_setprio(0); } while (0)
#define PG8_WAIT_V(n) asm volatile("s_waitcnt vmcnt(" #n ")" ::: "memory")
#define PG8_WAIT_L(n) asm volatile("s_waitcnt lgkmcnt(" #n ")" ::: "memory")
#define PG8_BAR __builtin_amdgcn_s_barrier()
#define PG8_SCHED __builtin_amdgcn_sched_barrier(0)
    Unit cur, nxt; int ui = 0;
    if (!S.next(0, cur)) return;
    f32x4 acc[2][2][4][2];
#pragma unroll
    for (int a = 0; a < 2; ++a)
#pragma unroll
        for (int b = 0; b < 2; ++b)
#pragma unroll
            for (int m = 0; m < 4; ++m)
#pragma unroll
                for (int n = 0; n < 2; ++n) acc[a][b][m][n] = (f32x4){0.f, 0.f, 0.f, 0.f};
    bf16x8 At[4][2], B0[2][2], B1[2][2];
    const char* cA = (const char*)g.A + (size_t)cur.pm * tstep; const char* cB = (const char*)g.Bt + (size_t)cur.pn * tstep;
    S.a_ready(cur);
    if constexpr (SP2) {
        PG8_STAGE(PG8_SB(0, 0), cB, voffB); PG8_STAGE(PG8_SB(0, 1), cB + hstep, voffB); PG8_STAGE(PG8_SA(0, 0), cA, voffA); PG8_STAGE(PG8_SA(0, 1), cA + hstep, voffA);
        if (wr == 1) PG8_BAR;
        PG8_WAIT_V(2); PG8_BAR;
        PG8_STAGE(PG8_SB(1, 0), cB + kstepB, voffB); PG8_STAGE(PG8_SA(1, 0), cA + kstepA, voffA); PG8_STAGE(PG8_SB(1, 1), cB + hstep + kstepB, voffB);
        PG8_WAIT_V(6); PG8_BAR;
    } else {
        PG8_STAGE(PG8_SB(0, 0), cB, voffB); PG8_STAGE(PG8_SA(0, 0), cA, voffA); PG8_STAGE(PG8_SB(0, 1), cB + hstep, voffB); PG8_STAGE(PG8_SA(0, 1), cA + hstep, voffA);
        if (wr == 1) PG8_BAR;
        PG8_WAIT_V(4); PG8_BAR;
        PG8_STAGE(PG8_SB(1, 0), cB + kstepB, voffB); PG8_STAGE(PG8_SA(1, 0), cA + kstepA, voffA); PG8_STAGE(PG8_SB(1, 1), cB + hstep + kstepB, voffB);
        PG8_WAIT_V(6); PG8_BAR;
    }
    for (;;) {
        const bool has_next = S.next(ui + 1, nxt);
        const char* nA = has_next ? (const char*)g.A + (size_t)nxt.pm * tstep : cA; const char* nB = has_next ? (const char*)g.Bt + (size_t)nxt.pn * tstep : cB;
        for (int t = 0; t < nt; t += 2) {
            const bool last = (t == nt - 2);
            const char* a1 = cA + (size_t)(t + 1) * kstepA;
            const char* a2 = last ? nA : cA + (size_t)(t + 2) * kstepA; const char* b2 = last ? nB : cB + (size_t)(t + 2) * kstepB;
            const char* a3 = a2 + kstepA; const char* b3 = b2 + kstepB;
            if (last && has_next) S.a_ready(nxt);
            if constexpr (SP2) {
            PG8_LDB(B0, 0, 0); PG8_LDB(B1, 0, 1); PG8_SCHED; PG8_LDA(At, 0, 0); PG8_STAGE(PG8_SA(1, 1), a1 + hstep, voffA);
            PG8_WAIT_V(8); PG8_WAIT_L(0); PG8_BAR; PG8_MMA(0, 0, At, B0); PG8_MMA(0, 1, At, B1); PG8_BAR; PG8_SCHED;
            PG8_LDA(At, 0, 1); PG8_STAGE(PG8_SB(0, 0), b2, voffB); PG8_STAGE(PG8_SB(0, 1), b2 + hstep, voffB); PG8_STAGE(PG8_SA(0, 0), a2, voffA);
            PG8_WAIT_V(8); PG8_WAIT_L(0); PG8_BAR; PG8_MMA(1, 0, At, B0); PG8_MMA(1, 1, At, B1); PG8_BAR; PG8_SCHED;
            PG8_LDB(B0, 1, 0); PG8_LDB(B1, 1, 1); PG8_SCHED; PG8_LDA(At, 1, 0); PG8_STAGE(PG8_SA(0, 1), a2 + hstep, voffA);
            PG8_WAIT_V(8); PG8_WAIT_L(0); PG8_BAR; PG8_MMA(0, 0, At, B0); PG8_MMA(0, 1, At, B1); PG8_BAR; PG8_SCHED;
            PG8_LDA(At, 1, 1); PG8_STAGE(PG8_SB(1, 0), b3, voffB); PG8_STAGE(PG8_SB(1, 1), b3 + hstep, voffB); PG8_STAGE(PG8_SA(1, 0), a3, voffA);
            PG8_WAIT_V(8); PG8_WAIT_L(0); PG8_BAR; PG8_MMA(1, 0, At, B0); PG8_MMA(1, 1, At, B1); PG8_BAR; PG8_SCHED;
            } else {
            PG8_LDB(B0, 0, 0); PG8_SCHED; PG8_LDA(At, 0, 0); PG8_STAGE(PG8_SA(1, 1), a1 + hstep, voffA);
            PG8_WAIT_L(8); PG8_BAR; PG8_WAIT_L(0); PG8_MMA(0, 0, At, B0); PG8_BAR; PG8_SCHED;
            PG8_LDB(B1, 0, 1); PG8_STAGE(PG8_SB(0, 0), b2, voffB);
            PG8_BAR; PG8_WAIT_L(0); PG8_MMA(0, 1, At, B1); PG8_BAR;
            PG8_LDA(At, 0, 1); PG8_STAGE(PG8_SA(0, 0), a2, voffA);
            PG8_BAR; PG8_WAIT_L(0); PG8_MMA(1, 0, At, B0); PG8_BAR; PG8_SCHED;
            PG8_STAGE(PG8_SB(0, 1), b2 + hstep, voffB);
            PG8_WAIT_V(6); PG8_BAR; PG8_MMA(1, 1, At, B1); PG8_BAR;
            PG8_LDB(B0, 1, 0); PG8_SCHED; PG8_LDA(At, 1, 0); PG8_STAGE(PG8_SA(0, 1), a2 + hstep, voffA);
            PG8_WAIT_L(8); PG8_BAR; PG8_WAIT_L(0); PG8_MMA(0, 0, At, B0); PG8_BAR; PG8_SCHED;
            PG8_LDB(B1, 1, 1); PG8_STAGE(PG8_SB(1, 0), b3, voffB);
            PG8_BAR; PG8_WAIT_L(0); PG8_MMA(0, 1, At, B1); PG8_BAR;
            PG8_LDA(At, 1, 1); PG8_STAGE(PG8_SA(1, 0), a3, voffA);
            PG8_BAR; PG8_WAIT_L(0); PG8_MMA(1, 0, At, B0); PG8_BAR; PG8_SCHED;
            PG8_STAGE(PG8_SB(1, 1), b3 + hstep, voffB);
            PG8_WAIT_V(6); PG8_BAR; PG8_MMA(1, 1, At, B1); PG8_BAR;
            }
        }
        if constexpr (ALIGN_EPI) { if (wr == 0) PG8_BAR; }
        if constexpr (!Epi::AFTER_DRAIN) { E(acc, cur, wr, wc, fr, fq); S.done(cur); }
        if (!has_next) break;
#pragma unroll
        for (int a = 0; a < 2; ++a)
#pragma unroll
            for (int b = 0; b < 2; ++b)
#pragma unroll
                for (int m = 0; m < 4; ++m)
#pragma unroll
                    for (int n = 0; n < 2; ++n) acc[a][b][m][n] = (f32x4){0.f, 0.f, 0.f, 0.f};
        cur = nxt; cA = nA; cB = nB; ++ui;
        if constexpr (ALIGN_EPI) { if (wr == 1) PG8_BAR; }
    }
    PG8_WAIT_V(0);
    if constexpr (!ALIGN_EPI) { if (wr == 0) PG8_BAR; }
    PG8_BAR;
#undef PG8_SA
#undef PG8_SB
#undef PG8_STAGE
#undef PG8_LDA
#undef PG8_LDB
#undef PG8_MMA
#undef PG8_WAIT_V
#undef PG8_WAIT_L
#undef PG8_BAR
#undef PG8_SCHED
}
}
using pg8::Unit;
DI int inv_perm32(int x) { return 16 * ((x >> 2) & 1) + 4 * (x >> 3) + (x & 3); }
DI size_t tiled_off(int r, int c, int K) { return ((((size_t)(r >> 4) * (K >> 5) + (c >> 5)) << 9) + ((r & 15) << 5) + (c & 31)); }

DI float row_rstd16(const float* ssq, int row, int fq) {
    const f32x4 a = *(const f32x4*)(ssq + (size_t)row * 16 + fq * 4);
    const float s = quad_sum((a.x + a.y) + (a.z + a.w));
    return rsqrtf(s * (1.f / 1024.f) + EPS);
}
struct EpiInAB {
    static constexpr bool PERM = true, AFTER_DRAIN = false;
    bf16* zb; const float* ssq; float* o_cmp; float* o_sel; float* o_win;
    DI void operator()(const f32x4 (&acc)[2][2][4][2], const Unit& u, int wr, int wc, int fr, int fq) const {
#pragma unroll
        for (int ai = 0; ai < 2; ++ai)
#pragma unroll
            for (int m = 0; m < 4; ++m) {
                const int row = u.pm * 256 + ai * 128 + wr * 64 + m * 16 + fr; const float rs = row_rstd16(ssq, row, fq);
#pragma unroll
                for (int bj = 0; bj < 2; ++bj) {
                    const int cl = bj * 128 + wc * 32 + fq * 8, col = u.pn * 256 + cl;
                    const f32x4 v0 = acc[ai][bj][m][0] * rs, v1 = acc[ai][bj][m][1] * rs;
                    u32x4 w; w.x = pk2(v0[0], v0[1]); w.y = pk2(v0[2], v0[3]); w.z = pk2(v1[0], v1[1]); w.w = pk2(v1[2], v1[3]);
                    *(u32x4*)(zb + (size_t)row * ABP + col) = w;
                    if (u.pn == 10) { float* o = o_cmp + (size_t)row * 256 + cl; *(f32x4*)o = v0; *(f32x4*)(o + 4) = v1; }
                    else if (u.pn == 11) { float* o = o_sel + (size_t)row * 256 + cl; *(f32x4*)o = v0; *(f32x4*)(o + 4) = v1; }
                    else if (u.pn == 12) { const int t = row & 4095, b = row >> 12; if (t >= SEQ - 512) { float* o = o_win + ((size_t)b * 512 + (t - (SEQ - 512))) * 256 + cl; *(f32x4*)o = v0; *(f32x4*)(o + 4) = v1; } }
                }
            }
    }
};
struct EpiResid {
    static constexpr bool PERM = true, AFTER_DRAIN = false;
    const bf16* res; bf16* hb; float* ssq;
    DI void operator()(const f32x4 (&acc)[2][2][4][2], const Unit& u, int wr, int wc, int fr, int fq) const {
#pragma unroll
        for (int ai = 0; ai < 2; ++ai)
#pragma unroll
            for (int m = 0; m < 4; ++m) {
                const int row = u.pm * 256 + ai * 128 + wr * 64 + m * 16 + fr; float ss = 0.f;
#pragma unroll
                for (int bj = 0; bj < 2; ++bj) {
                    const int col = u.pn * 256 + bj * 128 + wc * 32 + fq * 8; const size_t o = (size_t)row * D + col;
                    const u32x4 r8 = *(const u32x4*)(res + o);
                    const f32x4 v0 = acc[ai][bj][m][0] + (f32x4){bflo(r8.x), bfhi(r8.x), bflo(r8.y), bfhi(r8.y)}, v1 = acc[ai][bj][m][1] + (f32x4){bflo(r8.z), bfhi(r8.z), bflo(r8.w), bfhi(r8.w)};
                    u32x4 w; w.x = pk2(v0[0], v0[1]); w.y = pk2(v0[2], v0[3]); w.z = pk2(v1[0], v1[1]); w.w = pk2(v1[2], v1[3]);
                    *(u32x4*)(hb + o) = w;
                    ss += (v0[0] * v0[0] + v0[1] * v0[1]) + (v0[2] * v0[2] + v0[3] * v0[3]) + (v1[0] * v1[0] + v1[1] * v1[1]) + (v1[2] * v1[2] + v1[3] * v1[3]);
                }
                ss = quad_sum(ss);
                if (fq == 0) ssq[(size_t)row * 16 + u.pn * 4 + wc] = ss;
            }
    }
};
struct EpiFFN1 {
    static constexpr bool PERM = true, AFTER_DRAIN = false;
    bf16* hff; const float* ssq;
    DI void operator()(const f32x4 (&acc)[2][2][4][2], const Unit& u, int wr, int wc, int fr, int fq) const {
#pragma unroll
        for (int ai = 0; ai < 2; ++ai)
#pragma unroll
            for (int m = 0; m < 4; ++m) {
                const int row = u.pm * 256 + ai * 128 + wr * 64 + m * 16 + fr; const float rs = row_rstd16(ssq, row, fq);
#pragma unroll
                for (int bj = 0; bj < 2; ++bj) {
                    const int col = u.pn * 256 + bj * 128 + wc * 32 + fq * 8;
                    f32x4 v0 = acc[ai][bj][m][0] * rs, v1 = acc[ai][bj][m][1] * rs;
#pragma unroll
                    for (int i = 0; i < 4; ++i) { const float a = fmaxf(v0[i], 0.f), b = fmaxf(v1[i], 0.f); v0[i] = a * a; v1[i] = b * b; }
                    u32x4 w; w.x = pk2(v0[0], v0[1]); w.y = pk2(v0[2], v0[3]); w.z = pk2(v1[0], v1[1]); w.w = pk2(v1[2], v1[3]);
                    *(u32x4*)(hff + tiled_off(row, col, FF)) = w;
                }
            }
    }
};
struct EpiInC {
    static constexpr bool PERM = true, AFTER_DRAIN = false;
    bf16* ub; bf16* vb; const float* ssq; float* vstat;
    DI void operator()(const f32x4 (&acc)[2][2][4][2], const Unit& u, int wr, int wc, int fr, int fq) const {
        const bool isv = u.pn >= 4; bf16* dst = isv ? vb : ub; const int pn = isv ? u.pn - 4 : u.pn;
#pragma unroll
        for (int ai = 0; ai < 2; ++ai)
#pragma unroll
            for (int m = 0; m < 4; ++m) {
                const int row = u.pm * 256 + ai * 128 + wr * 64 + m * 16 + fr; const float rs = row_rstd16(ssq, row, fq); float s1 = 0.f, s2 = 0.f;
#pragma unroll
                for (int bj = 0; bj < 2; ++bj) {
                    const int col = pn * 256 + bj * 128 + wc * 32 + fq * 8;
                    f32x4 v0 = acc[ai][bj][m][0] * rs, v1 = acc[ai][bj][m][1] * rs;
#pragma unroll
                    for (int i = 0; i < 4; ++i) { v0[i] = gelu_tanh(v0[i]); v1[i] = gelu_tanh(v1[i]); s1 += v0[i] + v1[i]; s2 += v0[i] * v0[i] + v1[i] * v1[i]; }
                    u32x4 w; w.x = pk2(v0[0], v0[1]); w.y = pk2(v0[2], v0[3]); w.z = pk2(v1[0], v1[1]); w.w = pk2(v1[2], v1[3]);
                    *(u32x4*)(dst + (size_t)row * D + col) = w;
                }
                if (isv) { s1 = quad_sum(s1); s2 = quad_sum(s2);
                    if (fq == 0) *(f32x2*)(vstat + ((size_t)row * 16 + pn * 4 + wc) * 2) = (f32x2){s1, s2}; }
            }
    }
};

DI unsigned* ctl_words();
DI void publish_count(int idx) {
    asm volatile("s_waitcnt vmcnt(0)" ::: "memory");
    __syncthreads();
    if (threadIdx.x == 0) { __builtin_amdgcn_fence(__ATOMIC_RELEASE, "agent"); asm volatile("s_waitcnt vmcnt(0)" ::: "memory");
        __hip_atomic_fetch_add(ctl_words() + 4096 + 64 * idx, 1u, __ATOMIC_RELAXED, __HIP_MEMORY_SCOPE_AGENT); }
}
DI void wait_count(int idx, unsigned n) {
    if (threadIdx.x == 0) { unsigned* c = ctl_words() + 4096 + 64 * idx; unsigned sp = 0;
        while (__hip_atomic_load(c, __ATOMIC_RELAXED, __HIP_MEMORY_SCOPE_AGENT) < n) { __builtin_amdgcn_s_sleep(2); if (++sp > (1u << 22)) break; }
        __builtin_amdgcn_fence(__ATOMIC_ACQUIRE, "agent"); asm volatile("s_waitcnt vmcnt(0)" ::: "memory"); }
    __syncthreads();
}
DI float dot8sq(bf16x8 x) { const u32x4 u = __builtin_bit_cast(u32x4, x); float s = 0.f;
#pragma unroll
    for (int i = 0; i < 4; ++i) { const float a = bflo(u[i]), b = bfhi(u[i]); s += a * a + b * b; }
    return s; }
template <bool NORM, int KS, class Epi>
DI void skinny_gemm(unsigned char* lds, const bf16* A, int lda, const bf16* Wt, int N, int bid, int G, const Epi& E) {
    constexpr int K = KS * 32 * 8;
    float* red = (float*)lds; float* sred = red + 8 * 2 * 64 * 4;
    const int tid = otid(), wave = tid >> 6, lane = tid & 63, r16 = lane & 15, quad = lane >> 4, ksl = KS * 32;
    for (int task = bid; task < (N >> 4); task += G) {
        const int n0 = task * 16;
        f32x4 acc0 = {0.f, 0.f, 0.f, 0.f}, acc1 = {0.f, 0.f, 0.f, 0.f}; float ss0 = 0.f, ss1 = 0.f;
        float pre_[4] = {0.f, 0.f, 0.f, 0.f};
        if (tid < 128) { const int rt = tid >> 6, l = tid & 63, p_ = n0 + (l & 15), col = (p_ & ~31) + pg8::perm32(p_ & 31);
#pragma unroll
            for (int i = 0; i < 4; ++i) pre_[i] = E.pre(rt * 16 + (l >> 4) * 4 + i, col); }
        const unsigned woff = (unsigned)(((task * (K >> 5) + wave * KS) << 10) + r16 * 64 + quad * 16);
        const bf16* a0 = A + (size_t)r16 * lda + wave * ksl + quad * 8; const bf16* a1 = a0 + (size_t)16 * lda;
#pragma unroll
        for (int k0 = 0; k0 < KS; k0 += 8) {
            constexpr int NB = (KS < 8) ? KS : 8;
            bf16x8 bq[NB], x0[NB], x1[NB];
#pragma unroll
            for (int u = 0; u < NB; ++u) { bq[u] = *(const bf16x8*)((const char*)Wt + (size_t)(woff + (unsigned)((k0 + u) * 1024))); x0[u] = *(const bf16x8*)(a0 + (k0 + u) * 32); x1[u] = *(const bf16x8*)(a1 + (k0 + u) * 32); }
#pragma unroll
            for (int u = 0; u < NB; ++u) { if (NORM) { ss0 += dot8sq(x0[u]); ss1 += dot8sq(x1[u]); } acc0 = MFMA16(x0[u], bq[u], acc0); acc1 = MFMA16(x1[u], bq[u], acc1); }
        }
        if (NORM) { ss0 = quad_sum(ss0); ss1 = quad_sum(ss1); if (quad == 0) { sred[wave * 32 + r16] = ss0; sred[wave * 32 + 16 + r16] = ss1; } }
        *(f32x4*)(red + ((wave * 2 + 0) * 64 + lane) * 4) = acc0; *(f32x4*)(red + ((wave * 2 + 1) * 64 + lane) * 4) = acc1;
        __syncthreads();
        if (tid < 128) {
            const int rt = tid >> 6, l = tid & 63; f32x4 s = {0.f, 0.f, 0.f, 0.f};
#pragma unroll
            for (int w = 0; w < 8; ++w) s += *(const f32x4*)(red + ((w * 2 + rt) * 64 + l) * 4);
#pragma unroll
            for (int i = 0; i < 4; ++i) { const int row = rt * 16 + (l >> 4) * 4 + i, p_ = n0 + (l & 15), col = (p_ & ~31) + pg8::perm32(p_ & 31); float sc = 1.f;
                if (NORM) { float q = 0.f;
#pragma unroll
                    for (int w = 0; w < 8; ++w) q += sred[w * 32 + row];
                    sc = rsqrtf(q / (float)K + EPS); }
                E(row, col, s[i] * sc, pre_[i]); }
        }
        __syncthreads();
    }
}
struct SEpiInAB { float* zs; float* o_cmp; float* o_sel;
    DI float pre(int, int) const { return 0.f; }
    DI void operator()(int row, int col, float v, float) const { zs[row * ABP + col] = v; if (col >= C_CMP && col < C_SEL) o_cmp[row * 256 + col - C_CMP] = v; else if (col >= C_SEL && col < C_WIN) o_sel[row * 256 + col - C_SEL] = v; } };
struct SEpiResid { float* hs; bf16* hsb; DI float pre(int row, int col) const { return hs[row * D + col]; }
    DI void operator()(int row, int col, float v, float p) const { const float r = p + v; hs[row * D + col] = r; hsb[row * D + col] = f2bf(r); } };
struct SEpiFFN1 { bf16* h; DI float pre(int, int) const { return 0.f; } DI void operator()(int row, int col, float v, float) const { const float a = fmaxf(v, 0.f); h[row * FF + col] = f2bf(a * a); } };
struct SEpiInC { float* uv; DI float pre(int, int) const { return 0.f; } DI void operator()(int row, int col, float v, float) const { uv[row * 2048 + col] = gelu_tanh(v); } };

#define XB_TMO      128
#define XB_XCNT(j)  (256  + 64 * (j))
#define XB_XSUB(j)  (1280 + 64 * (j))
#define XB_XGEN(j)  (2304 + 64 * (j))
#define XB_TOP      3328
#define XB_TOPGEN   3392
#define XCD_BAR_WORDS 3456
#define XB_SPIN_CAP (1u << 18)
__device__ __forceinline__ unsigned xb_ld(unsigned* p)              { return __hip_atomic_load(p, __ATOMIC_RELAXED, __HIP_MEMORY_SCOPE_AGENT); }
__device__ __forceinline__ unsigned xb_add(unsigned* p, unsigned v) { return __hip_atomic_fetch_add(p, v, __ATOMIC_RELAXED, __HIP_MEMORY_SCOPE_AGENT); }
__device__ __forceinline__ unsigned xb_xcc_id() { return (unsigned)__builtin_amdgcn_s_getreg((3 << 11) | 20) & 0xFu; }
#define XB_SPIN(cond, bar) do { unsigned _sp = 0; while (cond) { __builtin_amdgcn_s_sleep(1); \
    if ((++_sp & 255u) == 0u) { if (xb_ld(&(bar)[XB_TMO])) break; if (_sp > XB_SPIN_CAP) { atomicAdd(&(bar)[XB_TMO], 1u); break; } } } } while (0)
struct XcdBarrier { unsigned* bar; unsigned x; volatile LAS unsigned* st; };
__device__ __forceinline__ XcdBarrier xcd_barrier_post(unsigned* bar, volatile LAS unsigned* st) {
    XcdBarrier b; b.bar = bar; b.x = xb_xcc_id(); b.st = st;
    if (threadIdx.x == 0) (void)xb_add(&bar[XB_XCNT(b.x)], 1u);
    return b;
}
__device__ __forceinline__ void xcd_barrier_complete(unsigned* bar, unsigned x, unsigned& nloc, unsigned& nx) {
    const unsigned G = gridDim.x * gridDim.y * gridDim.z;
    unsigned sum, cnt, mine, sp = 0u;
    for (;;) {
        sum = 0u; cnt = 0u; mine = 0u;
#pragma unroll
        for (unsigned j = 0; j < 16; ++j) { const unsigned c = xb_ld(&bar[XB_XCNT(j)]); sum += c; cnt += (c > 0u) ? 1u : 0u; mine = (j == x) ? c : mine; }
        if (sum == G) break;
        __builtin_amdgcn_s_sleep(1);
        if ((++sp & 255u) == 0u) { if (xb_ld(&bar[XB_TMO])) break; if (sp > XB_SPIN_CAP) { atomicAdd(&bar[XB_TMO], 1u); break; } }
    }
    nloc = mine > 0u ? mine : 1u; nx = cnt > 0u ? cnt : 1u;
}
__device__ __forceinline__ void xcd_barrier(const XcdBarrier& b) {
    asm volatile("s_waitcnt vmcnt(0)" ::: "memory");
    __syncthreads();
    if (threadIdx.x == 0) {
        unsigned* bar = b.bar;
        __builtin_amdgcn_s_waitcnt(0);
        unsigned nloc = b.st[0], nx = b.st[1];
        if (nloc == 0u) { xcd_barrier_complete(bar, b.x, nloc, nx); b.st[0] = nloc; b.st[1] = nx; }
        const unsigned old = xb_add(&bar[XB_XSUB(b.x)], 1u);
        const unsigned gen = old / nloc;
        if (old + 1u == (gen + 1u) * nloc) {
            __builtin_amdgcn_fence(__ATOMIC_RELEASE, "agent");
            asm volatile("s_waitcnt vmcnt(0)" ::: "memory");
            const unsigned og = xb_add(&bar[XB_TOP], 1u);
            const unsigned tg = og / nx;
            if (og + 1u == (tg + 1u) * nx) xb_add(&bar[XB_TOPGEN], 1u);
            else XB_SPIN(xb_ld(&bar[XB_TOPGEN]) == tg, bar);
            __builtin_amdgcn_fence(__ATOMIC_ACQUIRE, "agent");
            xb_add(&bar[XB_XGEN(b.x)], 1u);
            asm volatile("s_waitcnt vmcnt(0)" ::: "memory");
        } else {
            XB_SPIN(xb_ld(&bar[XB_XGEN(b.x)]) == gen, bar);
            __builtin_amdgcn_fence(__ATOMIC_ACQUIRE, "agent");
            asm volatile("s_waitcnt vmcnt(0)" ::: "memory");
        }
    }
    __syncthreads();
}

template <int MODE = 0>
DI void transpose_item(const float* W, int K, int N, bf16* WT, const float* gain, float* scr, int item, int nblk, int lane) {
    const int kb = item / nblk, nb = item % nblk, k0 = 64 * kb, n0 = 64 * nb;
    const int kr = lane >> 4, nc = (lane & 15) * 4; const bool ok = (n0 + nc) < N;
    f32x4 v[16];
#pragma unroll
    for (int i = 0; i < 16; ++i) v[i] = ok ? *(const f32x4*)(W + (size_t)(k0 + 4 * i + kr) * N + n0 + nc) : (f32x4){0.f, 0.f, 0.f, 0.f};
#pragma unroll
    for (int i = 0; i < 16; ++i) { const int kk = 4 * i + kr; f32x4 x = v[i]; if (gain) x = x * gain[k0 + kk]; *(f32x4*)(scr + kk * 68 + nc) = x; }
    asm volatile("s_waitcnt lgkmcnt(0)" ::: "memory");
    const int c = lane & 7;
#pragma unroll
    for (int j = 0; j < 8; ++j) { const int nn = (lane >> 3) + 8 * j; const float* s = scr + (8 * c) * 68 + nn;
        u32x4 o; o.x = pk2(s[0 * 68], s[1 * 68]); o.y = pk2(s[2 * 68], s[3 * 68]); o.z = pk2(s[4 * 68], s[5 * 68]); o.w = pk2(s[6 * 68], s[7 * 68]);
        if (MODE == 1) { const int n_ = n0 + nn, k8 = k0 + 8 * c; *(u32x4*)(WT + ((((size_t)(n_ >> 4) * (K >> 5) + (k8 >> 5)) * 4 + ((k8 >> 3) & 3)) * 16 + (n_ & 15)) * 8) = o; }
        else if (MODE == 2) { const int n_ = n0 + nn, p_ = (n_ & ~31) + inv_perm32(n_ & 31); *(u32x4*)(WT + tiled_off(p_, k0 + 8 * c, K)) = o; }
        else *(u32x4*)(WT + (size_t)(n0 + nn) * K + k0 + 8 * c) = o; }
    asm volatile("s_waitcnt lgkmcnt(0)" ::: "memory");
}

struct Args { const void* in[25]; float* out; unsigned char* ws; int ph_lo, ph_hi; };
struct Ptrs {
    const float *x_prompt, *x_sample, *cache_cmp, *cache_sel, *state_win, *state_hgrn; const int* page_table;
    const float *norm_mix, *norm_ffn, *norm_final, *w_in_ab, *w_out_ab, *hgrn_lb, *hgrn_norm, *cmp_pe, *cmp_w1, *cmp_w2, *w_in_c, *ln_c_g, *ln_c_b, *w_s, *b_s, *w_out_c, *w_ffn1, *w_ffn2;
    float* out; unsigned char* ws;
};
typedef const __attribute__((address_space(4))) Args* KArgs;
DI Ptrs get_ptrs() {
    KArgs a = (KArgs)__builtin_amdgcn_kernarg_segment_ptr(); asm volatile("" : "+s"(a));
    Ptrs P;
    P.x_prompt = (const float*)a->in[0]; P.x_sample = (const float*)a->in[1]; P.cache_cmp = (const float*)a->in[2]; P.cache_sel = (const float*)a->in[3];
    P.state_win = (const float*)a->in[4]; P.state_hgrn = (const float*)a->in[5]; P.page_table = (const int*)a->in[6];
    P.norm_mix = (const float*)a->in[7]; P.norm_ffn = (const float*)a->in[8]; P.norm_final = (const float*)a->in[9]; P.w_in_ab = (const float*)a->in[10]; P.w_out_ab = (const float*)a->in[11];
    P.hgrn_lb = (const float*)a->in[12]; P.hgrn_norm = (const float*)a->in[13]; P.cmp_pe = (const float*)a->in[14]; P.cmp_w1 = (const float*)a->in[15]; P.cmp_w2 = (const float*)a->in[16];
    P.w_in_c = (const float*)a->in[17]; P.ln_c_g = (const float*)a->in[18]; P.ln_c_b = (const float*)a->in[19]; P.w_s = (const float*)a->in[20]; P.b_s = (const float*)a->in[21];
    P.w_out_c = (const float*)a->in[22]; P.w_ffn1 = (const float*)a->in[23]; P.w_ffn2 = (const float*)a->in[24]; P.out = a->out; P.ws = a->ws;
    return P;
}

DI unsigned* ctl_words() { return (unsigned*)(get_ptrs().ws + WS_CTL); }
DI void prologue(unsigned char* lds, int bid, int G) {
    const Ptrs P = get_ptrs();
    const int tid = otid(), wave = tid >> 6, lane = tid & 63;
    float* scr = (float*)lds + wave * (64 * 68);
    const int gw = bid * 8 + wave, NGW = G * 8;
    unsigned char* ws = P.ws;
    for (int t = bid; t < 128; t += G) {
        const int q = t >> 5, part = t & 31;
        float* part_l = (float*)lds + 8 * 64 * 68;
        const float* pe = P.cmp_pe + (size_t)q * 2048 + part * 64 + wave * 8; const float* w1 = P.cmp_w1 + ((size_t)q * 2048 + part * 64 + wave * 8) * 128;
        float a0 = 0.f, a1 = 0.f;
#pragma unroll
        for (int f = 0; f < 8; ++f) { const float p = pe[f]; a0 += p * w1[(size_t)f * 128 + lane]; a1 += p * w1[(size_t)f * 128 + 64 + lane]; }
        part_l[wave * 128 + lane] = a0; part_l[wave * 128 + 64 + lane] = a1;
        __syncthreads();
        if (tid < 128) { float s = 0.f; for (int w = 0; w < 8; ++w) s += part_l[w * 128 + tid]; ((float*)(ws + WS_SMALL + 8192))[(size_t)t * 128 + tid] = s; }
        publish_count(980 + q);
    }
    constexpr int I_INAB = 16 * 56, I_OUTAB = 16 * 16, I_INC = 16 * 32, I_OUTC = 16 * 16, I_F1 = 16 * 64, I_F2 = 64 * 16, I_C1 = 32 * 2, I_C2 = 2 * 1;
    constexpr int NITEMS = 2 * (I_INAB + I_OUTAB + I_INC + I_OUTC) + 4 * (I_F1 + I_F2) + 4 * I_C1;
    for (int it = gw; it < NITEMS; it += NGW) {
        int r = it;
        if (r < 4 * I_F1) { const int l = r / I_F1; transpose_item<2>(P.w_ffn1 + (size_t)l * D * FF, D, FF, (bf16*)(ws + WS_WF1) + (size_t)l * FF * D, P.norm_ffn + l * D, scr, r % I_F1, 64, lane); continue; } r -= 4 * I_F1;
        if (r < 4 * I_F2) { const int l = r / I_F2; transpose_item<2>(P.w_ffn2 + (size_t)l * FF * D, FF, D, (bf16*)(ws + WS_WF2) + (size_t)l * D * FF, nullptr, scr, r % I_F2, 16, lane); continue; } r -= 4 * I_F2;
        if (r < 2 * I_INAB) { const int j = r / I_INAB; transpose_item<2>(P.w_in_ab + (size_t)j * D * ABC, D, ABC, (bf16*)(ws + WS_WINAB) + (size_t)j * ABP * D, P.norm_mix + (2 * j) * D, scr, r % I_INAB, 56, lane); continue; } r -= 2 * I_INAB;
        if (r < 2 * I_OUTAB) { const int j = r / I_OUTAB; transpose_item<2>(P.w_out_ab + (size_t)j * D * D, D, D, (bf16*)(ws + WS_WOUTAB) + (size_t)j * D * D, nullptr, scr, r % I_OUTAB, 16, lane); continue; } r -= 2 * I_OUTAB;
        if (r < 2 * I_INC) { const int j = r / I_INC; transpose_item<2>(P.w_in_c + (size_t)j * D * 2048, D, 2048, (bf16*)(ws + WS_WINC) + (size_t)j * 2048 * D, P.norm_mix + (2 * j + 1) * D, scr, r % I_INC, 32, lane); continue; } r -= 2 * I_INC;
        if (r < 2 * I_OUTC) { const int j = r / I_OUTC; transpose_item<2>(P.w_out_c + (size_t)j * D * D, D, D, (bf16*)(ws + WS_WOUTC) + (size_t)j * D * D, nullptr, scr, r % I_OUTC, 16, lane); continue; } r -= 2 * I_OUTC;
        { const int q = r / I_C1; transpose_item<1>(P.cmp_w1 + (size_t)q * 2048 * 128, 2048, 128, (bf16*)(ws + WS_WC1) + (size_t)q * 128 * 2048, nullptr, scr, r % I_C1, 2, lane); }
    }
    for (int r = (G - 1 - bid) * 8 + wave; r < 4 * I_C2; r += NGW) { const int q = r / I_C2; transpose_item(P.cmp_w2 + (size_t)q * 128 * 64, 128, 64, (bf16*)(ws + WS_WC2) + (size_t)q * 64 * 128, nullptr, scr, r % I_C2, 1, lane); }
    {
        bf16* hb = (bf16*)(ws + WS_HB); float* ssq = (float*)(ws + WS_SSQ);
        for (int m0 = gw; m0 < MP; m0 += 4 * NGW) {
            f32x4 xv[4][4];
#pragma unroll
            for (int r = 0; r < 4; ++r) { const int m = m0 + r * NGW; if (m < MP) { const f32x4* xr = (const f32x4*)(P.x_prompt + (size_t)m * D) + lane;
#pragma unroll
                for (int j = 0; j < 4; ++j) xv[r][j] = xr[64 * j]; } }
#pragma unroll
            for (int r = 0; r < 4; ++r) { const int m = m0 + r * NGW; if (m < MP) { float s = 0.f; u64* o8 = (u64*)(hb + (size_t)m * D) + lane;
#pragma unroll
                for (int j = 0; j < 4; ++j) { const f32x4 v = xv[r][j]; s += (v.x * v.x + v.y * v.y) + (v.z * v.z + v.w * v.w); o8[64 * j] = (u64)pk2(v.x, v.y) | ((u64)pk2(v.z, v.w) << 32); }
                s = wave_sum(s);
                if (lane < 16) ssq[(size_t)m * 16 + lane] = (lane == 0) ? s : 0.f; } }
        }
    }
    { float* hs = (float*)(ws + WS_SMP + SMP_HS); bf16* hsb = (bf16*)(ws + WS_SMP + SMP_HSB); for (int i = bid * 512 + tid; i < DB * D; i += G * 512) { const float v = P.x_sample[i]; hs[i] = v; hsb[i] = f2bf(v); } }
    { float* lbs = (float*)(ws + WS_SMALL);
      for (int i = bid * 512 + tid; i < 512; i += G * 512) { const float a = P.hgrn_lb[i], b = P.hgrn_lb[512 + i], mx = fmaxf(a, b), ea = __expf(a - mx), eb = __expf(b - mx); lbs[i] = 0.f; lbs[512 + i] = eb / (ea + eb); } }
    { bf16* tr = (bf16*)(ws + WS_TRIL);
      for (int i = bid * 512 + tid; i < 2 * 8 * 128 * 128; i += G * 512) { const int s = i & 127, t = (i >> 7) & 127; tr[i] = (s <= t) ? f2bf(P.w_s[i]) : (bf16)0; } }
    {
        float* cb = (float*)(ws + WS_SMALL + 4096);
        for (int q = G - 2 - bid; q >= 0 && q < 4; q += G) {
            wait_count(980 + q, 32u);
            if (tid < 128) { const float* cbp = (const float*)(ws + WS_SMALL + 8192) + (size_t)q * 32 * 128 + tid; float s = 0.f;
#pragma unroll 8
                for (int p = 0; p < 32; ++p) s += __builtin_nontemporal_load(cbp + p * 128);
                cb[q * 128 + tid] = s; }
        }
    }
}

#ifndef CU_VAR
#define CU_VAR 0
#endif
template <bool SAMPLE>
DI void compress_unit(unsigned char* lds, int j, int b, int ub, int ncmp, int L, int kv_lo, int kv_hi) {
    const Ptrs P = get_ptrs();
    const int tid = otid(), wave = tid >> 6, lane = tid & 63, r16 = lane & 15, quad = lane >> 4;
    unsigned char* rowsL = lds; bf16* hid = (bf16*)(lds + 135168);
    int* pg = (int*)(lds + 135168 + 17408);
    const bf16* w1t = (const bf16*)(P.ws + WS_WC1) + (size_t)j * 2 * 128 * 2048; const bf16* w2t = (const bf16*)(P.ws + WS_WC2) + (size_t)j * 2 * 64 * 128;
    const float* cb = (const float*)(P.ws + WS_SMALL + 4096) + j * 256;
    const int n0 = ub * 32, row0 = n0 * 16;
    if (SAMPLE) { if (tid < 5) { const int pi = (row0 >> 7) + tid; pg[tid] = (pi < NPAGES) ? P.page_table[b * NPAGES + pi] : 0; } __syncthreads(); }
    for (int kv = kv_lo; kv < kv_hi; ++kv) {
        for (int rp_ = 0; rp_ < ((CU_VAR == 1 && SAMPLE) ? 2 : 1); ++rp_) {
            asm volatile("" ::: "memory");
            f32x4 fa[17], fc[17]; u32x4 w[17];
#pragma unroll
            for (int u = 0; u < 17; ++u) { const int idx = u * 512 + tid, row = idx >> 4, ch = idx & 15, sr = row0 + row; const bool ok = (u < 16 || tid < 256) && (sr < L);
                if (SAMPLE) { const float* src = P.cache_cmp + (((size_t)j * NPOOL + (ok ? pg[row >> 7] : 0)) * 128 + (sr & 127)) * 256 + kv * 128 + ch * 8;
                    fa[u] = ok ? *(const f32x4*)src : (f32x4){0.f, 0.f, 0.f, 0.f}; fc[u] = ok ? *(const f32x4*)(src + 4) : (f32x4){0.f, 0.f, 0.f, 0.f};
                } else w[u] = ok ? *(const u32x4*)((const bf16*)(P.ws + WS_ZB) + ((size_t)b * SEQ + sr) * ABP + C_CMP + kv * 128 + ch * 8) : (u32x4){0u, 0u, 0u, 0u}; }
#pragma unroll
            for (int u = 0; u < 17; ++u) { const int idx = u * 512 + tid, row = idx >> 4, ch = idx & 15;
                if (SAMPLE) { w[u].x = pk2(fa[u].x, fa[u].y); w[u].y = pk2(fa[u].z, fa[u].w); w[u].z = pk2(fc[u].x, fc[u].y); w[u].w = pk2(fc[u].z, fc[u].w); }
                if (u < 16 || tid < 256) *(u32x4*)(rowsL + row * 256 + ((ch ^ ((row >> 4) & 15)) << 4)) = w[u]; }
        }
        __syncthreads();
        bf16x8 w2f[4][2];
#pragma unroll
        for (int ks = 0; ks < 4; ++ks)
#pragma unroll
            for (int x = 0; x < 2; ++x) w2f[ks][x] = *(const bf16x8*)(w2t + ((size_t)kv * 64 + ((wave & 1) * 2 + x) * 16 + r16) * 128 + ks * 32 + quad * 8);
        const float cbv = cb[kv * 128 + wave * 16 + r16];
        f32x4 acc[2][2];
        for (int rp_ = 0; rp_ < ((CU_VAR == 2 && SAMPLE) ? 2 : 1); ++rp_) {
        asm volatile("" ::: "memory");
#pragma unroll
        for (int g = 0; g < 2; ++g) { acc[g][0] = (f32x4){0.f, 0.f, 0.f, 0.f}; acc[g][1] = (f32x4){0.f, 0.f, 0.f, 0.f}; }
        const bf16* wp = w1t + (size_t)kv * 128 * 2048 + (size_t)wave * 64 * 512 + lane * 8;
        bf16x8 bq[4][8];
#pragma unroll
        for (int pb_ = 0; pb_ < 3; ++pb_)
#pragma unroll
            for (int u = 0; u < 8; ++u) bq[pb_][u] = *(const bf16x8*)(wp + (pb_ * 8 + u) * 512);
#pragma unroll
        for (int bt8 = 0; bt8 < 8; ++bt8) {
            if (bt8 + 3 < 8) {
#pragma unroll
                for (int u = 0; u < 8; ++u) bq[(bt8 + 3) & 3][u] = *(const bf16x8*)(wp + ((bt8 + 3) * 8 + u) * 512); }
#pragma unroll
            for (int u = 0; u < 8; ++u) { const int ks = bt8 * 8 + u, r = ks >> 1, c0 = (ks & 1) * 4 + quad, sw = (r16 + (r >> 4)) & 15;
#pragma unroll
                for (int bt = 0; bt < 2; ++bt) { const int row = 256 * bt + 16 * r16 + r;
#pragma unroll
                    for (int g = 0; g < 2; ++g) { const bf16x8 a = *(const bf16x8*)(rowsL + row * 256 + (((g * 8 + c0) ^ sw) << 4)); acc[g][bt] = MFMA16(a, bq[bt8 & 3][u], acc[g][bt]); } } }
        }
        asm volatile("" : "+v"(acc[0][0]), "+v"(acc[0][1]), "+v"(acc[1][0]), "+v"(acc[1][1]));
        }
#pragma unroll
        for (int g = 0; g < 2; ++g)
#pragma unroll
            for (int bt = 0; bt < 2; ++bt)
#pragma unroll
                for (int i = 0; i < 4; ++i) { const int h = wave * 16 + r16; hid[(g * 32 + bt * 16 + quad * 4 + i) * 136 + h] = f2bf(gelu_tanh(acc[g][bt][i] + cbv)); }
        __syncthreads();
        { const int rt = wave >> 1, g2 = rt >> 1; f32x4 a2[2] = {{0.f, 0.f, 0.f, 0.f}, {0.f, 0.f, 0.f, 0.f}};
#pragma unroll
          for (int ks = 0; ks < 4; ++ks) { const bf16x8 a = *(const bf16x8*)(hid + (rt * 16 + r16) * 136 + ks * 32 + quad * 8);
#pragma unroll
              for (int x = 0; x < 2; ++x) a2[x] = MFMA16(a, w2f[ks][x], a2[x]); }
#pragma unroll
          for (int x = 0; x < 2; ++x)
#pragma unroll
              for (int i = 0; i < 4; ++i) { const int n = n0 + (rt & 1) * 16 + quad * 4 + i, d = ((wave & 1) * 2 + x) * 16 + r16;
                  if (n < ncmp) { if (SAMPLE) ((float*)(P.ws + WS_KCS))[(((size_t)b * 512 + n) * 4 + kv * 2 + g2) * 64 + d] = a2[x][i];
                                  else ((bf16*)(P.ws + WS_KCP))[(((size_t)b * 256 + n) * 4 + kv * 2 + g2) * 64 + d] = f2bf(a2[x][i]); } }
        }
        __syncthreads();
    }
}

DI void hgrn_p1_unit(unsigned char* lds, int j, int b, int c, int h) {
    const Ptrs P = get_ptrs();
    const int tid = otid(), wave = tid >> 6, lane = tid & 63, r16 = lane & 15, quad = lane >> 4;
    float* bl = (float*)lds; float* kk = bl + 8192; bf16* Vr = (bf16*)(lds + 65536); bf16* KD = Vr + 64 * 144; float* tot = (float*)(lds + 65536 + 2 * 64 * 144 * 2);
    const bf16* zb = (const bf16*)(P.ws + WS_ZB) + ((size_t)b * SEQ + c * 64) * ABP; const float* lb = (const float*)(P.ws + WS_SMALL) + j * 512 + h * 128;
    const int unit = (b * 4 + h) * 64 + c;
    u32x4 f8[2], v8[2];
#pragma unroll
    for (int u = 0; u < 2; ++u) { const int idx = tid + 512 * u, t = idx >> 4, ch = idx & 15; f8[u] = *(const u32x4*)(zb + (size_t)t * ABP + C_F + h * 128 + ch * 8); v8[u] = *(const u32x4*)(zb + (size_t)t * ABP + C_I + h * 128 + ch * 8); }
#pragma unroll
    for (int u = 0; u < 2; ++u) { const int idx = tid + 512 * u, t = idx >> 4, ch = idx & 15;
#pragma unroll
        for (int i = 0; i < 4; ++i) { const unsigned fw = f8[u][i]; const int d = ch * 8 + 2 * i;
            { const float lbv = lb[d], fg = lbv + (1.f - lbv) * sigmoidf_(bflo(fw)); bl[t * 128 + d] = __logf(fg); kk[t * 128 + d] = 1.f - fg; }
            { const float lbv = lb[d + 1], fg = lbv + (1.f - lbv) * sigmoidf_(bfhi(fw)); bl[t * 128 + d + 1] = __logf(fg); kk[t * 128 + d + 1] = 1.f - fg; } }
        *(u32x4*)(Vr + t * 144 + ch * 8) = v8[u]; }
    __syncthreads();
    { const int seg = tid >> 7, d = tid & 127; float run = 0.f;
#pragma unroll
      for (int i = 0; i < 16; ++i) { run += bl[(seg * 16 + i) * 128 + d]; bl[(seg * 16 + i) * 128 + d] = run; }
      tot[seg * 128 + d] = run; }
    __syncthreads();
    for (int idx = tid; idx < 4096; idx += 512) { const int t = idx >> 6, d = (idx & 63) * 2, seg = t >> 4; float e0 = 0.f, e1 = 0.f;
        e0 = tot[seg * 128 + d] - bl[t * 128 + d]; e1 = tot[seg * 128 + d + 1] - bl[t * 128 + d + 1];
        for (int s = seg + 1; s < 4; ++s) { e0 += tot[s * 128 + d]; e1 += tot[s * 128 + d + 1]; }
        *(unsigned*)(KD + t * 144 + d) = pk2(kk[t * 128 + d] * __expf(e0), kk[t * 128 + d + 1] * __expf(e1)); }
    if (tid < 128) ((float*)(P.ws + WS_DL))[(size_t)unit * 128 + tid] = __expf((tot[tid] + tot[128 + tid]) + (tot[256 + tid] + tot[384 + tid]));
    __syncthreads();
    f32x4 acc[8];
#pragma unroll
    for (int nt = 0; nt < 8; ++nt) acc[nt] = (f32x4){0.f, 0.f, 0.f, 0.f};
#pragma unroll
    for (int ks = 0; ks < 2; ++ks) { const bf16x8 a = tr_frag(Vr, 144, ks * 32, wave * 16, r16, quad);
#pragma unroll
        for (int nt = 0; nt < 8; ++nt) { const bf16x8 bb = tr_frag(KD, 144, ks * 32, nt * 16, r16, quad); acc[nt] = MFMA16(a, bb, acc[nt]); } }
    float* LT = (float*)(P.ws + WS_LT) + (size_t)unit * 16384;
#pragma unroll
    for (int nt = 0; nt < 8; ++nt)
#pragma unroll
        for (int i = 0; i < 4; ++i) LT[(wave * 16 + quad * 4 + i) * 128 + nt * 16 + r16] = acc[nt][i];
    __syncthreads();
}
DI void hgrn_scan_item(int j, int item) {
    const Ptrs P = get_ptrs();
    float* LT = (float*)(P.ws + WS_LT); const float* DL = (const float*)(P.ws + WS_DL);
    { const int gi = item * 512 + otid();
        const int bh = gi >> 12, q4 = gi & 4095, e = q4 >> 5, d4 = (q4 & 31) * 4;
        float* p = LT + (size_t)bh * 64 * 16384 + q4 * 4; const float* dp = DL + (size_t)bh * 64 * 128 + d4;
        f32x4 S = {0.f, 0.f, 0.f, 0.f};
        for (int c0 = 0; c0 < 64; c0 += 16) {
            f32x4 Lv[16], dv[16];
#pragma unroll
            for (int u = 0; u < 16; ++u) { Lv[u] = *(const f32x4*)(p + (size_t)(c0 + u) * 16384); dv[u] = *(const f32x4*)(dp + (c0 + u) * 128); }
#pragma unroll
            for (int u = 0; u < 16; ++u) { *(f32x4*)(p + (size_t)(c0 + u) * 16384) = S; S = dv[u] * S + Lv[u]; }
        }
        float* o = P.out + O_HG_P + ((size_t)j * 16 + bh) * 16384;
#pragma unroll
        for (int i = 0; i < 4; ++i) o[(d4 + i) * 128 + e] = S[i];
    }
    asm volatile("s_waitcnt vmcnt(0)" ::: "memory");
    __syncthreads();
    if (threadIdx.x == 0) { __builtin_amdgcn_fence(__ATOMIC_RELEASE, "agent"); asm volatile("s_waitcnt vmcnt(0)" ::: "memory");
        __hip_atomic_fetch_add((unsigned*)(P.ws + WS_CTL) + 4096 + 64 * (120 + j), 1u, __ATOMIC_RELAXED, __HIP_MEMORY_SCOPE_AGENT); }
}
DI void scan_wait(int j) {
    const Ptrs P = get_ptrs();
    if (threadIdx.x == 0) { unsigned* c = (unsigned*)(P.ws + WS_CTL) + 4096 + 64 * (120 + j); unsigned sp = 0;
        while (__hip_atomic_load(c, __ATOMIC_RELAXED, __HIP_MEMORY_SCOPE_AGENT) < 128u) { __builtin_amdgcn_s_sleep(2); if (++sp > (1u << 22)) break; }
        __builtin_amdgcn_fence(__ATOMIC_ACQUIRE, "agent"); asm volatile("s_waitcnt vmcnt(0)" ::: "memory"); }
    __syncthreads();
}
DI void hgrn_p3_unit(unsigned char* lds, int j, int b, int c, int h) {
    const Ptrs P = get_ptrs();
    const int tid = otid(), wave = tid >> 6, lane = tid & 63, r16 = lane & 15, quad = lane >> 4;
    float* bl = (float*)lds; unsigned char* Sb = lds;
    bf16* Qt = (bf16*)(lds + 32768); bf16* Qh = Qt + 64 * 136; bf16* Kt = Qh + 64 * 136; bf16* Vr = Kt + 160 * 136; bf16* att = Vr + 64 * 144; float* tot = (float*)(att + 64 * 72);
    float* obuf = (float*)Kt;
    const bf16* zb = (const bf16*)(P.ws + WS_ZB) + ((size_t)b * SEQ + c * 64) * ABP; const float* lb = (const float*)(P.ws + WS_SMALL) + j * 512 + h * 128;
    const int unit = (b * 4 + h) * 64 + c;
    u32x4 f8[2], v8[2], q8[2];
#pragma unroll
    for (int u = 0; u < 2; ++u) { const int idx = tid + 512 * u, t = idx >> 4, ch = idx & 15; const bf16* zr = zb + (size_t)t * ABP + h * 128 + ch * 8;
        f8[u] = *(const u32x4*)(zr + C_F); v8[u] = *(const u32x4*)(zr + C_I); q8[u] = *(const u32x4*)(zr + C_Q); }
    f32x4 sa[4], sc4[4];
    { const float* St = (const float*)(P.ws + WS_LT) + (size_t)unit * 16384;
#pragma unroll
      for (int u = 0; u < 4; ++u) { const int idx = tid + 512 * u, e = idx >> 4, ch = idx & 15; sa[u] = *(const f32x4*)(St + e * 128 + ch * 8); sc4[u] = *(const f32x4*)(St + e * 128 + ch * 8 + 4); } }
#pragma unroll
    for (int u = 0; u < 2; ++u) { const int idx = tid + 512 * u, t = idx >> 4, ch = idx & 15;
#pragma unroll
        for (int i = 0; i < 4; ++i) { const unsigned fw = f8[u][i]; const int d = ch * 8 + 2 * i;
            { const float lbv = lb[d]; bl[t * 128 + d] = __logf(lbv + (1.f - lbv) * sigmoidf_(bflo(fw))); }
            { const float lbv = lb[d + 1]; bl[t * 128 + d + 1] = __logf(lbv + (1.f - lbv) * sigmoidf_(bfhi(fw))); } }
        *(u32x4*)(Vr + t * 144 + ch * 8) = v8[u]; }
    __syncthreads();
    { const int seg = tid >> 7, d = tid & 127; float run = 0.f;
#pragma unroll
      for (int i = 0; i < 16; ++i) { run += bl[(seg * 16 + i) * 128 + d]; bl[(seg * 16 + i) * 128 + d] = run; }
      tot[seg * 128 + d] = run; }
    __syncthreads();
#pragma unroll
    for (int u = 0; u < 2; ++u) { const int idx = tid + 512 * u, t = idx >> 4, ch = idx & 15, I = t >> 4;
        u32x4 wqt, wqh; float kv_[8], ex[8], pre[8];
#pragma unroll
        for (int i = 0; i < 8; ++i) { const int d = ch * 8 + i; float p = 0.f; for (int s = 0; s < I; ++s) p += tot[s * 128 + d]; pre[i] = p; }
#pragma unroll
        for (int i = 0; i < 4; ++i) {
            const int d = ch * 8 + 2 * i; const float q0 = siluf_(bflo(q8[u][i])), q1 = siluf_(bfhi(q8[u][i]));
            const float b0 = bl[t * 128 + d], b1 = bl[t * 128 + d + 1], e0 = __expf(b0), e1 = __expf(b1);
            wqt[i] = pk2(q0 * e0, q1 * e1); wqh[i] = pk2(q0 * e0 * __expf(pre[2 * i]), q1 * e1 * __expf(pre[2 * i + 1]));
            const float l0 = lb[d], l1 = lb[d + 1];
            kv_[2 * i] = 1.f - (l0 + (1.f - l0) * sigmoidf_(bflo(f8[u][i]))); kv_[2 * i + 1] = 1.f - (l1 + (1.f - l1) * sigmoidf_(bfhi(f8[u][i]))); ex[2 * i] = -b0; ex[2 * i + 1] = -b1;
        }
        *(u32x4*)(Qt + t * 136 + ch * 8) = wqt; *(u32x4*)(Qh + t * 136 + ch * 8) = wqh;
        for (int I2 = I; I2 < 4; ++I2) {
            u32x4 wk;
#pragma unroll
            for (int i = 0; i < 4; ++i) wk[i] = pk2(kv_[2 * i] * __expf(ex[2 * i]), kv_[2 * i + 1] * __expf(ex[2 * i + 1]));
            *(u32x4*)(Kt + (8 * I2 * (I2 + 1) + t) * 136 + ch * 8) = wk;
#pragma unroll
            for (int i = 0; i < 8; ++i) ex[i] += tot[I2 * 128 + ch * 8 + i];
        }
    }
    __syncthreads();
    {
#pragma unroll
      for (int u = 0; u < 4; ++u) { const int idx = tid + 512 * u, e = idx >> 4, ch = idx & 15;
          u32x4 w; w.x = pk2(sa[u].x, sa[u].y); w.y = pk2(sa[u].z, sa[u].w); w.z = pk2(sc4[u].x, sc4[u].y); w.w = pk2(sc4[u].z, sc4[u].w); *(u32x4*)(Sb + e * 256 + ((ch ^ (e & 15)) << 4)) = w; } }
    { const int I = wave >> 1;
#pragma unroll
      for (int jj = 0; jj < 2; ++jj) { const int J = 2 * (wave & 1) + jj; f32x4 a4 = {0.f, 0.f, 0.f, 0.f};
          if (J <= I) {
#pragma unroll
              for (int ks = 0; ks < 4; ++ks) { const bf16x8 a = *(const bf16x8*)(Qt + (16 * I + r16) * 136 + ks * 32 + quad * 8);
                  const bf16x8 bb = *(const bf16x8*)(Kt + (8 * I * (I + 1) + 16 * J + r16) * 136 + ks * 32 + quad * 8); a4 = MFMA16(a, bb, a4); } }
#pragma unroll
          for (int i = 0; i < 4; ++i) { const int t = 16 * I + quad * 4 + i, s = 16 * J + r16; att[t * 72 + s] = (s <= t) ? f2bf(a4[i]) : (bf16)0; } } }
    __syncthreads();
    unsigned gw[8]; float h0, h1;
    { const float* hn = P.hgrn_norm + j * 128; h0 = hn[2 * lane]; h1 = hn[2 * lane + 1];
#pragma unroll
      for (int i = 0; i < 8; ++i) gw[i] = *(const unsigned*)(zb + (size_t)(wave * 8 + i) * ABP + C_G + h * 128 + 2 * lane); }
    { const int I = wave >> 1; f32x4 acc[4];
#pragma unroll
      for (int x = 0; x < 4; ++x) acc[x] = (f32x4){0.f, 0.f, 0.f, 0.f};
#pragma unroll
      for (int ks = 0; ks < 4; ++ks) { const bf16x8 a = *(const bf16x8*)(Qh + (16 * I + r16) * 136 + ks * 32 + quad * 8);
#pragma unroll
          for (int x = 0; x < 4; ++x) { const int e = ((wave & 1) * 4 + x) * 16 + r16; const bf16x8 bb = *(const bf16x8*)(Sb + e * 256 + (((ks * 4 + quad) ^ (e & 15)) << 4)); acc[x] = MFMA16(a, bb, acc[x]); } }
      const int nks = (I >= 2) ? 2 : 1;
      for (int ks = 0; ks < nks; ++ks) { const bf16x8 a = *(const bf16x8*)(att + (16 * I + r16) * 72 + ks * 32 + quad * 8);
#pragma unroll
          for (int x = 0; x < 4; ++x) { const bf16x8 bb = tr_frag(Vr, 144, ks * 32, ((wave & 1) * 4 + x) * 16, r16, quad); acc[x] = MFMA16(a, bb, acc[x]); } }
#pragma unroll
      for (int x = 0; x < 4; ++x)
#pragma unroll
          for (int i = 0; i < 4; ++i) obuf[(16 * I + quad * 4 + i) * 132 + ((wave & 1) * 4 + x) * 16 + r16] = acc[x][i];
    }
    __syncthreads();
    { bf16* oc = (bf16*)(P.ws + WS_OC) + ((size_t)b * SEQ + c * 64) * D + h * 128;
#pragma unroll
      for (int i = 0; i < 8; ++i) { const int t = wave * 8 + i; const f32x2 v = *(const f32x2*)(obuf + t * 132 + 2 * lane); const float ss = wave_sum(v.x * v.x + v.y * v.y), rs = rsqrtf(ss * (1.f / 128.f) + EPS);
          *(unsigned*)(oc + (size_t)t * D + 2 * lane) = pk2(v.x * rs * h0 * siluf_(bflo(gw[i])), v.y * rs * h1 * siluf_(bfhi(gw[i]))); } }
    __syncthreads();
}

DI float ex2(float x) { return __builtin_amdgcn_exp2f(x); }
DI void attn_fetch(u32x4& k8, u32x4& v8, const bf16* kbase, const bf16* vbase, size_t stride, int nvalid, int tid) {
    const int key = tid >> 3, ch = tid & 7; k8 = (u32x4){0u, 0u, 0u, 0u}; v8 = k8;
    if (key < nvalid) { k8 = *(const u32x4*)(kbase + (size_t)key * stride + ch * 8); v8 = *(const u32x4*)(vbase + (size_t)key * stride + ch * 8); }
}
DI void attn_put(bf16* Ks, const u32x4& k8, const u32x4& v8, int tid) {
    const int key = tid >> 3, ch = tid & 7; *(u32x4*)(Ks + key * 72 + ch * 8) = k8; *(u32x4*)(Ks + 64 * 72 + key * 72 + ch * 8) = v8;
}
DI void attn_qk(f32x4 (&s)[4][2], const bf16* Ks, const bf16x8 (&qf)[2][2], int r16, int quad, bool en0, bool en1) {
    if (en0 && en1) {
        bf16x8 kf[4][2];
#pragma unroll
        for (int kt = 0; kt < 4; ++kt)
#pragma unroll
            for (int ks = 0; ks < 2; ++ks) kf[kt][ks] = *(const bf16x8*)(Ks + (kt * 16 + r16) * 72 + ks * 32 + quad * 8);
#pragma unroll
        for (int kt = 0; kt < 4; ++kt) {
            s[kt][0] = MFMA16(kf[kt][0], qf[0][0], ((f32x4){0.f, 0.f, 0.f, 0.f})); s[kt][1] = MFMA16(kf[kt][0], qf[1][0], ((f32x4){0.f, 0.f, 0.f, 0.f}));
            s[kt][0] = MFMA16(kf[kt][1], qf[0][1], s[kt][0]); s[kt][1] = MFMA16(kf[kt][1], qf[1][1], s[kt][1]);
        }
    } else {
#pragma unroll
        for (int qt = 0; qt < 2; ++qt) {
            if (qt ? en1 : en0) {
#pragma unroll
                for (int kt = 0; kt < 4; ++kt) {
                    s[kt][qt] = (f32x4){0.f, 0.f, 0.f, 0.f};
#pragma unroll
                    for (int ks = 0; ks < 2; ++ks) { const bf16x8 a = *(const bf16x8*)(Ks + (kt * 16 + r16) * 72 + ks * 32 + quad * 8); s[kt][qt] = MFMA16(a, qf[qt][ks], s[kt][qt]); }
                }
            }
        }
    }
}
DI void attn_pv(f32x4 (&o)[4][2], const bf16* Vs, const bf16x8 (&pb)[2][2], int r16, int quad, bool en0, bool en1) {
    const bf16* vb = Vs + (quad * 4 + (r16 >> 2)) * 72 + (r16 & 3) * 4;
    if (en0 && en1) {
        s16x4 vf[4][2][2];
#pragma unroll
        for (int dt = 0; dt < 4; ++dt)
#pragma unroll
            for (int kk = 0; kk < 2; ++kk) { vf[dt][kk][0] = vtr(vb + (2 * kk) * 16 * 72 + dt * 16); vf[dt][kk][1] = vtr(vb + (2 * kk + 1) * 16 * 72 + dt * 16); }
#pragma unroll
        for (int dt = 0; dt < 4; ++dt)
#pragma unroll
            for (int kk = 0; kk < 2; ++kk) {
                const bf16x8 a = __builtin_shufflevector(vf[dt][kk][0], vf[dt][kk][1], 0, 1, 2, 3, 4, 5, 6, 7);
                o[dt][0] = MFMA16(a, pb[kk][0], o[dt][0]); o[dt][1] = MFMA16(a, pb[kk][1], o[dt][1]);
            }
    } else {
#pragma unroll
        for (int qt = 0; qt < 2; ++qt) {
            if (qt ? en1 : en0) {
#pragma unroll
                for (int dt = 0; dt < 4; ++dt)
#pragma unroll
                    for (int kk = 0; kk < 2; ++kk) {
                        const s16x4 lo = vtr(vb + (2 * kk) * 16 * 72 + dt * 16), hi = vtr(vb + (2 * kk + 1) * 16 * 72 + dt * 16);
                        const bf16x8 a = __builtin_shufflevector(lo, hi, 0, 1, 2, 3, 4, 5, 6, 7);
                        o[dt][qt] = MFMA16(a, pb[kk][qt], o[dt][qt]);
                    }
            }
        }
    }
}
template <int MODE>
DI void attn_branch(bf16* KV, const unsigned char* tl, int n, const bf16* zb, const bf16* kc, int g, int qi, int tid, int wave, int r16, int quad,
                    const bf16x8 (&qf)[2][2], const int (&tpos)[2], f32x4 (&o)[4][2], float (&m)[2], float (&l)[2], const u64 (&mk)[2], const u64 (&wq)[2], float* impA, float* impB) {
    const int q0 = qi * 64, rh = (r16 >> 2) & 3;
    u32x4 k8, v8;
#define AB_FETCH(i_) do { const int jb_ = tl[i_]; if (MODE <= 1) attn_fetch(k8, v8, kc + (size_t)jb_ * 64 * 256, kc + (size_t)jb_ * 64 * 256 + 128, 256, 255 - jb_ * 64, tid); \
        else { const int co_ = (MODE == 2) ? C_WIN : C_SEL; attn_fetch(k8, v8, zb + (size_t)jb_ * 64 * ABP + co_ + g * 64, zb + (size_t)jb_ * 64 * ABP + co_ + 128 + g * 64, ABP, 64, tid); } } while (0)
    if (n <= 0) return;
    AB_FETCH(0); attn_put(KV, k8, v8, tid);
    if (n > 1) AB_FETCH(1);
    __syncthreads();
    for (int i = 0; i < n; ++i) {
        bf16* Ks = KV + (i & 1) * (128 * 72);
        if (i + 1 < n) attn_put(KV + ((i + 1) & 1) * (128 * 72), k8, v8, tid);
        if (i + 2 < n) AB_FETCH(i + 2);
        const int jb = tl[i];
        bool en0 = true, en1 = true;
        if (MODE == 3) { en0 = (wq[0] >> jb) & 1ull; en1 = (wq[1] >> jb) & 1ull; }
        if (en0 || en1) {
            f32x4 s[4][2];
            attn_qk(s, Ks, qf, r16, quad, en0, en1);
            bool partial;
            if (MODE <= 1) partial = !(16 * (jb * 64 + 63) + 31 <= q0);
            else if (MODE == 2) partial = (jb == qi) || (jb + 8 == qi);
            else partial = (jb == qi);
            bf16x8 pb[2][2];
#pragma unroll
            for (int qt = 0; qt < 2; ++qt) {
                if (!(qt ? en1 : en0)) continue;
                if (partial) {
#pragma unroll
                    for (int kt = 0; kt < 4; ++kt)
#pragma unroll
                        for (int i2 = 0; i2 < 4; ++i2) { const int kp = jb * 64 + kt * 16 + quad * 4 + i2; bool ok;
                            if (MODE <= 1) ok = (16 * kp + 31 <= tpos[qt]); else if (MODE == 2) { const int dd = tpos[qt] - kp; ok = (dd >= 0 && dd < 512); } else ok = (kp <= tpos[qt]);
                            s[kt][qt][i2] = ok ? s[kt][qt][i2] : -INFINITY; }
                }
                if (MODE == 1) {
                    const float mu = m[qt], il = (l[qt] > 0.f) ? 1.f / l[qt] : 0.f; const int tokl = 8 * wave + 4 * qt + (r16 & 3);
#pragma unroll
                    for (int kt = 0; kt < 4; ++kt) {
#pragma unroll
                        for (int i2 = 0; i2 < 4; ++i2) s[kt][qt][i2] = ex2(s[kt][qt][i2] - mu) * il;
                        float v = (s[kt][qt][0] + s[kt][qt][1]) + (s[kt][qt][2] + s[kt][qt][3]), v3 = s[kt][qt][3];
                        v += __shfl_xor(v, 4); v += __shfl_xor(v, 8); v3 += __shfl_xor(v3, 4); v3 += __shfl_xor(v3, 8);
                        if (rh == 0) { const int c = jb * 16 + kt * 4 + quad; impA[tokl * 65 + c] = v; if (c + 1 < 64) impB[tokl * 65 + c + 1] = v3; }
                    }
                } else {
                    const bool lsel = (MODE == 3) ? ((mk[qt] >> jb) & 1ull) : true;
                    float mx = fmax3(s[0][qt][0], s[0][qt][1], s[0][qt][2]);
                    mx = fmax3(mx, s[0][qt][3], s[1][qt][0]); mx = fmax3(mx, s[1][qt][1], s[1][qt][2]); mx = fmax3(mx, s[1][qt][3], s[2][qt][0]); mx = fmax3(mx, s[2][qt][1], s[2][qt][2]);
                    mx = fmax3(mx, s[2][qt][3], s[3][qt][0]); mx = fmax3(mx, s[3][qt][1], s[3][qt][2]); mx = fmax2(mx, s[3][qt][3]);
                    if (MODE == 3) mx = lsel ? mx : -INFINITY;
                    mx = quad_max(mx);
                    const bool slow = (m[qt] != 0.f) || (mx > 8.f) || (l[qt] == 0.f && mx < -8.f && mx > -INFINITY);
                    f32x2 r2 = {0.f, 0.f};
                    if (__any(slow)) {
                        const bool fresh = (l[qt] == 0.f);
                        const float mn = (mx == -INFINITY) ? m[qt] : (fresh ? mx : fmax2(m[qt], mx)), alpha = fresh ? 1.f : ex2(m[qt] - mn);
#pragma unroll
                        for (int kt = 0; kt < 4; ++kt) {
#pragma unroll
                            for (int i2 = 0; i2 < 4; ++i2) s[kt][qt][i2] = ex2(s[kt][qt][i2] - mn);
                            r2 += (f32x2){s[kt][qt][0], s[kt][qt][1]}; r2 += (f32x2){s[kt][qt][2], s[kt][qt][3]}; }
                        float rs = r2.x + r2.y; if (MODE == 3) rs = lsel ? rs : 0.f;
                        l[qt] = l[qt] * alpha + quad_sum(rs); m[qt] = mn;
                        if (MODE != 0) {
#pragma unroll
                            for (int dt = 0; dt < 4; ++dt) o[dt][qt] = o[dt][qt] * alpha; }
                    } else {
#pragma unroll
                        for (int kt = 0; kt < 4; ++kt) {
#pragma unroll
                            for (int i2 = 0; i2 < 4; ++i2) s[kt][qt][i2] = ex2(s[kt][qt][i2]);
                            r2 += (f32x2){s[kt][qt][0], s[kt][qt][1]}; r2 += (f32x2){s[kt][qt][2], s[kt][qt][3]}; }
                        float rs = r2.x + r2.y; if (MODE == 3) rs = lsel ? rs : 0.f;
                        l[qt] += quad_sum(rs);
                    }
                }
                if (MODE != 0) {
#pragma unroll
                    for (int kk = 0; kk < 2; ++kk) { pb[kk][qt] = pack8(s[2 * kk][qt], s[2 * kk + 1][qt]);
                        if (MODE == 3) { const bool lsel = (mk[qt] >> jb) & 1ull; const bf16x8 z = {0, 0, 0, 0, 0, 0, 0, 0}; pb[kk][qt] = lsel ? pb[kk][qt] : z; } }
                }
            }
            if (MODE != 0) attn_pv(o, Ks + 64 * 72, pb, r16, quad, en0, en1);
        }
        __syncthreads();
    }
#undef AB_FETCH
}
DI void attn_unit(unsigned char* lds, int b, int g, int qi) {
    const Ptrs P = get_ptrs();
    const int tid = otid(), wave = tid >> 6, lane = tid & 63, r16 = lane & 15, quad = lane >> 4;
    bf16* Qs = (bf16*)lds; bf16* KV = (bf16*)(lds + 36864);
    float* impA = (float*)(lds + 73728); float* impB = impA + 64 * 65; u64* msk = (u64*)(lds + 107008);
    unsigned char* tl = lds + 107584;
    f32x4* obLo = (f32x4*)lds + tid; f32x4* obHi = (f32x4*)(lds + 73728) + tid;
    const bf16* zb = (const bf16*)(P.ws + WS_ZB) + (size_t)b * SEQ * ABP; const int q0 = qi * 64;
    const bf16* kc = (const bf16*)(P.ws + WS_KCP) + (size_t)b * 256 * 256 + g * 64;
    const int ntc = ((q0 + 32) >> 4) / 64 + 1;
    for (int idx = tid; idx < 2048; idx += 512) { const int tok = idx >> 5, r = (idx >> 3) & 3, ch = idx & 7; const float qs = 0.18033688011112042f;
        const u32x4 q8 = *(const u32x4*)(zb + (size_t)(q0 + tok) * ABP + C_QB + (g * 4 + r) * 64 + ch * 8); u32x4 w;
#pragma unroll
        for (int i = 0; i < 4; ++i) w[i] = pk2(bflo(q8[i]) * qs, bfhi(q8[i]) * qs);
        *(u32x4*)(Qs + (tok * 4 + r) * 72 + ch * 8) = w; }
    for (int idx = tid; idx < 2 * 64 * 65; idx += 512) impA[idx] = 0.f;
    if (tid < 4) tl[tid] = (unsigned char)tid;
    __syncthreads();
    bf16x8 qf[2][2]; int tpos[2]; float gate[2][3];
    const int rh = (r16 >> 2) & 3;
#pragma unroll
    for (int qt = 0; qt < 2; ++qt) { const int tokl = 8 * wave + 4 * qt + (r16 & 3); tpos[qt] = q0 + tokl;
#pragma unroll
        for (int ks = 0; ks < 2; ++ks) qf[qt][ks] = *(const bf16x8*)(Qs + (tokl * 4 + rh) * 72 + ks * 32 + quad * 8);
#pragma unroll
        for (int br = 0; br < 3; ++br) gate[qt][br] = sigmoidf_(bf2f(zb[(size_t)tpos[qt] * ABP + C_GATE + (g * 4 + rh) * 3 + br])); }
    f32x4 o[4][2]; float m[2], l[2]; u64 mk[2] = {0ull, 0ull}, wq[2] = {0ull, 0ull};
    m[0] = m[1] = 0.f; l[0] = l[1] = 0.f;
#pragma unroll
    for (int dt = 0; dt < 4; ++dt) { o[dt][0] = (f32x4){0.f, 0.f, 0.f, 0.f}; o[dt][1] = (f32x4){0.f, 0.f, 0.f, 0.f}; }
    attn_branch<0>(KV, tl, ntc, zb, kc, g, qi, tid, wave, r16, quad, qf, tpos, o, m, l, mk, wq, impA, impB);
    attn_branch<1>(KV, tl, ntc, zb, kc, g, qi, tid, wave, r16, quad, qf, tpos, o, m, l, mk, wq, impA, impB);
    {
        const int tok = tid >> 3, sub = tid & 7, cur = qi; u64 mkk;
        if (cur < 16) mkk = (1ull << (cur + 1)) - 1ull;
        else {
            float v[8]; unsigned taken = 0u;
#pragma unroll
            for (int i = 0; i < 8; ++i) { const int jb = sub + 8 * i; v[i] = (jb >= 1 && jb <= cur - 2) ? impA[tok * 65 + jb] + impB[tok * 65 + jb] : -INFINITY; }
            for (int it = 0; it < 13; ++it) {
                float bv = -INFINITY; int bi = 64;
#pragma unroll
                for (int i = 0; i < 8; ++i) { const bool c = !((taken >> i) & 1u) && v[i] > bv; bv = c ? v[i] : bv; bi = c ? sub + 8 * i : bi; }
#pragma unroll
                for (int o_ = 1; o_ < 8; o_ <<= 1) { const float ov = __shfl_xor(bv, o_); const int oi = __shfl_xor(bi, o_); const bool c = ov > bv || (ov == bv && oi < bi); bv = c ? ov : bv; bi = c ? oi : bi; }
                if ((bi & 7) == sub && bi < 64) taken |= 1u << (bi >> 3);
            }
            unsigned lo = 0u, hi = 0u;
#pragma unroll
            for (int i = 0; i < 8; ++i) if ((taken >> i) & 1u) { const int jb = sub + 8 * i; if (jb < 32) lo |= 1u << jb; else hi |= 1u << (jb - 32); }
#pragma unroll
            for (int o_ = 1; o_ < 8; o_ <<= 1) { lo |= __shfl_xor(lo, o_); hi |= __shfl_xor(hi, o_); }
            mkk = (((u64)hi << 32) | lo) | 1ull | (1ull << cur) | (1ull << (cur - 1));
        }
        if (sub == 0) msk[tok] = mkk;
        unsigned ul = (unsigned)mkk, uh = (unsigned)(mkk >> 32);
#pragma unroll
        for (int o_ = 8; o_ < 64; o_ <<= 1) { ul |= __shfl_xor(ul, o_); uh |= __shfl_xor(uh, o_); }
        if (lane == 0) msk[64 + wave] = ((u64)uh << 32) | ul;
    }
    __syncthreads();
#pragma unroll
    for (int qt = 0; qt < 2; ++qt) { obLo[(0 * 2 + qt) * 512] = o[0][qt] * gate[qt][0]; obLo[(1 * 2 + qt) * 512] = o[1][qt] * gate[qt][0]; }
    u64 uni = 0;
    {
#pragma unroll
      for (int t = 0; t < 8; ++t) uni |= msk[64 + t];
      uni &= (qi == 63) ? ~0ull : ((1ull << (qi + 1)) - 1ull);
#pragma unroll
      for (int qt = 0; qt < 2; ++qt) { mk[qt] = msk[8 * wave + 4 * qt + (r16 & 3)]; u64 w_ = 0; for (int t = 0; t < 4; ++t) w_ |= msk[8 * wave + 4 * qt + t];
          wq[qt] = ((u64)__builtin_amdgcn_readfirstlane((unsigned)(w_ >> 32)) << 32) | (unsigned)__builtin_amdgcn_readfirstlane((unsigned)w_); } }
    __syncthreads();
#pragma unroll
    for (int qt = 0; qt < 2; ++qt) { obHi[(0 * 2 + qt) * 512] = o[2][qt] * gate[qt][0]; obHi[(1 * 2 + qt) * 512] = o[3][qt] * gate[qt][0]; }
    const int jw0 = (qi > 8 ? qi - 8 : 0), nw = qi - jw0 + 1;
    if (tid < nw) tl[tid] = (unsigned char)(jw0 + tid);
    __syncthreads();
    m[0] = m[1] = 0.f; l[0] = l[1] = 0.f;
#pragma unroll
    for (int dt = 0; dt < 4; ++dt) { o[dt][0] = (f32x4){0.f, 0.f, 0.f, 0.f}; o[dt][1] = (f32x4){0.f, 0.f, 0.f, 0.f}; }
    attn_branch<2>(KV, tl, nw, zb, kc, g, qi, tid, wave, r16, quad, qf, tpos, o, m, l, mk, wq, impA, impB);
#pragma unroll
    for (int qt = 0; qt < 2; ++qt) { const float sc = gate[qt][2] / fmaxf(l[qt], 1e-30f);
        obLo[(0 * 2 + qt) * 512] += o[0][qt] * sc; obLo[(1 * 2 + qt) * 512] += o[1][qt] * sc; obHi[(0 * 2 + qt) * 512] += o[2][qt] * sc; obHi[(1 * 2 + qt) * 512] += o[3][qt] * sc; }
    if (tid < 64) ((u64*)(P.ws + WS_MSK))[(size_t)(b * 2 + g) * SEQ + q0 + tid] = msk[tid];
    { bf16* oc = (bf16*)(P.ws + WS_OC) + (size_t)b * SEQ * D;
#pragma unroll
      for (int qt = 0; qt < 2; ++qt)
#pragma unroll
          for (int dt = 0; dt < 4; ++dt) { const f32x4 acc = (dt < 2) ? obLo[(dt * 2 + qt) * 512] : obHi[((dt - 2) * 2 + qt) * 512];
              u32x2 w; w.x = pk2(acc[0], acc[1]); w.y = pk2(acc[2], acc[3]);
              *(u32x2*)(oc + (size_t)tpos[qt] * D + 512 + (g * 4 + rh) * 64 + dt * 16 + quad * 4) = w; } }
    __syncthreads();
}

namespace selb {
typedef unsigned short bf16;
using bf16x8=__attribute__((ext_vector_type(8)))short;
using s16x4=__attribute__((ext_vector_type(4)))short;
using f32x16=__attribute__((ext_vector_type(16)))float;
using u32x4=__attribute__((ext_vector_type(4)))unsigned;
constexpr int D=64,PQ=3584,PO=1024;
constexpr int NW=8,QBLK=32,QB=QBLK*NW,KVBLK=64;
__device__ __forceinline__ int crow(int r,int hi){return (r&3)+8*(r>>2)+4*hi;}
#define SBAR() __builtin_amdgcn_sched_barrier(0)
__device__ __forceinline__ void cmask(f32x16&p0,f32x16&p1,int jb,int qrel,int hi){
  const float NEG=-INFINITY; int kb=64*jb+4*hi;
  #pragma unroll
  for(int r=0;r<16;++r){int kv=kb+(r&3)+8*(r>>2); if(kv>qrel)p0[r]=NEG; if(kv+32>qrel)p1[r]=NEG;}
}

constexpr int NSLOT=3, SLOTB=8192;
constexpr int LDS_K=0, LDS_V=NSLOT*SLOTB, LDS_WS=2*NSLOT*SLOTB, LDS_OST=LDS_WS+NW*64*4, LDS_BYTES=LDS_OST+NW*4096;
constexpr float C2=0.125f*1.4426950408889634f;
__device__ __forceinline__ void glds16(const void*gsrc,unsigned lds_dst){unsigned keep;
  asm volatile("s_mov_b32 %0, m0\n\ts_mov_b32 m0, %2\n\ts_nop 0\n\tglobal_load_lds_dwordx4 %1, off\n\ts_mov_b32 m0, %0":"=&s"(keep):"v"(gsrc),"s"(lds_dst):"memory");}
__device__ __forceinline__ float max3f(float a,float b,float c){float r;asm("v_max3_f32 %0, %1, %2, %3":"=v"(r):"v"(a),"v"(b),"v"(c));return r;}
__device__ __forceinline__ float max2f(float a,float b){float r;asm("v_max_f32_e32 %0, %1, %2":"=v"(r):"v"(a),"v"(b));return r;}
__device__ __forceinline__ float fadd_s(float a,float b){float r;asm("v_add_f32_e32 %0, %1, %2":"=v"(r):"v"(a),"v"(b));return r;}
__device__ __forceinline__ float fsub_s(float a,float b){float r;asm("v_sub_f32_e32 %0, %1, %2":"=v"(r):"v"(a),"v"(b));return r;}
typedef float f32x2_t __attribute__((ext_vector_type(2))); typedef __bf16 bf16x2_t __attribute__((ext_vector_type(2)));
__device__ __forceinline__ unsigned cvtpk_s(float lo,float hi){f32x2_t v={lo,hi};bf16x2_t b=__builtin_convertvector(v,bf16x2_t);return __builtin_bit_cast(unsigned,b);}
#define WAIT_BAR(N) asm volatile("s_waitcnt vmcnt(" #N ") lgkmcnt(0)\n\ts_barrier":::"memory")

__device__ __forceinline__ void qkt(f32x16&p0,f32x16&p1,const char*Kslot,const bf16x8*qr,const f32x16&negm,int r32,int hi){
  const char*kb=Kslot+hi*1024+r32*16;
  #pragma unroll
  for(int d0=0;d0<4;++d0){
    const bf16x8 b0=*reinterpret_cast<const bf16x8*>(kb+d0*2048);
    const bf16x8 b1=*reinterpret_cast<const bf16x8*>(kb+d0*2048+512);
    if(d0==0){p0=__builtin_amdgcn_mfma_f32_32x32x16_bf16(b0,qr[0],negm,0,0,0);p1=__builtin_amdgcn_mfma_f32_32x32x16_bf16(b1,qr[0],negm,0,0,0);}
    else{p0=__builtin_amdgcn_mfma_f32_32x32x16_bf16(b0,qr[d0],p0,0,0,0);p1=__builtin_amdgcn_mfma_f32_32x32x16_bf16(b1,qr[d0],p1,0,0,0);}}
}
typedef __attribute__((address_space(3))) const char* lds_cptr;
typedef short v4i16_t __attribute__((ext_vector_type(4)));
__device__ __forceinline__ void kload8(bf16x8*kf,lds_cptr kp){
  kf[0]=*(const __attribute__((address_space(3))) bf16x8*)(kp);      kf[1]=*(const __attribute__((address_space(3))) bf16x8*)(kp+512);
  kf[2]=*(const __attribute__((address_space(3))) bf16x8*)(kp+2048); kf[3]=*(const __attribute__((address_space(3))) bf16x8*)(kp+2560);
  kf[4]=*(const __attribute__((address_space(3))) bf16x8*)(kp+4096); kf[5]=*(const __attribute__((address_space(3))) bf16x8*)(kp+4608);
  kf[6]=*(const __attribute__((address_space(3))) bf16x8*)(kp+6144); kf[7]=*(const __attribute__((address_space(3))) bf16x8*)(kp+6656);
}
__device__ __forceinline__ void kload2(bf16x8*kf,lds_cptr kp,int j){ kf[2*j]=*(const __attribute__((address_space(3))) bf16x8*)(kp+j*2048); kf[2*j+1]=*(const __attribute__((address_space(3))) bf16x8*)(kp+j*2048+512); }
__device__ __forceinline__ s16x4 vtr(lds_cptr p){ return __builtin_bit_cast(s16x4,__builtin_amdgcn_ds_read_tr16_b64_v4i16((__attribute__((address_space(3))) v4i16_t*)p)); }
__device__ __forceinline__ float rowmax(const f32x16&p0,const f32x16&p1){
  float a=max3f(p0[0],p0[1],p1[0]),b=max3f(p0[2],p0[3],p1[1]);a=max3f(a,p1[2],p1[3]);
  #pragma unroll
  for(int r=4;r<16;r+=4){a=max3f(a,p0[r],p0[r+1]);b=max3f(b,p0[r+2],p0[r+3]);a=max3f(a,p1[r],p1[r+1]);b=max3f(b,p1[r+2],p1[r+3]);}
  const float m=max2f(a,b);
  auto rr=__builtin_amdgcn_permlane32_swap(__float_as_uint(m),__float_as_uint(m),false,false);
  return max2f(__uint_as_float(rr[0]),__uint_as_float(rr[1]));
}
__device__ __forceinline__ void pv(f32x16*o,int vb,bf16x8 pa0,bf16x8 pa1,bf16x8 pa2,bf16x8 pa3){
  #pragma unroll
  for(int d0=0;d0<2;++d0){s16x4 lo[4],hi[4];
    #pragma unroll
    for(int ks=0;ks<4;++ks){
      asm volatile("ds_read_b64_tr_b16 %0,%1 offset:%c2":"=&v"(lo[ks]):"v"(vb),"i"(d0*4096+ks*1024):"memory");
      asm volatile("ds_read_b64_tr_b16 %0,%1 offset:%c2":"=&v"(hi[ks]):"v"(vb),"i"(d0*4096+ks*1024+512):"memory");}
    asm volatile("s_waitcnt lgkmcnt(0)":::"memory");SBAR();
    #define PK(k) (bf16x8){lo[k][0],lo[k][1],lo[k][2],lo[k][3],hi[k][0],hi[k][1],hi[k][2],hi[k][3]}
    o[d0]=__builtin_amdgcn_mfma_f32_32x32x16_bf16(pa0,PK(0),o[d0],0,0,0);
    o[d0]=__builtin_amdgcn_mfma_f32_32x32x16_bf16(pa1,PK(1),o[d0],0,0,0);
    o[d0]=__builtin_amdgcn_mfma_f32_32x32x16_bf16(pa2,PK(2),o[d0],0,0,0);
    o[d0]=__builtin_amdgcn_mfma_f32_32x32x16_bf16(pa3,PK(3),o[d0],0,0,0);
    #undef PK
  }
}

template<int THRL> __device__ __forceinline__ void sel_unit(int qb,const bf16*Qh,const bf16*__restrict__ Kh,const bf16*__restrict__ Vh,bf16*Oh,const unsigned long long*mrow,const bf16*gz,char*shm){
  const int tid=otid(),lane=tid&63,r32=lane&31,hi=lane>>5; const int wid=__builtin_amdgcn_readfirstlane(tid>>6);
  const int q0=qb*QB;
  const bf16*Qw=Qh+(long)(q0+wid*QBLK)*PQ;
  const unsigned lds0=(unsigned)(uintptr_t)shm;
  float*wsf=(float*)(shm+LDS_WS)+wid*64;
  const bf16*ksrc=Kh+(long)lane*PQ+wid*8;
  const bf16*vsrc=Vh+(long)(16*(wid&3)+(lane>>2))*PQ+(wid>>2)*32+(lane&3)*8;
  const unsigned kdst=lds0+LDS_K+wid*1024, vdst=lds0+LDS_V+wid*1024;
  #define DMA_K(t,slot) glds16(ksrc+(long)(t)*KVBLK*PQ,(unsigned)__builtin_amdgcn_readfirstlane(kdst+(slot)))
  #define DMA_V(t,slot) glds16(vsrc+(long)(t)*KVBLK*PQ,(unsigned)__builtin_amdgcn_readfirstlane(vdst+(slot)))
  const int vb0=(int)(lds0+LDS_V)+((lane>>4)&1)*32+(lane&3)*8+(4*hi+((lane&15)>>2))*64;
  const char*Kbase=shm+LDS_K; bf16x8 kf[8];
  const lds_cptr shm3=(lds_cptr)shm; const lds_cptr kp0=shm3+LDS_K+hi*1024+r32*16; const lds_cptr vp0=shm3+LDS_V+((lane>>4)&1)*32+(lane&3)*8+(4*hi+((lane&15)>>2))*64;
  const int NT=(q0+QB)/KVBLK;
  DMA_K(0,0);DMA_V(0,0);DMA_K(1,SLOTB);
  bf16x8 qr[4];
  #pragma unroll
  for(int d0=0;d0<4;++d0){ const u32x4 q8=*reinterpret_cast<const u32x4*>(&Qw[(long)r32*PQ+d0*16+hi*8]); u32x4 w;
    _Pragma("unroll") for(int i=0;i<4;++i) w[i]=cvtpk_s(__uint_as_float(q8[i]<<16)*C2,__uint_as_float(q8[i]&0xffff0000u)*C2);
    qr[d0]=__builtin_bit_cast(bf16x8,w); }
  const unsigned long long mkl=mrow[q0+wid*QBLK+r32];
  const unsigned gzw=(unsigned)gz[(long)(q0+wid*QBLK+r32)*PQ];
  float mhat=0.f,l_reg=0.f;f32x16 o[2];o[0]=f32x16{};o[1]=f32x16{};f32x16 csel=f32x16{};
  const int qrel=wid*QBLK+r32;
  #define CMASK(P0,P1,t) do{int jb_=(t)-(NT-4); if(jb_>=0)cmask(P0,P1,jb_,qrel,hi);}while(0)
  bool resc=false;
  #define START(P0,P1) do{ const float rm=rowmax(P0,P1); resc=false; \
    { const float dl=rm; mhat=fadd_s(mhat,dl); \
      _Pragma("unroll") for(int r=0;r<16;++r){P0[r]=fsub_s(P0[r],dl);P1[r]=fsub_s(P1[r],dl);} \
      } \
    _Pragma("unroll") for(int r=0;r<16;++r)P0[r]=__builtin_amdgcn_exp2f(P0[r]); }while(0)
  #define RESC() do{ if(resc){ asm volatile("s_waitcnt lgkmcnt(0)":::"memory"); \
      _Pragma("unroll") for(int d_=0;d_<2;++d_) _Pragma("unroll") for(int r=0;r<16;++r)o[d_][r]*=wsf[crow(r,hi)]; } }while(0)
  f32x16 pA0,pA1,pB0,pB1;
  int sl_prev=0,sl_cur=0,sl_next=SLOTB;
  #define ROT() do{sl_prev=sl_cur;sl_cur=sl_next;sl_next=(sl_next==(NSLOT-1)*SLOTB)?0:sl_next+SLOTB;}while(0)
  DMA_K(2,2*SLOTB);
  WAIT_BAR(3);
  qkt(pA0,pA1,Kbase,qr,csel,r32,hi);asm volatile("s_nop 15\n\ts_nop 7":"+v"(pA0),"+v"(pA1));CMASK(pA0,pA1,0);
  START(pA0,pA1);
  _Pragma("unroll") for(int r=0;r<16;++r)pA1[r]=__builtin_amdgcn_exp2f(pA1[r]);
  WAIT_BAR(0);
  DMA_K(3,0);DMA_V(1,SLOTB);
  ROT();
  kload8(kf,kp0+sl_cur);
  WAIT_BAR(2);
  s16x4 vlo[8],vhi[8]; u32x4 pw0,pw1,pw2,pw3;
  #define PKW(P,B) cvtpk_s(P[B],P[B+1])
  #define PAF(k) __builtin_bit_cast(bf16x8,pw##k)
  #define VFR(i) (bf16x8){vlo[i][0],vlo[i][1],vlo[i][2],vlo[i][3],vhi[i][0],vhi[i][1],vhi[i][2],vhi[i][3]}
  #define PIN(x) asm volatile("":"+v"(x))
  #define MX3(a,b,c) __builtin_fmaxf(__builtin_fmaxf((a),(b)),(c))
  #define GAPA(MF,A0,A1,A2,A3,W0,W1,PW) do{ MF; sacc+=A0; sacc+=A1; sacc+=A2; sacc+=A3; PIN(sacc); W0; W1; PIN(PW); SBAR(); }while(0)
  #define EX(v) __builtin_amdgcn_exp2f(v)
  #define GAPB(MF,X,B) do{ MF; X[B]=EX(X[B]); X[B+1]=EX(X[B+1]); X[B+2]=EX(X[B+2]); X[B+3]=EX(X[B+3]); PIN(X); SBAR(); }while(0)
  #define VRD(i) do{ vlo[i]=vtr(vp_+(((i)>>2)*4096+((i)&3)*1024)); vhi[i]=vtr(vp_+(((i)>>2)*4096+((i)&3)*1024+512)); }while(0)
  #define KRD(G,j) do{ if(G){ kload2(kf,kp0+sl_next,j); SBAR(); } }while(0)
  #define STEP(C0,C1,P0,P1,t,GK,GV,GL) do{ SBAR(); \
    { const float cs_=((mkl>>(t))&1ull)?-mhat:-INFINITY; _Pragma("unroll") for(int r=0;r<16;++r)csel[r]=cs_; asm volatile("":"+v"(csel)); } SBAR(); \
    const lds_cptr vp_=vp0+sl_prev; \
    VRD(0); SBAR(); float sacc=(P0[0]+P0[1]); \
    GAPA(C0=__builtin_amdgcn_mfma_f32_32x32x16_bf16(kf[0],qr[0],csel,0,0,0), P0[2],P0[3],P0[4],P0[5],     pw0[0]=PKW(P0,0), pw0[1]=PKW(P0,2), pw0); \
    VRD(4); SBAR(); GAPA(C1=__builtin_amdgcn_mfma_f32_32x32x16_bf16(kf[1],qr[0],csel,0,0,0), P0[6],P0[7],P0[8],P0[9],     pw0[2]=PKW(P0,4), pw0[3]=PKW(P0,6), pw0); \
    VRD(1); SBAR(); GAPA(C0=__builtin_amdgcn_mfma_f32_32x32x16_bf16(kf[2],qr[1],C0,0,0,0),   P0[10],P0[11],P0[12],P0[13], pw1[0]=PKW(P0,8), pw1[1]=PKW(P0,10), pw1); \
    VRD(5); SBAR(); GAPA(C1=__builtin_amdgcn_mfma_f32_32x32x16_bf16(kf[3],qr[1],C1,0,0,0),   P0[14],P0[15],P1[0],P1[1],   pw1[2]=PKW(P0,12),pw1[3]=PKW(P0,14), pw1); \
    VRD(2); SBAR(); GAPA(C0=__builtin_amdgcn_mfma_f32_32x32x16_bf16(kf[4],qr[2],C0,0,0,0),   P1[2],P1[3],P1[4],P1[5],     pw2[0]=PKW(P1,0), pw2[1]=PKW(P1,2), pw2); \
    VRD(6); SBAR(); GAPA(C1=__builtin_amdgcn_mfma_f32_32x32x16_bf16(kf[5],qr[2],C1,0,0,0),   P1[6],P1[7],P1[8],P1[9],     pw2[2]=PKW(P1,4), pw2[3]=PKW(P1,6), pw2); \
    VRD(3); SBAR(); GAPA(C0=__builtin_amdgcn_mfma_f32_32x32x16_bf16(kf[6],qr[3],C0,0,0,0),   P1[10],P1[11],P1[12],P1[13], pw3[0]=PKW(P1,8), pw3[1]=PKW(P1,10), pw3); \
    VRD(7); SBAR(); GAPA(C1=__builtin_amdgcn_mfma_f32_32x32x16_bf16(kf[7],qr[3],C1,0,0,0),   P1[14],P1[15],0.f,0.f,       pw3[2]=PKW(P1,12),pw3[3]=PKW(P1,14), pw3); \
    l_reg+=sacc; \
    if(GK){DMA_K((t)+3,sl_cur);} if(GV){DMA_V((t)+1,sl_next);} \
    CMASK(C0,C1,t); \
    { float a=MX3(C0[0],C0[1],C1[0]),b=MX3(C0[2],C0[3],C1[1]); a=MX3(a,C1[2],C1[3]); \
      _Pragma("unroll") for(int r=4;r<16;r+=4){a=MX3(a,C0[r],C0[r+1]);b=MX3(b,C0[r+2],C0[r+3]);a=MX3(a,C1[r],C1[r+1]);b=MX3(b,C1[r+2],C1[r+3]);} \
      float rm=__builtin_fmaxf(a,b); { auto rr=__builtin_amdgcn_permlane32_swap(__float_as_uint(rm),__float_as_uint(rm),false,false); rm=__builtin_fmaxf(__uint_as_float(rr[0]),__uint_as_float(rr[1])); } \
      resc=false; \
      if(__builtin_expect(__any(rm>(float)THRL),0)){ const float dl=__builtin_fmaxf(rm,0.f); mhat+=dl; \
        _Pragma("unroll") for(int r=0;r<16;++r){C0[r]-=dl;C1[r]-=dl;} \
        const float f=__builtin_amdgcn_exp2f(-dl); l_reg*=f; if(hi==0)wsf[r32]=f; resc=true; } } \
    SBAR(); \
    GAPB(o[0]=__builtin_amdgcn_mfma_f32_32x32x16_bf16(PAF(0),VFR(0),o[0],0,0,0), C0,0); \
    GAPB(o[1]=__builtin_amdgcn_mfma_f32_32x32x16_bf16(PAF(0),VFR(4),o[1],0,0,0), C0,4); \
    KRD(GL,0); GAPB(o[0]=__builtin_amdgcn_mfma_f32_32x32x16_bf16(PAF(1),VFR(1),o[0],0,0,0), C0,8); \
    KRD(GL,1); GAPB(o[1]=__builtin_amdgcn_mfma_f32_32x32x16_bf16(PAF(1),VFR(5),o[1],0,0,0), C0,12); \
    KRD(GL,2); GAPB(o[0]=__builtin_amdgcn_mfma_f32_32x32x16_bf16(PAF(2),VFR(2),o[0],0,0,0), C1,0); \
    KRD(GL,3); GAPB(o[1]=__builtin_amdgcn_mfma_f32_32x32x16_bf16(PAF(2),VFR(6),o[1],0,0,0), C1,4); \
    GAPB(o[0]=__builtin_amdgcn_mfma_f32_32x32x16_bf16(PAF(3),VFR(3),o[0],0,0,0), C1,8); \
    GAPB(o[1]=__builtin_amdgcn_mfma_f32_32x32x16_bf16(PAF(3),VFR(7),o[1],0,0,0), C1,12); \
    }while(0)
  int t=1;
  #undef CMASK
  #define CMASK(P0,P1,t) do{}while(0)
  for(;t+5<NT;t+=2){
    STEP(pB0,pB1,pA0,pA1,t,true,true,true);     WAIT_BAR(2); RESC(); ROT();
    STEP(pA0,pA1,pB0,pB1,t+1,true,true,true);   WAIT_BAR(2); RESC(); ROT();
  }
  #undef CMASK
  #define CMASK(P0,P1,t) do{int jb_=(t)-(NT-4); if(jb_>=0)cmask(P0,P1,jb_,qrel,hi);}while(0)
  #define ENDW(tt) do{ if((tt)+3<NT){WAIT_BAR(2);} else if((tt)+2<NT){WAIT_BAR(1);} else {WAIT_BAR(0);} }while(0)
  for(;t+1<NT;t+=2){
    STEP(pB0,pB1,pA0,pA1,t,(t+3<NT),(t+1<NT),(t+1<NT));       ENDW(t);   RESC(); ROT();
    STEP(pA0,pA1,pB0,pB1,t+1,(t+4<NT),(t+2<NT),(t+2<NT));     ENDW(t+1); RESC(); ROT();
  }
  STEP(pB0,pB1,pA0,pA1,NT-1,false,false,false); RESC();
  { float sacc=pB0[0]+pB0[1]; _Pragma("unroll") for(int r=2;r<16;++r)sacc+=pB0[r]; _Pragma("unroll") for(int r=0;r<16;++r)sacc+=pB1[r]; l_reg+=sacc;
    pw0=(u32x4){PKW(pB0,0),PKW(pB0,2),PKW(pB0,4),PKW(pB0,6)};pw1=(u32x4){PKW(pB0,8),PKW(pB0,10),PKW(pB0,12),PKW(pB0,14)};pw2=(u32x4){PKW(pB1,0),PKW(pB1,2),PKW(pB1,4),PKW(pB1,6)};pw3=(u32x4){PKW(pB1,8),PKW(pB1,10),PKW(pB1,12),PKW(pB1,14)};
    SBAR(); pv(o,vb0+sl_cur,PAF(0),PAF(1),PAF(2),PAF(3)); }
  #undef PKW
  #undef PAF
  #undef VFR
  #undef PIN
  #undef MX3
  #undef GAPA
  #undef GAPB
  #undef EX
  #undef VRD
  #undef KRD
  #undef STEP
  #undef ENDW
  {auto rr=__builtin_amdgcn_permlane32_swap(__float_as_uint(l_reg),__float_as_uint(l_reg),false,false);l_reg=__uint_as_float(rr[0])+__uint_as_float(rr[1]);}
  { const float gl=__uint_as_float(gzw<<16); const float gate=__builtin_amdgcn_rcpf(1.f+__expf(-gl));
    if(hi==0)wsf[32+r32]=gate*__builtin_amdgcn_rcpf(fmaxf(l_reg,1e-30f)); }
  asm volatile("s_waitcnt lgkmcnt(0)":::"memory");
  float rli[16];
  #pragma unroll
  for(int r=0;r<16;++r)rli[r]=wsf[32+crow(r,hi)];
  bf16*Ow=Oh+(long)(q0+wid*QBLK)*PO;
  { bf16*stg=(bf16*)(shm+LDS_OST)+wid*2048;
    #pragma unroll
    for(int r=0;r<16;++r){const int orow=crow(r,hi);
      #pragma unroll
      for(int d0=0;d0<2;++d0)stg[orow*64+d0*32+r32]=(bf16)(cvtpk_s(o[d0][r]*rli[r],0.f)&0xffffu);}
    asm volatile("s_waitcnt lgkmcnt(0)":::"memory");
    #pragma unroll
    for(int i=0;i<4;++i){const int row=i*8+(lane>>3),ch=lane&7; const u32x4 v=*(const u32x4*)(stg+row*64+ch*8); bf16*dst=Ow+(long)row*PO+ch*8; const u32x4 p=*(const u32x4*)dst; u32x4 w;
      _Pragma("unroll") for(int e=0;e<4;++e) w[e]=cvtpk_s(__uint_as_float(v[e]<<16)+__uint_as_float(p[e]<<16),__uint_as_float(v[e]&0xffff0000u)+__uint_as_float(p[e]&0xffff0000u));
      *(u32x4*)dst=w;} }
  asm volatile("s_waitcnt lgkmcnt(0)\n\ts_barrier":::"memory");
  #undef DMA_K
  #undef DMA_V
  #undef CMASK
  #undef START
  #undef RESC
  #undef ROT
}
constexpr int SEL_LDS_BYTES=LDS_BYTES;
#undef SBAR
#undef WAIT_BAR
}

DI void sel_attn_unit(unsigned char* lds, int b, int hq, int qb) {
    const Ptrs P = get_ptrs();
    const int g = hq >> 2;
    const bf16* zb = (const bf16*)(P.ws + WS_ZB) + (size_t)b * SEQ * ABP;
    selb::sel_unit<8>(qb, zb + C_QB + hq * 64, zb + C_SEL + g * 64, zb + C_SEL + 128 + g * 64, (bf16*)(P.ws + WS_OC) + (size_t)b * SEQ * D + 512 + hq * 64,
                      (const u64*)(P.ws + WS_MSK) + (size_t)(b * 2 + g) * SEQ, zb + C_GATE + hq * 3 + 1, (char*)lds);
}

DI void mix_unit(unsigned char* lds, int jc, int chunk, int gq) {
    const Ptrs P = get_ptrs();
    const int tid = otid(), wave = tid >> 6, lane = tid & 63, r16 = lane & 15, quad = lane >> 4;
    bf16* Vr = (bf16*)lds; float* mu = (float*)(lds + 128 * 144 * 2); float* rsd = mu + 128;
    const size_t tok0 = (size_t)chunk * 128;
    const bf16* ub = (const bf16*)(P.ws + WS_ZB); const bf16* vb = ub + (size_t)MP * D; const float* vstat = (const float*)(P.ws + WS_VSTAT);
    u32x4 v8[4];
#pragma unroll
    for (int u = 0; u < 4; ++u) { const int idx = tid + 512 * u, s = idx >> 4, ch = idx & 15; v8[u] = *(const u32x4*)(vb + (tok0 + s) * D + gq * 128 + ch * 8); }
    const int t = wave * 16 + r16; u32x2 u4[8];
#pragma unroll
    for (int mt = 0; mt < 8; ++mt) u4[mt] = *(const u32x2*)(ub + (tok0 + t) * D + gq * 128 + mt * 16 + quad * 4);
    const bf16* wt = (const bf16*)(P.ws + WS_TRIL) + ((size_t)(jc * 8 + gq) * 128 + t) * 128 + quad * 8;
    bf16x8 bbw[4];
#pragma unroll
    for (int ks = 0; ks < 4; ++ks) bbw[ks] = *(const bf16x8*)(wt + ks * 32);
    const float bs = P.b_s[(jc * 8 + gq) * 128 + t];
    f32x4 lgv[2], lbv[2];
    { const f32x4* lg4 = (const f32x4*)(P.ln_c_g + jc * D + gq * 128 + (tid & 15) * 8); const f32x4* lb4 = (const f32x4*)(P.ln_c_b + jc * D + gq * 128 + (tid & 15) * 8);
      lgv[0] = lg4[0]; lgv[1] = lg4[1]; lbv[0] = lb4[0]; lbv[1] = lb4[1]; }
    if (tid < 128) { const f32x4* p = (const f32x4*)(vstat + (tok0 + tid) * 32); float s1 = 0.f, s2 = 0.f;
#pragma unroll
        for (int i = 0; i < 8; ++i) { const f32x4 v = p[i]; s1 += v.x + v.z; s2 += v.y + v.w; }
        const float mean = s1 * (1.f / 1024.f), var = fmaxf(s2 * (1.f / 1024.f) - mean * mean, 0.f); mu[tid] = mean; rsd[tid] = rsqrtf(var + EPS); }
    __syncthreads();
    {
#pragma unroll
      for (int u = 0; u < 4; ++u) { const int idx = tid + 512 * u, s = idx >> 4, ch = idx & 15; const float mm = mu[s], rr = rsd[s]; u32x4 w;
#pragma unroll
          for (int i = 0; i < 4; ++i) { const int c2 = 2 * i; w[i] = pk2((bflo(v8[u][i]) - mm) * rr * lgv[c2 >> 2][c2 & 3] + lbv[c2 >> 2][c2 & 3], (bfhi(v8[u][i]) - mm) * rr * lgv[(c2 + 1) >> 2][(c2 + 1) & 3] + lbv[(c2 + 1) >> 2][(c2 + 1) & 3]); }
          *(u32x4*)(Vr + s * 144 + ch * 8) = w; } }
    __syncthreads();
    f32x4 acc[8];
#pragma unroll
    for (int mt = 0; mt < 8; ++mt) acc[mt] = (f32x4){0.f, 0.f, 0.f, 0.f};
    const int nks = (wave >> 1) + 1;
#pragma unroll
    for (int ks = 0; ks < 4; ++ks) { if (ks < nks) {
#pragma unroll
        for (int mt = 0; mt < 8; ++mt) { const bf16x8 a = tr_frag(Vr, 144, ks * 32, mt * 16, r16, quad); acc[mt] = MFMA16(a, bbw[ks], acc[mt]); } } }
    { bf16* um = (bf16*)(P.ws + WS_OC);
#pragma unroll
      for (int mt = 0; mt < 8; ++mt) { const int c = gq * 128 + mt * 16 + quad * 4;
          u32x2 w; w.x = pk2(bflo(u4[mt].x) * (acc[mt][0] + bs), bfhi(u4[mt].x) * (acc[mt][1] + bs)); w.y = pk2(bflo(u4[mt].y) * (acc[mt][2] + bs), bfhi(u4[mt].y) * (acc[mt][3] + bs));
          *(u32x2*)(um + (tok0 + t) * D + c) = w; } }
    __syncthreads();
}

DI void hgrn_s_unit(unsigned char* lds, int j, int b, int h) {
    const Ptrs P = get_ptrs();
    const int tid = otid(); float* qq = (float*)lds; float* fg = qq + 128; float* kx = fg + 128; float* vv = kx + 128; float* part = vv + 128; float* sq = part + 16 * 128;
    const float* z = (const float*)(P.ws + WS_SMP + SMP_ZS) + (size_t)b * ABP; const float* lb = (const float*)(P.ws + WS_SMALL) + j * 512 + h * 128;
    if (tid < 128) { const float f = z[C_F + h * 128 + tid], lbv = lb[tid], fgv = lbv + (1.f - lbv) * sigmoidf_(f);
        qq[tid] = siluf_(z[C_Q + h * 128 + tid]); fg[tid] = fgv; kx[tid] = 1.f - fgv; vv[tid] = z[C_I + h * 128 + tid]; }
    __syncthreads();
    const int e4 = (tid & 31) * 4, dr = tid >> 5; const size_t sbase = (((size_t)j * DB + b) * 4 + h) * 16384;
    const float* S0 = P.state_hgrn + sbase; float* S1 = P.out + O_HG_S + sbase;
    f32x4 acc = {0.f, 0.f, 0.f, 0.f}; const f32x4 v4 = *(const f32x4*)(vv + e4);
#pragma unroll
    for (int it = 0; it < 8; ++it) { const int d = it * 16 + dr; const f32x4 s0 = *(const f32x4*)(S0 + d * 128 + e4); const f32x4 sn = s0 * fg[d] + v4 * kx[d]; *(f32x4*)(S1 + d * 128 + e4) = sn; acc += sn * qq[d]; }
    *(f32x4*)(part + dr * 128 + e4) = acc;
    __syncthreads();
    float o = 0.f;
    if (tid < 128) { for (int r = 0; r < 16; ++r) o += part[r * 128 + tid]; sq[tid] = o * o; }
    __syncthreads();
    if (tid < 128) { float ss = 0.f; for (int i = 0; i < 128; ++i) ss += sq[i]; const float rs = rsqrtf(ss * (1.f / 128.f) + EPS);
        ((bf16*)(P.ws + WS_SMP + SMP_OCS))[(size_t)b * D + h * 128 + tid] = f2bf(o * rs * P.hgrn_norm[j * 128 + tid] * siluf_(z[C_G + h * 128 + tid])); }
    __syncthreads();
}
DI void sattn_core(const float* const* kp, int nkeys, const float* qL, float* sc, float* red, float* oacc) {
    const int tid = otid(), wave = tid >> 6, lane = tid & 63;
    for (int key = tid; key < nkeys; key += 512) { const float* k = kp[key]; float d0 = -INFINITY, d1 = -INFINITY, d2 = -INFINITY, d3 = -INFINITY;
        if (k) { d0 = d1 = d2 = d3 = 0.f;
#pragma unroll
            for (int i = 0; i < 16; ++i) { const f32x4 kv = *(const f32x4*)(k + 4 * i); const f32x4 a = *(const f32x4*)(qL + 4 * i), b = *(const f32x4*)(qL + 64 + 4 * i), c = *(const f32x4*)(qL + 128 + 4 * i), d = *(const f32x4*)(qL + 192 + 4 * i);
                d0 += (kv.x * a.x + kv.y * a.y) + (kv.z * a.z + kv.w * a.w); d1 += (kv.x * b.x + kv.y * b.y) + (kv.z * b.z + kv.w * b.w);
                d2 += (kv.x * c.x + kv.y * c.y) + (kv.z * c.z + kv.w * c.w); d3 += (kv.x * d.x + kv.y * d.y) + (kv.z * d.z + kv.w * d.w); }
            d0 *= 0.125f; d1 *= 0.125f; d2 *= 0.125f; d3 *= 0.125f; }
        sc[key] = d0; sc[1040 + key] = d1; sc[2080 + key] = d2; sc[3120 + key] = d3; }
    __syncthreads();
    if (wave < 4) { float* row = sc + wave * 1040; float mx = -INFINITY; for (int k = lane; k < nkeys; k += 64) mx = fmaxf(mx, row[k]); mx = wave_max(mx); const float mu = (mx == -INFINITY) ? 0.f : mx;
        float sm = 0.f; for (int k = lane; k < nkeys; k += 64) { const float e = __expf(row[k] - mu); row[k] = e; sm += e; } sm = wave_sum(sm); const float il = 1.f / fmaxf(sm, 1e-30f);
        for (int k = lane; k < nkeys; k += 64) row[k] *= il; }
    __syncthreads();
    {
      const int ks = tid >> 4, d4 = (tid & 15) * 4; f32x4 a0 = {0.f, 0.f, 0.f, 0.f}, a1 = a0, a2 = a0, a3 = a0; const float* safe = kp[0];
      for (int k0 = ks; k0 < nkeys; k0 += 256) {
          f32x4 v[8]; float p0[8], p1[8], p2[8], p3[8];
#pragma unroll
          for (int u = 0; u < 8; ++u) { const int k = k0 + 32 * u; const bool ok = k < nkeys; const float* kv = ok ? kp[k] : nullptr; const bool ld = kv != nullptr; kv = ld ? kv : safe;
              v[u] = *(const f32x4*)(kv + 128 + d4); const int kk = ok ? k : 0;
              p0[u] = ld ? sc[kk] : 0.f; p1[u] = ld ? sc[1040 + kk] : 0.f; p2[u] = ld ? sc[2080 + kk] : 0.f; p3[u] = ld ? sc[3120 + kk] : 0.f; }
#pragma unroll
          for (int u = 0; u < 8; ++u) { a0 += v[u] * p0[u]; a1 += v[u] * p1[u]; a2 += v[u] * p2[u]; a3 += v[u] * p3[u]; }
      }
      *(f32x4*)(red + (ks * 4 + 0) * 64 + d4) = a0; *(f32x4*)(red + (ks * 4 + 1) * 64 + d4) = a1; *(f32x4*)(red + (ks * 4 + 2) * 64 + d4) = a2; *(f32x4*)(red + (ks * 4 + 3) * 64 + d4) = a3; }
    __syncthreads();
    if (tid < 256) { float a = 0.f;
#pragma unroll 8
        for (int ks = 0; ks < 32; ++ks) a += red[ks * 256 + tid];
        oacc[tid] = a; }
    __syncthreads();
}
DI void sattn_unit(unsigned char* lds, int j, int b, int g) {
    const Ptrs P = get_ptrs();
    const int tid = otid(), lane = tid & 63;
    const float** kp = (const float**)lds;
    float* sc = (float*)(lds + 8320);
    float* qL = sc + 4 * 1040; float* red = qL + 256; float* oacc = red + 8192; float* om = oacc + 256; float* imp = om + 256; int* flag = (int*)(imp + 132); int* list = flag + 132;
    const float* z = (const float*)(P.ws + WS_SMP + SMP_ZS) + (size_t)b * ABP;
    if (tid < 256) { qL[tid] = z[C_QB + g * 256 + tid]; om[tid] = 0.f; }
    const float* wbuf = P.state_win + (((size_t)j * DB + b) * 512) * 256 + g * 64;
    for (int k = tid; k < 512; k += 512) kp[k] = (k < 511) ? wbuf + (size_t)(k + 1) * 256 : z + C_WIN + g * 64;
    __syncthreads();
    sattn_core(kp, 512, qL, sc, red, oacc);
    if (tid < 256) { const int r = tid >> 6; om[tid] += sigmoidf_(z[C_GATE + (g * 4 + r) * 3 + 2]) * oacc[tid]; }
    __syncthreads();
    const float* kcs = (const float*)(P.ws + WS_KCS) + (size_t)b * 512 * 256 + g * 64;
    for (int k = tid; k < 511; k += 512) kp[k] = kcs + (size_t)k * 256;
    __syncthreads();
    sattn_core(kp, 511, qL, sc, red, oacc);
    if (tid < 256) { const int r = tid >> 6; om[tid] += sigmoidf_(z[C_GATE + (g * 4 + r) * 3 + 0]) * oacc[tid]; }
    if (tid < 129) { float a = 0.f; const int nlo = (4 * tid - 1 < 0) ? 0 : 4 * tid - 1, nhi = (4 * tid + 3 > 510) ? 510 : 4 * tid + 3;
        for (int r = 0; r < 4; ++r) for (int n = nlo; n <= nhi; ++n) a += sc[r * 1040 + n];
        imp[tid] = a; flag[tid] = (tid == 0 || tid == 127 || tid == 128) ? 1 : 0; }
    __syncthreads();
    if (tid < 64) {
        const int j1 = lane + 1, j2 = lane + 65; float v1 = imp[j1], v2 = (j2 <= 126) ? imp[j2] : -INFINITY; bool t1 = false, t2 = (j2 > 126);
        for (int it = 0; it < 13; ++it) {
            float bv; int bi;
            const float c1 = t1 ? -INFINITY : v1, c2 = t2 ? -INFINITY : v2;
            if (c2 > c1) { bv = c2; bi = j2; } else { bv = c1; bi = j1; }
#pragma unroll
            for (int o_ = 1; o_ < 64; o_ <<= 1) { const float ov = __shfl_xor(bv, o_); const int oi = __shfl_xor(bi, o_); if (ov > bv || (ov == bv && oi < bi)) { bv = ov; bi = oi; } }
            if (bi == j1) { t1 = true; flag[j1] = 1; } else if (bi == j2) { t2 = true; flag[j2] = 1; }
        }
    }
    __syncthreads();
    if (tid == 0) { int n = 0; for (int jb = 0; jb < 129 && n < 16; ++jb) if (flag[jb]) list[n++] = jb; for (; n < 16; ++n) list[n] = -1; }
    __syncthreads();
    for (int k = tid; k < 1024; k += 512) { const int jb = list[k >> 6], i = k & 63; const float* p = nullptr;
        if (jb >= 0) { if (jb < 128) { const int pos = jb * 64 + i, page = P.page_table[b * NPAGES + (pos >> 7)]; p = P.cache_sel + (((size_t)j * NPOOL + page) * 128 + (pos & 127)) * 256 + g * 64; }
                       else if (i == 0) p = z + C_SEL + g * 64; }
        kp[k] = p; }
    __syncthreads();
    sattn_core(kp, 1024, qL, sc, red, oacc);
    if (tid < 256) { const int r = tid >> 6, d = tid & 63; const float v = om[tid] + sigmoidf_(z[C_GATE + (g * 4 + r) * 3 + 1]) * oacc[tid];
        ((bf16*)(P.ws + WS_SMP + SMP_OCS))[(size_t)b * D + 512 + (g * 4 + r) * 64 + d] = f2bf(v); }
    __syncthreads();
}
DI void gmlp_s_unit(unsigned char* lds, int jc, int b) {
    const Ptrs P = get_ptrs();
    const int tid = otid(), wave = tid >> 6, lane = tid & 63; float* red = (float*)lds;
    const float* uv = (const float*)(P.ws + WS_SMP + SMP_UVS) + (size_t)b * 2048;
    const float v0 = uv[1024 + tid], v1 = uv[1024 + 512 + tid];
    float s = wave_sum(v0 + v1); if (lane == 0) red[wave] = s; __syncthreads();
    float mean = 0.f; for (int w = 0; w < 8; ++w) mean += red[w]; mean *= (1.f / 1024.f); __syncthreads();
    const float d0 = v0 - mean, d1 = v1 - mean; s = wave_sum(d0 * d0 + d1 * d1); if (lane == 0) red[wave] = s; __syncthreads();
    float var = 0.f; for (int w = 0; w < 8; ++w) var += red[w]; const float rs = rsqrtf(var * (1.f / 1024.f) + EPS);
#pragma unroll
    for (int k = 0; k < 2; ++k) { const int c = tid + 512 * k, gq = c >> 7; const float vl = (k ? d1 : d0) * rs * P.ln_c_g[jc * D + c] + P.ln_c_b[jc * D + c];
        P.out[O_CV_S + ((size_t)jc * DB + b) * D + c] = vl;
        ((bf16*)(P.ws + WS_SMP + SMP_OCS))[(size_t)b * D + c] = f2bf(uv[c] * (P.w_s[(size_t)(jc * 8 + gq) * 16384] * vl + P.b_s[(jc * 8 + gq) * 128])); }
    __syncthreads();
}
DI void final_norm(int bid, int G) {
    const Ptrs P = get_ptrs();
    const int tid = otid(), wave = tid >> 6, lane = tid & 63; const int gw = bid * 8 + wave, NGW = G * 8;
    const float* hs = (const float*)(P.ws + WS_SMP + SMP_HS);
    f32x4 g4[4];
#pragma unroll
    for (int k = 0; k < 4; ++k) g4[k] = ((const f32x4*)P.norm_final)[lane + 64 * k];
    const bf16* hbp = (const bf16*)(P.ws + WS_HB);
    for (int m0 = gw; m0 < MP; m0 += 4 * NGW) {
        u32x2 w[4][4];
#pragma unroll
        for (int r = 0; r < 4; ++r) { const int m = m0 + r * NGW; if (m < MP) { const u32x2* xr = (const u32x2*)(hbp + (size_t)m * D) + lane;
#pragma unroll
            for (int k = 0; k < 4; ++k) w[r][k] = xr[64 * k]; } }
#pragma unroll
        for (int r = 0; r < 4; ++r) { const int m = m0 + r * NGW; if (m < MP) { f32x4 v[4]; float s = 0.f;
#pragma unroll
            for (int k = 0; k < 4; ++k) v[k] = (f32x4){bflo(w[r][k].x), bfhi(w[r][k].x), bflo(w[r][k].y), bfhi(w[r][k].y)};
#pragma unroll
            for (int k = 0; k < 4; ++k) s += (v[k].x * v[k].x + v[k].y * v[k].y) + (v[k].z * v[k].z + v[k].w * v[k].w);
            const float rs = rsqrtf(wave_sum(s) * (1.f / 1024.f) + EPS);
            f32x4* o = (f32x4*)(P.out + O_YP + (size_t)m * D) + lane;
#pragma unroll
            for (int k = 0; k < 4; ++k) o[64 * k] = v[k] * rs * g4[k]; } }
    }
    for (int m = gw; m < DB; m += NGW) {
        f32x4 v[4]; float s = 0.f; const f32x4* xr = (const f32x4*)(hs + (size_t)m * D) + lane;
#pragma unroll
        for (int k = 0; k < 4; ++k) v[k] = xr[64 * k];
#pragma unroll
        for (int k = 0; k < 4; ++k) s += (v[k].x * v[k].x + v[k].y * v[k].y) + (v[k].z * v[k].z + v[k].w * v[k].w);
        const float rs = rsqrtf(wave_sum(s) * (1.f / 1024.f) + EPS);
        f32x4* o = (f32x4*)(P.out + O_YS + (size_t)m * D) + lane;
#pragma unroll
        for (int k = 0; k < 4; ++k) o[64 * k] = v[k] * rs * g4[k];
    }
}
constexpr int N_PHASES = 30;
__global__ void __launch_bounds__(512, 2) mega_fwd(Args args) {
    extern __shared__ __attribute__((aligned(16))) unsigned char lds[];
    const int tid = otid(), bid = blockIdx.x, G = gridDim.x;
    const int lo = args.ph_lo, hi = args.ph_hi;
    volatile LAS unsigned* MISC = (volatile LAS unsigned*)((LAS unsigned char*)lds + MISC_OFF);
    if (tid < 16) MISC[tid] = 0u;
    __syncthreads();
    XcdBarrier bar; bar.bar = (unsigned*)(args.ws + WS_CTL); bar.x = 0; bar.st = nullptr;
    const bool multi = (hi - lo) > 1;
    if (multi) bar = xcd_barrier_post((unsigned*)(args.ws + WS_CTL), MISC + 8);
#ifndef PHM
#define PHM 0x7ff
#endif
#define SITE(s) ((PHM >> (s)) & 1)
#ifndef PROBE_DUP
#define PROBE_DUP 0
#endif
#define NREP(s) (1 + ((PROBE_DUP >> (s)) & 1))
#ifndef FILL_A
#define FILL_A 1
#endif
#ifndef WGM_A
#define WGM_A 4
#endif
#ifndef WGM_C
#define WGM_C 4
#endif
#ifndef WGM_E
#define WGM_E 4
#endif
#ifndef WGM_F
#define WGM_F 4
#endif
#ifndef WGM_G
#define WGM_G 16
#endif
#ifndef PROBE_SK
#define PROBE_SK 0
#endif
#ifndef PROBE_SUB
#define PROBE_SUB 0
#endif
#define IN(k) (lo <= (k) && (k) < hi)
#ifndef PROBE_DBLBAR
#define PROBE_DBLBAR 0
#endif
#define SEAM(k) do { if (multi && (k) + 1 < hi) { xcd_barrier(bar); if (PROBE_DBLBAR) xcd_barrier(bar); } else __syncthreads(); } while (0)
#define LOCALS const Ptrs P = get_ptrs(); unsigned char* ws = P.ws; (void)ws; \
    float* hp = (float*)(ws + WS_HP); bf16* hb = (bf16*)(ws + WS_HB); float* ssq = (float*)(ws + WS_SSQ); bf16* zb = (bf16*)(ws + WS_ZB); bf16* hff = (bf16*)(ws + WS_HFF); bf16* oc = (bf16*)(ws + WS_OC); \
    float* hs = (float*)(ws + WS_SMP + SMP_HS); float* zs = (float*)(ws + WS_SMP + SMP_ZS); bf16* ocs = (bf16*)(ws + WS_SMP + SMP_OCS); bf16* hffs = (bf16*)(ws + WS_SMP + SMP_HFFS); float* uvs = (float*)(ws + WS_SMP + SMP_UVS); bf16* hsb = (bf16*)(ws + WS_SMP + SMP_HSB); (void)hsb; \
    (void)hp; (void)hb; (void)ssq; (void)zb; (void)hff; (void)oc; (void)hs; (void)zs; (void)ocs; (void)hffs; (void)uvs;
    PG8_LAS unsigned char* ring = (PG8_LAS unsigned char*)lds;

    if (SITE(0) && IN(0)) { for (int rep = 0; rep < NREP(0); ++rep) prologue(lds, bid, G); SEAM(0); }

    for (int L = 0; L < 4; ++L) {
        const int pb = 1 + 7 * L, j = L >> 1;
        if ((L & 1) == 0) {
            if (SITE(1) && IN(pb + 0)) {
                LOCALS
                for (int rep = 0; rep < NREP(1); ++rep) {
                { pg8::Gemm g{hb, (const bf16*)(ws + WS_WINAB) + (size_t)j * ABP * D, MP, ABP, D}; pg8::StaticOrder S; S.init(MP, ABP, G, bid, WGM_A);
                  EpiInAB E{zb, ssq, P.out + O_CMP_P + (size_t)j * MP * 256, P.out + O_SEL_P + (size_t)j * MP * 256, P.out + O_WIN_P + (size_t)j * BATCH * 512 * 256};
                  pg8::gemm_phase<EpiInAB, pg8::StaticOrder, true, true, false, true>(ring, g, S, E); }
                { SEpiInAB E{zs, P.out + O_CMP_S + (size_t)j * DB * 256, P.out + O_SEL_S + (size_t)j * DB * 256};
                  skinny_gemm<true, 4, SEpiInAB>(lds, hsb, D, (const bf16*)(ws + WS_WINAB) + (size_t)j * ABP * D, ABP, bid, G, E);
                   }
                if (rep == 0 && FILL_A) { const int rem = 896 % G;
                    if (rem != 0 && bid >= rem && bid - rem < 512) { const int u_ = bid - rem;
#pragma unroll 1
                        for (int kv_ = 0; kv_ < 2; ++kv_) compress_unit<true>(lds, j, u_ >> 4, u_ & 15, 511, PAST, kv_, kv_ + 1); } }
                }
                SEAM(pb + 0);
            }
            if (SITE(2) && IN(pb + 1)) {
                for (int rep = 0; rep < NREP(2); ++rep) {
                const int rem_ = 896 % G, npre = (FILL_A && rem_ != 0) ? ((G - rem_ < 512) ? 2 * (G - rem_) : 1024) : 0, NH = 1024 - npre;
                unsigned* qctr = (unsigned*)(get_ptrs().ws + WS_CTL) + 4096 + 64 * (4 + j * 2 + rep);
                volatile LAS unsigned* qslot = MISC + 4;
                unsigned nxt = 0u;
                if (tid == 0) nxt = __hip_atomic_fetch_add(qctr, 1u, __ATOMIC_RELAXED, __HIP_MEMORY_SCOPE_AGENT);
                for (;;) {
                    if (tid == 0) qslot[0] = nxt;
                    __syncthreads();
                    int it = (int)qslot[0];
                    __syncthreads();
                    if (it >= NH + 736) break;
                    if (tid == 0) nxt = __hip_atomic_fetch_add(qctr, 1u, __ATOMIC_RELAXED, __HIP_MEMORY_SCOPE_AGENT);
                    if (it < 32) { const int u = it; compress_unit<false>(lds, j, u >> 3, u & 7, 255, SEQ, 0, 2); continue; }
                    it -= 32;
                    if (it < NH) { const int hi_ = it + npre; compress_unit<true>(lds, j, hi_ >> 5, (hi_ >> 1) & 15, 511, PAST, hi_ & 1, (hi_ & 1) + 1); continue; }
                    it += 544 - NH;
                    if (it < 672) { const int u = it - 544; hgrn_s_unit(lds, j, u >> 2, u & 3); }
                    else if (it < 736) {
                        LOCALS
                        const f32x4* src = (const f32x4*)(P.state_win + (size_t)j * DB * 512 * 256); f32x4* dst = (f32x4*)(P.out + O_WIN_S + (size_t)j * DB * 512 * 256);
                        const int i0 = (it - 672) * 16384 + otid();
#pragma unroll 16
                        for (int q = 0; q < 32; ++q) { const int i = i0 + q * 512, c4 = i & 63, s = (i >> 6) & 511, b = i >> 15;
                            dst[i] = (s < 511) ? src[i + 64] : *(const f32x4*)(zs + (size_t)b * ABP + C_WIN + c4 * 4); } }
                    else { const int u = (it - 736) * 2; hgrn_p1_unit(lds, j, u >> 8, u & 63, (u >> 6) & 3); hgrn_p1_unit(lds, j, (u + 1) >> 8, (u + 1) & 63, ((u + 1) >> 6) & 3); }
                }
                }
                SEAM(pb + 1);
            }
            if (SITE(3) && IN(pb + 2)) {
                for (int rep = 0; rep < NREP(3); ++rep) {
                const int myq = (int)(xb_xcc_id() & 7u); bool scan_ok = false;
                volatile LAS unsigned* qslot = MISC + 4;
                for (int off = 0; off < 8; ++off) {
                    const int q = (myq + off) & 7;
                    unsigned* qctr = (unsigned*)(get_ptrs().ws + WS_CTL) + 4096 + 64 * (16 + (j * 2 + rep) * 8 + q);
                    unsigned nxt = 0u;
                    if (tid == 0) nxt = __hip_atomic_fetch_add(qctr, 1u, __ATOMIC_RELAXED, __HIP_MEMORY_SCOPE_AGENT);
                    for (;;) {
                        if (tid == 0) qslot[0] = nxt;
                        __syncthreads();
                        const int it = (int)qslot[0];
                        __syncthreads();
                        if (it >= 216) break;
                        if (tid == 0) nxt = __hip_atomic_fetch_add(qctr, 1u, __ATOMIC_RELAXED, __HIP_MEMORY_SCOPE_AGENT);
                        if (it < 16) { if (rep == 0) hgrn_scan_item(j, q * 16 + it); }
                        else if (it < 24) { if (rep == 0 || PROBE_SUB != 2) { const int u = q * 8 + (it - 16); sattn_unit(lds, j, u >> 1, u & 1); } }
                        else if (it < 88) { if (rep == 0 || PROBE_SUB != 1) { const int qi = 63 - (it - 24); attn_unit(lds, q >> 1, q & 1, qi); if (rep == 0) publish_count(700 + (j * 8 + q) * 16 + (qi >> 2)); } }
                        else if (it < 152) { if (rep != 0) continue; const int i_ = it - 88, qb = 15 - (i_ >> 2);
                            wait_count(700 + (j * 8 + q) * 16 + qb, 4u);
                            sel_attn_unit(lds, q >> 1, (q & 1) * 4 + (i_ & 3), qb); }
                        else {
                            if (rep != 0) continue;
                            if (!scan_ok) { scan_wait(j); scan_ok = true; }
                            const int u = q * 128 + (it - 152) * 2; hgrn_p3_unit(lds, j, u >> 8, u & 63, (u >> 6) & 3); hgrn_p3_unit(lds, j, (u + 1) >> 8, (u + 1) & 63, ((u + 1) >> 6) & 3); }
                    }
                }
                }
                SEAM(pb + 2);
            }
        } else {
            if (SITE(5) && IN(pb + 0)) {
                LOCALS
                for (int rep = 0; rep < NREP(5); ++rep) {
                { pg8::Gemm g{hb, (const bf16*)(ws + WS_WINC) + (size_t)j * 2048 * D, MP, 2048, D}; pg8::StaticOrder S; S.init(MP, 2048, G, bid, WGM_C);
                  EpiInC E{zb, zb + (size_t)MP * D, ssq, (float*)(ws + WS_VSTAT)};
                  pg8::gemm_phase<EpiInC, pg8::StaticOrder, true, true, false, true>(ring, g, S, E); }
                { SEpiInC E{uvs}; skinny_gemm<true, 4, SEpiInC>(lds, hsb, D, (const bf16*)(ws + WS_WINC) + (size_t)j * 2048 * D, 2048, bid, G, E); }
                }
                SEAM(pb + 0);
            }
            if (SITE(6) && IN(pb + 1)) {
                for (int rep = 0; rep < NREP(6); ++rep) {
                unsigned* qctr = (unsigned*)(get_ptrs().ws + WS_CTL) + 4096 + 64 * (72 + j * 2 + rep);
                volatile LAS unsigned* qslot = MISC + 4; unsigned nxt = 0u;
                if (tid == 0) nxt = __hip_atomic_fetch_add(qctr, 1u, __ATOMIC_RELAXED, __HIP_MEMORY_SCOPE_AGENT);
                for (;;) {
                    if (tid == 0) qslot[0] = nxt;
                    __syncthreads();
                    const int it = (int)qslot[0];
                    __syncthreads();
                    if (it >= 512 + DB) break;
                    if (tid == 0) nxt = __hip_atomic_fetch_add(qctr, 1u, __ATOMIC_RELAXED, __HIP_MEMORY_SCOPE_AGENT);
                    if (it < DB) gmlp_s_unit(lds, j, it);
                    else { const int u = (it - DB) * 2; mix_unit(lds, j, u >> 3, u & 7); mix_unit(lds, j, (u + 1) >> 3, (u + 1) & 7); }
                }
                }
                SEAM(pb + 1);
            }
        }
        if (SITE(7) && IN(pb + 4)) {
            LOCALS
            const bf16* wo = (L & 1) ? (const bf16*)(ws + WS_WOUTC) + (size_t)j * D * D : (const bf16*)(ws + WS_WOUTAB) + (size_t)j * D * D;
            { pg8::Gemm g{oc, wo, MP, D, D}; pg8::StaticOrder S; S.init(MP, D, G, bid, WGM_E);
              if (NREP(7) == 2) { EpiResid E2{hb, (bf16*)(ws + WS_DUMMY + 64 * MiB), (float*)(ws + WS_DUMMY + 96 * MiB)}; pg8::gemm_phase<EpiResid, pg8::StaticOrder, true, true, false, true>(ring, g, S, E2);
                  SEpiResid E3{(float*)(ws + WS_DUMMY + 98 * MiB), (bf16*)(ws + WS_DUMMY + 99 * MiB)}; skinny_gemm<false, 4, SEpiResid>(lds, ocs, D, wo, D, bid, G, E3); }
              EpiResid E{hb, hb, ssq};
              pg8::gemm_phase<EpiResid, pg8::StaticOrder, true, true, false, true>(ring, g, S, E); }
            { SEpiResid E{hs, hsb}; skinny_gemm<false, 4, SEpiResid>(lds, ocs, D, wo, D, bid, G, E); }
            SEAM(pb + 4);
        }
        if (SITE(8) && IN(pb + 5)) {
            LOCALS
            const bf16* w1 = (const bf16*)(ws + WS_WF1) + (size_t)L * FF * D;
            for (int rep = 0; rep < NREP(8); ++rep) {
            { pg8::Gemm g{hb, w1, MP, FF, D}; pg8::StaticOrder S; S.init(MP, FF, G, bid, WGM_F); EpiFFN1 E{hff, ssq};
              pg8::gemm_phase<EpiFFN1, pg8::StaticOrder, true, true, false, true>(ring, g, S, E); }
            { SEpiFFN1 E{hffs}; skinny_gemm<true, 4, SEpiFFN1>(lds, hsb, D, w1, FF, bid, G, E); }
            }
            SEAM(pb + 5);
        }
        if (SITE(9) && IN(pb + 6)) {
            LOCALS
            const bf16* w2 = (const bf16*)(ws + WS_WF2) + (size_t)L * D * FF;
            { pg8::Gemm g{hff, w2, MP, D, FF}; pg8::StaticOrder S; S.init(MP, D, G, bid, WGM_G);
              if (NREP(9) == 2) { EpiResid E2{hb, (bf16*)(ws + WS_DUMMY + 64 * MiB), (float*)(ws + WS_DUMMY + 96 * MiB)}; pg8::gemm_phase<EpiResid, pg8::StaticOrder, true, true, true, true>(ring, g, S, E2);
                  SEpiResid E3{(float*)(ws + WS_DUMMY + 98 * MiB), (bf16*)(ws + WS_DUMMY + 99 * MiB)}; skinny_gemm<false, 16, SEpiResid>(lds, hffs, FF, w2, D, bid, G, E3); }
              EpiResid E{hb, hb, ssq};
              pg8::gemm_phase<EpiResid, pg8::StaticOrder, true, true, true, true>(ring, g, S, E); }
            { SEpiResid E{hs, hsb}; skinny_gemm<false, 16, SEpiResid>(lds, hffs, FF, w2, D, bid, G, E); }
            SEAM(pb + 6);
        }
    }
    if (SITE(10) && IN(29)) for (int rep = 0; rep < NREP(10); ++rep) final_norm(bid, G);
#undef IN
#undef SEAM
#undef LOCALS
}

extern "C" void kernel_launch(void* const* d_in, const int* in_sizes, int n_in, void* d_out, int out_size, void* d_ws, size_t ws_size, hipStream_t stream) {
    static int grid = 0;
    if (grid == 0) {
        if (n_in != 25 || (size_t)out_size != O_END || ws_size < WS_END + 100 * MiB) { fprintf(stderr, "kernel_launch: unexpected shapes (n_in %d out %d ws %zu)\n", n_in, out_size, ws_size); grid = -1; return; }
        int dev = 0, cus = 0, per_cu = 0;
        if (hipGetDevice(&dev) != hipSuccess || hipDeviceGetAttribute(&cus, hipDeviceAttributeMultiprocessorCount, dev) != hipSuccess) { grid = -1; return; }
        if (hipFuncSetAttribute((const void*)mega_fwd, hipFuncAttributeMaxDynamicSharedMemorySize, LDS_BYTES) != hipSuccess) { fprintf(stderr, "kernel_launch: hipFuncSetAttribute failed\n"); grid = -1; return; }
        if (hipOccupancyMaxActiveBlocksPerMultiprocessor(&per_cu, (const void*)mega_fwd, 512, LDS_BYTES) != hipSuccess || per_cu < 1) fprintf(stderr, "kernel_launch: occupancy query says %d\n", per_cu);
        (void)hipGetLastError();
        grid = cus;
    }
    if (grid < 0) return;
    (void)hipMemsetAsync((char*)d_ws + WS_CTL, 0, CTL_ZERO_BYTES, stream);
    Args a{};
    for (int i = 0; i < 25; ++i) a.in[i] = d_in[i];
    a.out = (float*)d_out; a.ws = (unsigned char*)d_ws;
#if MK_ONE_LAUNCH
#ifndef PROBE_PRE
#define PROBE_PRE 0
#endif
    if (PROBE_PRE > 0) {
        a.ph_lo = 0; a.ph_hi = PROBE_PRE; hipLaunchKernelGGL(mega_fwd, dim3(grid), dim3(512), LDS_BYTES, stream, a);
        (void)hipMemsetAsync((char*)d_ws + WS_CTL, 0, CTL_ZERO_BYTES, stream); }
    a.ph_lo = 0; a.ph_hi = N_PHASES;
    hipLaunchKernelGGL(mega_fwd, dim3(grid), dim3(512), LDS_BYTES, stream, a);
#else
    for (int ph = 0; ph < N_PHASES; ++ph) {
        if (ph >= 1 && ph <= 28) { const int L = (ph - 1) / 7, loc = (ph - 1) % 7; if ((L & 1) && (loc == 2 || loc == 3)) continue; }
        a.ph_lo = ph; a.ph_hi = ph + 1;
        hipLaunchKernelGGL(mega_fwd, dim3(grid), dim3(512), LDS_BYTES, stream, a);
    }
#endif
}
```
